# Optimizing an MI355X kernel written in HIP

```python
import jax
import jax.numpy as jnp
from jax import lax
import numpy as np

D_MODEL = 1024
BATCH = 2
SEQ = 8192
DEPTH = 1

N_MEM = 256
EPS = 1e-6

GLA_HEADS = 4
GLA_DK = D_MODEL // 16
GLA_DV = D_MODEL // 8
GLA_RANK = 16
GLA_GATE_NORMALIZER = 16.0
GLA_CHUNK = 64

MOBA_HEADS = 4
MOBA_DH = D_MODEL // 16
MOBA_BLOCK = 256
MOBA_TOPK = 3
MOBA_QBLOCK = 128

MEM_HEADS = 4
MEM_DH = D_MODEL // 16

GLA_QK_W = GLA_HEADS * GLA_DK
GLA_V_W = GLA_HEADS * GLA_DV
MOBA_W = MOBA_HEADS * MOBA_DH
MEM_W = MEM_HEADS * MEM_DH
D_MIX = GLA_V_W + MOBA_W + MEM_W
IN_SPLITS = (GLA_QK_W, GLA_QK_W, GLA_V_W, GLA_V_W, GLA_RANK, MOBA_W, MOBA_W, MOBA_W, MEM_W)
D_IN = sum(IN_SPLITS)

N_GROUPS = 4
EXPERTS_PER_GROUP = 8
N_EXPERTS = N_GROUPS * EXPERTS_PER_GROUP
MOE_TOPK = 2
MOE_FF = D_MODEL // 2
MOE_BLOCK = 128

kernel_name = 'hymba_gla_moba_mem_hmoe_layer'


def rmsnorm(x, g):
    xf = x.astype(jnp.float32)
    y = xf * lax.rsqrt(jnp.mean(xf * xf, axis=-1, keepdims=True) + EPS)
    return (y * g.astype(jnp.float32)).astype(x.dtype)


def split_heads(t, n):
    b, s, w = t.shape
    return t.reshape(b, s, n, w // n).transpose(0, 2, 1, 3)


def merge_heads(t):
    b, n, s, d = t.shape
    return t.transpose(0, 2, 1, 3).reshape(b, s, n * d)


def alibi_slopes(n):
    return jnp.asarray(2.0 ** (-8.0 * np.arange(1, n + 1) / n), dtype=jnp.float32)


def gla_chunked(q, k, v, g):
    f32 = jnp.float32
    b, h, s, dk = q.shape
    dv = v.shape[-1]
    c = GLA_CHUNK
    n = s // c
    qf = q.astype(f32).reshape(b, h, n, c, dk) * (dk ** -0.5)
    kf = k.astype(f32).reshape(b, h, n, c, dk)
    vf = v.astype(f32).reshape(b, h, n, c, dv)
    cum = jnp.cumsum(g.astype(f32).reshape(b, h, n, c, dk), axis=3)
    cum_last = cum[:, :, :, -1:, :]
    q_dec = qf * jnp.exp(cum)
    k_inv = kf * jnp.exp(-cum)
    causal = jnp.tril(jnp.ones((c, c), dtype=bool))
    a_intra = jnp.where(causal, jnp.einsum('bhnik,bhnjk->bhnij', q_dec, k_inv), 0.0)
    o_intra = jnp.einsum('bhnij,bhnjv->bhniv', a_intra, vf)
    k_end = kf * jnp.exp(cum_last - cum)
    d_state = jnp.einsum('bhnck,bhncv->nbhkv', k_end, vf)
    chunk_decay = jnp.moveaxis(jnp.exp(cum_last[:, :, :, 0, :]), 2, 0)

    def step(state, inp):
        dec, ds = inp
        return state * dec[..., None] + ds, state

    _, s_prev = lax.scan(step, jnp.zeros((b, h, dk, dv), f32), (chunk_decay, d_state))
    o_inter = jnp.einsum('bhnck,nbhkv->bhncv', q_dec, s_prev)
    return (o_intra + o_inter).reshape(b, h, s, dv)


def moba_attention(q, k, v, slopes):
    f32 = jnp.float32
    b, h, s, d = q.shape
    nb = -(-s // MOBA_BLOCK)
    pad = nb * MOBA_BLOCK - s
    k_p = jnp.pad(k, ((0, 0), (0, 0), (0, pad), (0, 0)))
    v_p = jnp.pad(v, ((0, 0), (0, 0), (0, pad), (0, 0)))
    kb = k_p.reshape(b, h, nb, MOBA_BLOCK, d)
    vb = v_p.reshape(b, h, nb, MOBA_BLOCK, d)
    k_mean = jnp.mean(kb.astype(f32), axis=3)
    nb_gate = max(nb, MOBA_TOPK)
    scale = d ** -0.5
    bi = jnp.arange(b)[:, None, None, None]
    hi = jnp.arange(h)[None, :, None, None]
    blk_pos = jnp.arange(MOBA_BLOCK)
    m = slopes[None, :, None, None]
    n_sel = MOBA_TOPK * MOBA_BLOCK

    def query_block(qb):
        start = qb * MOBA_QBLOCK
        qc = lax.dynamic_slice_in_dim(q, start, MOBA_QBLOCK, axis=2)
        t = start + jnp.arange(MOBA_QBLOCK)
        own = start // MOBA_BLOCK
        gate = jnp.einsum('bhqd,bhnd->bhqn', qc.astype(f32), k_mean)
        gate = jnp.where(jnp.arange(nb) < own, gate, -jnp.inf)
        gate = jnp.pad(gate, ((0, 0), (0, 0), (0, 0), (0, nb_gate - nb)), constant_values=-jnp.inf)
        _, idx = lax.top_k(gate, MOBA_TOPK)
        idx = jnp.minimum(idx, nb - 1)
        valid = jnp.arange(MOBA_TOPK) < own
        k_sel = kb[bi, hi, idx]
        v_sel = vb[bi, hi, idx]
        s_sel = jnp.einsum('bhqd,bhqkjd->bhqkj', qc, k_sel, preferred_element_type=f32) * scale
        dist_sel = (t[:, None, None] - (idx[..., None] * MOBA_BLOCK + blk_pos)).astype(f32)
        s_sel = jnp.where(valid[:, None], s_sel - m[..., None] * dist_sel, -jnp.inf)
        k_own = lax.dynamic_slice_in_dim(k_p, own * MOBA_BLOCK, MOBA_BLOCK, axis=2)
        v_own = lax.dynamic_slice_in_dim(v_p, own * MOBA_BLOCK, MOBA_BLOCK, axis=2)
        dist_own = (t[:, None] - (own * MOBA_BLOCK + blk_pos)[None, :]).astype(f32)
        s_own = jnp.einsum('bhqd,bhjd->bhqj', qc, k_own, preferred_element_type=f32) * scale
        s_own = jnp.where(dist_own >= 0, s_own - m * dist_own, -jnp.inf)
        scores = jnp.concatenate([s_sel.reshape(b, h, MOBA_QBLOCK, n_sel), s_own], axis=-1)
        p = jax.nn.softmax(scores, axis=-1)
        p_sel = p[..., :n_sel].reshape(b, h, MOBA_QBLOCK, MOBA_TOPK, MOBA_BLOCK).astype(v.dtype)
        p_own = p[..., n_sel:].astype(v.dtype)
        o = (jnp.einsum('bhqkj,bhqkjd->bhqd', p_sel, v_sel, preferred_element_type=f32)
             + jnp.einsum('bhqj,bhjd->bhqd', p_own, v_own, preferred_element_type=f32))
        return o.astype(q.dtype)

    out = lax.map(query_block, jnp.arange(s // MOBA_QBLOCK))
    return out.transpose(1, 2, 0, 3, 4).reshape(b, h, s, d)


def memory_attention(q, mk, mv):
    f32 = jnp.float32
    scale = q.shape[-1] ** -0.5
    s = jnp.einsum('bhsd,bhmd->bhsm', q, mk, preferred_element_type=f32) * scale
    p = jax.nn.softmax(s, axis=-1).astype(mv.dtype)
    return jnp.einsum('bhsm,bhmd->bhsd', p, mv, preferred_element_type=f32).astype(q.dtype)


def hierarchical_moe(h, w_rg, b_rg, w_re, b_re, w_gate, w_up, w_down):
    f32 = jnp.float32
    b, s, d = h.shape
    t_tok = b * s
    xt = h.reshape(t_tok, d)
    lg = jnp.einsum('td,dg->tg', xt, w_rg).astype(f32) + b_rg.astype(f32)
    g_sel = jnp.argmax(lg, axis=-1)
    p_group = jnp.take_along_axis(jax.nn.softmax(lg, axis=-1), g_sel[:, None], axis=-1)
    le = jnp.einsum('td,gde->tge', xt, w_re).astype(f32) + b_re.astype(f32)
    le = jnp.take_along_axis(le, g_sel[:, None, None], axis=1)[:, 0]
    le_top, e_loc = lax.top_k(le, MOE_TOPK)
    gates = p_group * jax.nn.softmax(le_top, axis=-1)
    expert = (g_sel[:, None] * EXPERTS_PER_GROUP + e_loc).astype(jnp.int32)

    n_assign = t_tok * MOE_TOPK
    e_flat = expert.reshape(n_assign)
    t_flat = jnp.repeat(jnp.arange(t_tok, dtype=jnp.int32), MOE_TOPK)
    w_flat = gates.reshape(n_assign)
    order = jnp.argsort(e_flat)
    e_s, t_s, w_s = e_flat[order], t_flat[order], w_flat[order]
    counts = jax.ops.segment_sum(jnp.ones((n_assign,), jnp.int32), e_flat, num_segments=N_EXPERTS)
    padded = (counts + MOE_BLOCK - 1) // MOE_BLOCK * MOE_BLOCK
    starts = jnp.cumsum(counts) - counts
    pstarts = jnp.cumsum(padded) - padded
    dest = pstarts[e_s] + (jnp.arange(n_assign, dtype=jnp.int32) - starts[e_s])
    n_blocks = (n_assign + N_EXPERTS * (MOE_BLOCK - 1) + MOE_BLOCK - 1) // MOE_BLOCK
    n_rows = n_blocks * MOE_BLOCK
    tok_buf = jnp.full((n_rows,), t_tok, jnp.int32).at[dest].set(t_s)
    w_buf = jnp.zeros((n_rows,), f32).at[dest].set(w_s)
    block_start = jnp.arange(n_blocks, dtype=jnp.int32) * MOE_BLOCK
    block_expert = jnp.minimum(jnp.searchsorted(pstarts + padded, block_start, side='right'), N_EXPERTS - 1)
    x_pad = jnp.concatenate([xt, jnp.zeros((1, d), xt.dtype)], axis=0)

    def expert_block(args):
        toks, e = args
        xb = x_pad[toks]
        hid = jax.nn.silu(xb @ w_gate[e]) * (xb @ w_up[e])
        return hid @ w_down[e]

    y = lax.map(expert_block, (tok_buf.reshape(n_blocks, MOE_BLOCK), block_expert))
    y = y.reshape(n_rows, d) * w_buf[:, None].astype(y.dtype)
    out = jnp.zeros((t_tok + 1, d), y.dtype).at[tok_buf].add(y)[:t_tok]
    return out.reshape(b, s, d)


def setup_inputs(seed: int = 0) -> dict:
    key = jax.random.key(seed)
    ks = jax.random.split(key, 24)
    L = DEPTH

    def nrm(k, shape, fan_in):
        return jax.random.normal(k, shape, jnp.float32) * fan_in ** -0.5

    def gain(k, shape):
        return 1.0 + 0.02 * jax.random.normal(k, shape, jnp.float32)

    return {
        'x': jax.random.normal(ks[0], (BATCH, SEQ, D_MODEL), jnp.float32),
        'mem': jax.random.normal(ks[1], (BATCH, N_MEM, D_MODEL), jnp.float32),
        'attn_norm_g': gain(ks[2], (L, D_MODEL)),
        'mem_norm_g': gain(ks[3], (L, D_MODEL)),
        'w_in': nrm(ks[4], (L, D_MODEL, D_IN), D_MODEL),
        'w_gla_gk': nrm(ks[5], (L, GLA_RANK, GLA_QK_W), GLA_RANK),
        'b_gla_gk': 0.1 * jax.random.normal(ks[6], (L, GLA_QK_W), jnp.float32),
        'gla_out_norm_g': gain(ks[7], (L, GLA_DV)),
        'moba_q_norm_g': gain(ks[8], (L, MOBA_DH)),
        'moba_k_norm_g': gain(ks[9], (L, MOBA_DH)),
        'w_mem_kv': nrm(ks[10], (L, D_MODEL, 2 * MEM_W), D_MODEL),
        'mem_q_norm_g': gain(ks[11], (L, MEM_DH)),
        'mem_k_norm_g': gain(ks[12], (L, MEM_DH)),
        'w_out': nrm(ks[13], (L, D_MIX, D_MODEL), D_MIX),
        'ffn_norm_g': gain(ks[14], (L, D_MODEL)),
        'w_router_group': nrm(ks[15], (L, D_MODEL, N_GROUPS), D_MODEL),
        'b_router_group': 0.01 * jax.random.normal(ks[16], (L, N_GROUPS), jnp.float32),
        'w_router_expert': nrm(ks[17], (L, N_GROUPS, D_MODEL, EXPERTS_PER_GROUP), D_MODEL),
        'b_router_expert': 0.01 * jax.random.normal(ks[18], (L, N_GROUPS, EXPERTS_PER_GROUP), jnp.float32),
        'w_gate': nrm(ks[19], (L, N_EXPERTS, D_MODEL, MOE_FF), D_MODEL),
        'w_up': nrm(ks[20], (L, N_EXPERTS, D_MODEL, MOE_FF), D_MODEL),
        'w_down': nrm(ks[21], (L, N_EXPERTS, MOE_FF, D_MODEL), MOE_FF),
    }


def reference(x, mem, attn_norm_g, mem_norm_g, w_in, w_gla_gk, b_gla_gk, gla_out_norm_g,
              moba_q_norm_g, moba_k_norm_g, w_mem_kv, mem_q_norm_g, mem_k_norm_g, w_out,
              ffn_norm_g, w_router_group, b_router_group, w_router_expert, b_router_expert,
              w_gate, w_up, w_down):
    slopes = alibi_slopes(MOBA_HEADS)
    split_at = np.cumsum(IN_SPLITS)[:-1].tolist()
    for l in range(DEPTH):
        h = rmsnorm(x, attn_norm_g[l])
        proj = jnp.einsum('bsd,de->bse', h, w_in[l])
        gla_q, gla_k, gla_v, gla_r, gla_lr, mb_q, mb_k, mb_v, mem_q = jnp.split(proj, split_at, axis=-1)

        g_log = jax.nn.log_sigmoid((gla_lr @ w_gla_gk[l] + b_gla_gk[l]).astype(jnp.float32)) / GLA_GATE_NORMALIZER
        o_gla = gla_chunked(split_heads(gla_q, GLA_HEADS), split_heads(gla_k, GLA_HEADS),
                            split_heads(gla_v, GLA_HEADS), split_heads(g_log, GLA_HEADS))
        o_gla = rmsnorm(o_gla, gla_out_norm_g[l]).astype(x.dtype)
        o_gla = merge_heads(o_gla) * jax.nn.silu(gla_r)

        q_b = rmsnorm(split_heads(mb_q, MOBA_HEADS), moba_q_norm_g[l])
        k_b = rmsnorm(split_heads(mb_k, MOBA_HEADS), moba_k_norm_g[l])
        v_b = split_heads(mb_v, MOBA_HEADS)
        o_moba = merge_heads(moba_attention(q_b, k_b, v_b, slopes))

        mem_h = rmsnorm(mem, mem_norm_g[l])
        mem_k, mem_v = jnp.split(jnp.einsum('bmd,de->bme', mem_h, w_mem_kv[l]), 2, axis=-1)
        q_c = rmsnorm(split_heads(mem_q, MEM_HEADS), mem_q_norm_g[l])
        k_c = rmsnorm(split_heads(mem_k, MEM_HEADS), mem_k_norm_g[l])
        o_mem = merge_heads(memory_attention(q_c, k_c, split_heads(mem_v, MEM_HEADS)))

        mix = jnp.concatenate([o_gla, o_moba, o_mem], axis=-1)
        x = x + jnp.einsum('bse,ed->bsd', mix, w_out[l])

        x = x + hierarchical_moe(rmsnorm(x, ffn_norm_g[l]), w_router_group[l], b_router_group[l],
                                 w_router_expert[l], b_router_expert[l], w_gate[l], w_up[l], w_down[l])
    return x
```

```cpp
#include <hip/hip_runtime.h>
#include <cstdio>
#include <cstdint>

#define LAS __attribute__((address_space(3)))
#define GAS __attribute__((address_space(1)))
typedef unsigned short bf16_t;
typedef float f32x4 __attribute__((ext_vector_type(4)));
typedef unsigned u32x4 __attribute__((ext_vector_type(4)));
typedef unsigned u32x2 __attribute__((ext_vector_type(2)));

constexpr int T_TOK = 16384, SEQ = 8192, DM = 1024, DIN = 2576, NMEM = 256;
constexpr int PROJ_LD = 2560;
constexpr int C_GQ = 0, C_GK = 256, C_GV = 512, C_GR = 1024, C_MBQ = 1536, C_MBK = 1792, C_MBV = 2048, C_MEMQ = 2304;
constexpr float EPS = 1e-6f;
constexpr float LOG2E = 1.4426950408889634f;
constexpr float C2 = 0.125f * LOG2E;

constexpr size_t MiB = 1u << 20;
constexpr size_t WS_CTL = 0, CTL_ZERO_BYTES = 1 * MiB;
constexpr size_t WS_LR = 1 * MiB;
constexpr size_t WS_MEMKV = 2 * MiB;
constexpr size_t WS_KMEAN = 2 * MiB + 512 * 1024;
constexpr size_t WS_ETOK = 3 * MiB;
constexpr size_t WS_EGATE = 5 * MiB;
constexpr size_t WS_TLOC = 7 * MiB;
constexpr size_t WS_PROJ = 114 * MiB;
constexpr size_t WS_XN = 194 * MiB;
constexpr size_t WS_MIX = 194 * MiB;
constexpr size_t WS_H2 = 114 * MiB;
constexpr size_t WS_G = 242 * MiB;
constexpr size_t WS_END = 266 * MiB;
constexpr int CW_BAR = 4096;
constexpr int CW_ECNT = 8192;

constexpr int LDS_BYTES = 147456;
constexpr int LDSCTL_OFF = 131072;

__device__ __forceinline__ unsigned f2bf(float f) { unsigned u = __builtin_bit_cast(unsigned, f); return (u + 0x7fffu + ((u >> 16) & 1u)) >> 16; }
__device__ __forceinline__ float bf2f(unsigned h) { return __builtin_bit_cast(float, h << 16); }
__device__ __forceinline__ unsigned pk2(float lo, float hi) { return f2bf(lo) | (f2bf(hi) << 16); }
__device__ __forceinline__ float wave_sum(float v) {
#pragma unroll
    for (int o = 1; o < 64; o <<= 1) v += __shfl_xor(v, o);
    return v;
}
__device__ __forceinline__ float silu_f(float x) { return x / (1.f + __expf(-x)); }

#define XB_TMO      128
#define XB_XCNT(j)  (256  + 64 * (j))
#define XB_XSUB(j)  (1280 + 64 * (j))
#define XB_XGEN(j)  (2304 + 64 * (j))
#define XB_TOP      3328
#define XB_TOPGEN   3392
#define XCD_BAR_WORDS 3456
#define XB_SPIN_CAP (1u << 18)
__device__ __forceinline__ unsigned xb_ld(unsigned* p)              { return __hip_atomic_load(p, __ATOMIC_RELAXED, __HIP_MEMORY_SCOPE_AGENT); }
__device__ __forceinline__ unsigned xb_add(unsigned* p, unsigned v) { return __hip_atomic_fetch_add(p, v, __ATOMIC_RELAXED, __HIP_MEMORY_SCOPE_AGENT); }
__device__ __forceinline__ unsigned xb_xcc_id() { return (unsigned)__builtin_amdgcn_s_getreg((3 << 11) | 20) & 0xFu; }
#define XB_SPIN(cond, bar) do { unsigned _sp = 0; while (cond) { __builtin_amdgcn_s_sleep(1); \
    if ((++_sp & 255u) == 0u) { if (xb_ld(&(bar)[XB_TMO])) break; if (_sp > XB_SPIN_CAP) { atomicAdd(&(bar)[XB_TMO], 1u); break; } } } } while (0)
struct XcdBarrier { unsigned* bar; unsigned x; volatile LAS unsigned* st; };
__device__ __forceinline__ XcdBarrier xcd_barrier_post(unsigned* bar, volatile LAS unsigned* st) {
    XcdBarrier b; b.bar = bar; b.x = xb_xcc_id(); b.st = st;
    if (threadIdx.x == 0) (void)xb_add(&bar[XB_XCNT(b.x)], 1u);
    return b;
}
__device__ __forceinline__ void xcd_barrier_complete(unsigned* bar, unsigned x, unsigned& nloc, unsigned& nx) {
    const unsigned G = gridDim.x * gridDim.y * gridDim.z;
    unsigned sum, cnt, mine, sp = 0u;
    for (;;) {
        sum = 0u; cnt = 0u; mine = 0u;
#pragma unroll
        for (unsigned j = 0; j < 16; ++j) { const unsigned c = xb_ld(&bar[XB_XCNT(j)]); sum += c; cnt += (c > 0u) ? 1u : 0u; mine = (j == x) ? c : mine; }
        if (sum == G) break;
        __builtin_amdgcn_s_sleep(1);
        if ((++sp & 255u) == 0u) { if (xb_ld(&bar[XB_TMO])) break; if (sp > XB_SPIN_CAP) { atomicAdd(&bar[XB_TMO], 1u); break; } }
    }
    nloc = mine > 0u ? mine : 1u; nx = cnt > 0u ? cnt : 1u;
}
__device__ __forceinline__ void xcd_barrier(const XcdBarrier& b) {
    asm volatile("s_waitcnt vmcnt(0)" ::: "memory");
    __syncthreads();
    if (threadIdx.x == 0) {
        unsigned* bar = b.bar;
        __builtin_amdgcn_s_waitcnt(0);
        unsigned nloc = b.st[0], nx = b.st[1];
        if (nloc == 0u) { xcd_barrier_complete(bar, b.x, nloc, nx); b.st[0] = nloc; b.st[1] = nx; }
        const unsigned old = xb_add(&bar[XB_XSUB(b.x)], 1u);
        const unsigned gen = old / nloc;
        if (old + 1u == (gen + 1u) * nloc) {
            __builtin_amdgcn_fence(__ATOMIC_RELEASE, "agent");
            asm volatile("s_waitcnt vmcnt(0)" ::: "memory");
            const unsigned og = xb_add(&bar[XB_TOP], 1u);
            const unsigned tg = og / nx;
            if (og + 1u == (tg + 1u) * nx) xb_add(&bar[XB_TOPGEN], 1u);
            else XB_SPIN(xb_ld(&bar[XB_TOPGEN]) == tg, bar);
            __builtin_amdgcn_fence(__ATOMIC_ACQUIRE, "agent");
            xb_add(&bar[XB_XGEN(b.x)], 1u);
            asm volatile("s_waitcnt vmcnt(0)" ::: "memory");
        } else {
            XB_SPIN(xb_ld(&bar[XB_XGEN(b.x)]) == gen, bar);
            __builtin_amdgcn_fence(__ATOMIC_ACQUIRE, "agent");
            asm volatile("s_waitcnt vmcnt(0)" ::: "memory");
        }
    }
    __syncthreads();
}

struct Args {
    const float* in[22];
    float* out; unsigned char* ws;
    int ph_lo, ph_hi;
};
enum { I_X = 0, I_MEM, I_ATTN_G, I_MEM_G, I_WIN, I_WGK, I_BGK, I_GLA_OG, I_MBQ_G, I_MBK_G, I_WMEMKV, I_MEMQ_G, I_MEMK_G, I_WOUT, I_FFN_G,
       I_WRG, I_BRG, I_WRE, I_BRE, I_WGATE, I_WUP, I_WDOWN };

struct Frame {
    LAS unsigned char* lds; int tid, lane, wave, G, bid;
    const float* const* in; float* out; unsigned char* ws; unsigned* ctl;
};

__device__ __forceinline__ void ph_norm_in(Frame& F) {
    bf16_t* XN = (bf16_t*)(F.ws + WS_XN);
    const int gw = F.bid * 8 + F.wave, NGW = F.G * 8;
    for (int r = gw; r < T_TOK + 512; r += NGW) {
        const float* src = r < T_TOK ? F.in[I_X] + (size_t)r * DM : F.in[I_MEM] + (size_t)(r - T_TOK) * DM;
        const float* g = r < T_TOK ? F.in[I_ATTN_G] : F.in[I_MEM_G];
        f32x4 v[4]; float ss = 0.f;
#pragma unroll
        for (int j = 0; j < 4; ++j) { v[j] = ((const f32x4*)src)[F.lane + 64 * j]; ss += v[j].x * v[j].x + v[j].y * v[j].y + v[j].z * v[j].z + v[j].w * v[j].w; }
        const float rstd = rsqrtf(wave_sum(ss) * (1.f / DM) + EPS);
#pragma unroll
        for (int j = 0; j < 4; ++j) { const f32x4 gg = ((const f32x4*)g)[F.lane + 64 * j];
            u32x2 o; o.x = pk2(v[j].x * rstd * gg.x, v[j].y * rstd * gg.y); o.y = pk2(v[j].z * rstd * gg.z, v[j].w * rstd * gg.w);
            ((u32x2*)(XN + (size_t)r * DM))[F.lane + 64 * j] = o; }
    }
}

__device__ __forceinline__ void ph_proj_naive(Frame& F) {
    const bf16_t* XN = (const bf16_t*)(F.ws + WS_XN);
    bf16_t* PROJ = (bf16_t*)(F.ws + WS_PROJ); float* LR = (float*)(F.ws + WS_LR); bf16_t* MEMKV = (bf16_t*)(F.ws + WS_MEMKV);
    LAS float* xs = (LAS float*)F.lds;
    LAS float* rb = (LAS float*)(F.lds + 16384);
    LAS float* rs = (LAS float*)(F.lds + 16384 + 4 * DIN * 4);
    for (int item = F.bid; item < 4096 + 128; item += F.G) {
        const bool main_it = item < 4096;
        const int r0 = main_it ? item * 4 : T_TOK + (item - 4096) * 4;
        for (int i = F.tid; i < 4096; i += 512) xs[i] = bf2f(XN[(size_t)r0 * DM + i]);
        __syncthreads();
        const float* W = main_it ? F.in[I_WIN] : F.in[I_WMEMKV]; const int N = main_it ? DIN : 512;
        for (int c = F.tid; c < N; c += 512) {
            float a0 = 0.f, a1 = 0.f, a2 = 0.f, a3 = 0.f;
            for (int k = 0; k < DM; k += 4) {
                const f32x4 x0 = *(LAS f32x4*)(xs + k), x1 = *(LAS f32x4*)(xs + 1024 + k), x2 = *(LAS f32x4*)(xs + 2048 + k), x3 = *(LAS f32x4*)(xs + 3072 + k);
#pragma unroll
                for (int e = 0; e < 4; ++e) { const float w = W[(size_t)(k + e) * N + c]; a0 += x0[e] * w; a1 += x1[e] * w; a2 += x2[e] * w; a3 += x3[e] * w; }
            }
            rb[c] = a0; rb[DIN + c] = a1; rb[2 * DIN + c] = a2; rb[3 * DIN + c] = a3;
        }
        __syncthreads();
        if (main_it) {
            if (F.tid < 48) { const int j = F.tid / 12, hq = F.tid % 12; const int S = hq < 4 ? 1552 + 64 * hq : hq < 8 ? 1808 + 64 * (hq - 4) : 2320 + 64 * (hq - 8);
                float ss = 0.f; for (int i = 0; i < 64; ++i) { const float v = rb[j * DIN + S + i]; ss += v * v; } rs[F.tid] = rsqrtf(ss * (1.f / 64.f) + EPS); }
            __syncthreads();
            for (int idx = F.tid; idx < 4 * PROJ_LD; idx += 512) {
                const int j = idx / PROJ_LD, L = idx % PROJ_LD; const int S = L < 1536 ? L : L + 16; float v = rb[j * DIN + S];
                if (L < 256) v *= 0.125f;
                else if (L >= C_MBQ && L < C_MBK) v *= rs[j * 12 + (L - C_MBQ) / 64] * F.in[I_MBQ_G][(L - C_MBQ) & 63] * C2;
                else if (L >= C_MBK && L < C_MBV) v *= rs[j * 12 + 4 + (L - C_MBK) / 64] * F.in[I_MBK_G][(L - C_MBK) & 63];
                else if (L >= C_MEMQ) v *= rs[j * 12 + 8 + (L - C_MEMQ) / 64] * F.in[I_MEMQ_G][(L - C_MEMQ) & 63] * C2;
                PROJ[(size_t)(r0 + j) * PROJ_LD + L] = (bf16_t)f2bf(v);
            }
            if (F.tid < 64) { const int j = F.tid / 16, i = F.tid % 16; LR[(size_t)(r0 + j) * 16 + i] = rb[j * DIN + 1536 + i]; }
        } else {
            if (F.tid < 16) { const int j = F.tid / 4, hq = F.tid % 4; float ss = 0.f; for (int i = 0; i < 64; ++i) { const float v = rb[j * DIN + 64 * hq + i]; ss += v * v; } rs[F.tid] = rsqrtf(ss * (1.f / 64.f) + EPS); }
            __syncthreads();
            const int m0 = r0 - T_TOK;
            for (int idx = F.tid; idx < 4 * 512; idx += 512) { const int j = idx / 512, c = idx % 512; float v = rb[j * DIN + c];
                if (c < 256) v *= rs[j * 4 + c / 64] * F.in[I_MEMK_G][c & 63];
                MEMKV[(size_t)(m0 + j) * 512 + c] = (bf16_t)f2bf(v); }
        }
        __syncthreads();
    }
}

__device__ __forceinline__ void ph_kmean_g_naive(Frame& F) {
    const bf16_t* PROJ = (const bf16_t*)(F.ws + WS_PROJ); float* KMEAN = (float*)(F.ws + WS_KMEAN); const float* LR = (const float*)(F.ws + WS_LR); float* Gb = (float*)(F.ws + WS_G);
    const int gt = F.bid * 512 + F.tid, NT = F.G * 512;
    for (int idx = gt; idx < 2 * 4 * 32 * 64; idx += NT) {
        const int d = idx & 63, blk = (idx >> 6) & 31, h = (idx >> 11) & 3, b = idx >> 13; float s = 0.f;
        for (int i = 0; i < 256; ++i) s += bf2f(PROJ[(size_t)(b * SEQ + blk * 256 + i) * PROJ_LD + C_MBK + h * 64 + d]);
        KMEAN[idx] = s * (1.f / 256.f);
    }
    for (int idx = gt; idx < T_TOK * 256; idx += NT) {
        const int t = idx >> 8, c = idx & 255; float z = F.in[I_BGK][c];
#pragma unroll
        for (int i = 0; i < 16; ++i) z += LR[(size_t)t * 16 + i] * F.in[I_WGK][i * 256 + c];
        const float ls = fminf(z, 0.f) - log1pf(__expf(-fabsf(z)));
        Gb[idx] = ls * (1.f / 16.f);
    }
}

__device__ __forceinline__ void attend_naive(const float (&q)[64], float (&o)[64], float& m, float& l, const bf16_t* kp, const bf16_t* vp, int ld, int s0, int s1, int t, float slope2) {
    for (int s = s0; s < s1; ++s) {
        const u32x4* kr = (const u32x4*)(kp + (size_t)s * ld); float sc = 0.f;
#pragma unroll
        for (int c = 0; c < 8; ++c) { const u32x4 w = kr[c];
            sc += q[8 * c + 0] * bf2f(w.x & 0xffffu) + q[8 * c + 1] * bf2f(w.x >> 16) + q[8 * c + 2] * bf2f(w.y & 0xffffu) + q[8 * c + 3] * bf2f(w.y >> 16)
                + q[8 * c + 4] * bf2f(w.z & 0xffffu) + q[8 * c + 5] * bf2f(w.z >> 16) + q[8 * c + 6] * bf2f(w.w & 0xffffu) + q[8 * c + 7] * bf2f(w.w >> 16); }
        sc -= slope2 * (float)(t - s);
        float p;
        if (sc > m) { const float f = exp2f(m - sc); l *= f;
#pragma unroll
            for (int d = 0; d < 64; ++d) o[d] *= f;
            m = sc; p = 1.f; } else p = exp2f(sc - m);
        l += p;
        const u32x4* vr = (const u32x4*)(vp + (size_t)s * ld);
#pragma unroll
        for (int c = 0; c < 8; ++c) { const u32x4 w = vr[c];
            o[8 * c + 0] += p * bf2f(w.x & 0xffffu); o[8 * c + 1] += p * bf2f(w.x >> 16); o[8 * c + 2] += p * bf2f(w.y & 0xffffu); o[8 * c + 3] += p * bf2f(w.y >> 16);
            o[8 * c + 4] += p * bf2f(w.z & 0xffffu); o[8 * c + 5] += p * bf2f(w.z >> 16); o[8 * c + 6] += p * bf2f(w.w & 0xffffu); o[8 * c + 7] += p * bf2f(w.w >> 16); }
    }
}
__device__ __forceinline__ void load_q64(float (&q)[64], const bf16_t* p) {
#pragma unroll
    for (int c = 0; c < 8; ++c) { const u32x4 w = ((const u32x4*)p)[c];
        q[8 * c + 0] = bf2f(w.x & 0xffffu); q[8 * c + 1] = bf2f(w.x >> 16); q[8 * c + 2] = bf2f(w.y & 0xffffu); q[8 * c + 3] = bf2f(w.y >> 16);
        q[8 * c + 4] = bf2f(w.z & 0xffffu); q[8 * c + 5] = bf2f(w.z >> 16); q[8 * c + 6] = bf2f(w.w & 0xffffu); q[8 * c + 7] = bf2f(w.w >> 16); }
}
__device__ __forceinline__ void store_o64(const float (&o)[64], float inv, bf16_t* p) {
#pragma unroll
    for (int c = 0; c < 8; ++c) { u32x4 w; w.x = pk2(o[8 * c] * inv, o[8 * c + 1] * inv); w.y = pk2(o[8 * c + 2] * inv, o[8 * c + 3] * inv); w.z = pk2(o[8 * c + 4] * inv, o[8 * c + 5] * inv); w.w = pk2(o[8 * c + 6] * inv, o[8 * c + 7] * inv);
        ((u32x4*)p)[c] = w; }
}

__device__ __forceinline__ void ph_mixers_naive(Frame& F) {
    const bf16_t* PROJ = (const bf16_t*)(F.ws + WS_PROJ); bf16_t* MIX = (bf16_t*)(F.ws + WS_MIX);
    if (F.bid < 8) {
        const int b = F.bid >> 2, h = F.bid & 3; const float* Gb = (const float*)(F.ws + WS_G);
        LAS float* qs = (LAS float*)F.lds; LAS float* ks = qs + 4096; LAS float* eg = ks + 4096; LAS float* vs = eg + 4096; LAS float* os = vs + 8192;
        float S[64];
#pragma unroll
        for (int d = 0; d < 64; ++d) S[d] = 0.f;
        for (int n = 0; n < 128; ++n) {
            const int t0 = b * SEQ + 64 * n;
            for (int i = F.tid; i < 4096; i += 512) { const int c = i >> 6, d = i & 63; const size_t row = (size_t)(t0 + c) * PROJ_LD;
                qs[i] = bf2f(PROJ[row + C_GQ + h * 64 + d]); ks[i] = bf2f(PROJ[row + C_GK + h * 64 + d]); eg[i] = __expf(Gb[(size_t)(t0 + c) * 256 + h * 64 + d]); }
            for (int i = F.tid; i < 8192; i += 512) { const int c = i >> 7, v = i & 127; vs[i] = bf2f(PROJ[(size_t)(t0 + c) * PROJ_LD + C_GV + h * 128 + v]); }
            __syncthreads();
            if (F.tid < 128) {
                for (int c = 0; c < 64; ++c) { const float vv = vs[c * 128 + F.tid]; float o = 0.f;
#pragma unroll
                    for (int d = 0; d < 64; ++d) { S[d] = S[d] * eg[c * 64 + d] + ks[c * 64 + d] * vv; o += qs[c * 64 + d] * S[d]; }
                    os[c * 128 + F.tid] = o; }
            }
            __syncthreads();
            for (int rr = 0; rr < 8; ++rr) { const int c = F.wave * 8 + rr; const float o0 = os[c * 128 + F.lane], o1 = os[c * 128 + 64 + F.lane];
                const float rstd = rsqrtf(wave_sum(o0 * o0 + o1 * o1) * (1.f / 128.f) + EPS); const size_t row = (size_t)(t0 + c);
                const float r0 = bf2f(PROJ[row * PROJ_LD + C_GR + h * 128 + F.lane]), r1 = bf2f(PROJ[row * PROJ_LD + C_GR + h * 128 + 64 + F.lane]);
                MIX[row * DM + h * 128 + F.lane] = (bf16_t)f2bf(o0 * rstd * F.in[I_GLA_OG][F.lane] * silu_f(r0));
                MIX[row * DM + h * 128 + 64 + F.lane] = (bf16_t)f2bf(o1 * rstd * F.in[I_GLA_OG][64 + F.lane] * silu_f(r1)); }
            __syncthreads();
        }
    } else {
        const float* KMEAN = (const float*)(F.ws + WS_KMEAN); const bf16_t* MEMKV = (const bf16_t*)(F.ws + WS_MEMKV);
        const int gt = (F.bid - 8) * 512 + F.tid, NT = (F.G - 8) * 512;
        for (int gi = gt; gi < 2 * 65536; gi += NT) {
            const bool moba = gi < 65536; const int g2 = gi & 65535; const int t = g2 & 8191, h = (g2 >> 13) & 3, b = g2 >> 15;
            const size_t row = (size_t)(b * SEQ + t);
            float q[64], o[64]; float m = -INFINITY, l = 0.f;
#pragma unroll
            for (int d = 0; d < 64; ++d) o[d] = 0.f;
            if (moba) {
                load_q64(q, PROJ + row * PROJ_LD + C_MBQ + h * 64);
                const int own = t >> 8; float b0 = -INFINITY, b1 = -INFINITY, b2 = -INFINITY; int i0 = 0, i1 = 0, i2 = 0;
                for (int j = 0; j < own; ++j) { const float* km = KMEAN + ((b * 4 + h) * 32 + j) * 64; float gsc = 0.f;
#pragma unroll
                    for (int d = 0; d < 64; ++d) gsc += q[d] * km[d];
                    if (gsc > b0) { b2 = b1; i2 = i1; b1 = b0; i1 = i0; b0 = gsc; i0 = j; } else if (gsc > b1) { b2 = b1; i2 = i1; b1 = gsc; i1 = j; } else if (gsc > b2) { b2 = gsc; i2 = j; } }
                const int nsel = own < 3 ? own : 3; const float slope2 = exp2f(-2.f * (float)(h + 1)) * LOG2E;
                const bf16_t* kp = PROJ + (size_t)(b * SEQ) * PROJ_LD + C_MBK + h * 64; const bf16_t* vp = PROJ + (size_t)(b * SEQ) * PROJ_LD + C_MBV + h * 64;
                if (nsel > 0) attend_naive(q, o, m, l, kp, vp, PROJ_LD, i0 * 256, i0 * 256 + 256, t, slope2);
                if (nsel > 1) attend_naive(q, o, m, l, kp, vp, PROJ_LD, i1 * 256, i1 * 256 + 256, t, slope2);
                if (nsel > 2) attend_naive(q, o, m, l, kp, vp, PROJ_LD, i2 * 256, i2 * 256 + 256, t, slope2);
                attend_naive(q, o, m, l, kp, vp, PROJ_LD, own * 256, t + 1, t, slope2);
                store_o64(o, 1.f / l, MIX + row * DM + 512 + h * 64);
            } else {
                load_q64(q, PROJ + row * PROJ_LD + C_MEMQ + h * 64);
                attend_naive(q, o, m, l, MEMKV + (size_t)(b * NMEM) * 512 + h * 64, MEMKV + (size_t)(b * NMEM) * 512 + 256 + h * 64, 512, 0, NMEM, 0, 0.f);
                store_o64(o, 1.f / l, MIX + row * DM + 768 + h * 64);
            }
        }
    }
}

__device__ __forceinline__ void ph_outproj_naive(Frame& F) {
    const bf16_t* MIX = (const bf16_t*)(F.ws + WS_MIX); const float* W = F.in[I_WOUT];
    LAS float* xs = (LAS float*)F.lds;
    for (int item = F.bid; item < 4096; item += F.G) {
        const int r0 = item * 4;
        for (int i = F.tid; i < 4096; i += 512) xs[i] = bf2f(MIX[(size_t)r0 * DM + i]);
        __syncthreads();
        for (int c = F.tid; c < DM; c += 512) {
            float a0 = 0.f, a1 = 0.f, a2 = 0.f, a3 = 0.f;
            for (int k = 0; k < DM; k += 4) {
                const f32x4 x0 = *(LAS f32x4*)(xs + k), x1 = *(LAS f32x4*)(xs + 1024 + k), x2 = *(LAS f32x4*)(xs + 2048 + k), x3 = *(LAS f32x4*)(xs + 3072 + k);
#pragma unroll
                for (int e = 0; e < 4; ++e) { const float w = W[(size_t)(k + e) * DM + c]; a0 += x0[e] * w; a1 += x1[e] * w; a2 += x2[e] * w; a3 += x3[e] * w; }
            }
            F.out[(size_t)(r0 + 0) * DM + c] = F.in[I_X][(size_t)(r0 + 0) * DM + c] + a0; F.out[(size_t)(r0 + 1) * DM + c] = F.in[I_X][(size_t)(r0 + 1) * DM + c] + a1;
            F.out[(size_t)(r0 + 2) * DM + c] = F.in[I_X][(size_t)(r0 + 2) * DM + c] + a2; F.out[(size_t)(r0 + 3) * DM + c] = F.in[I_X][(size_t)(r0 + 3) * DM + c] + a3;
        }
        __syncthreads();
    }
}

__device__ __forceinline__ void ph_router(Frame& F) {
    bf16_t* H2 = (bf16_t*)(F.ws + WS_H2); unsigned* ETOK = (unsigned*)(F.ws + WS_ETOK); float* EGATE = (float*)(F.ws + WS_EGATE); unsigned* TLOC = (unsigned*)(F.ws + WS_TLOC);
    unsigned* ECNT = F.ctl + CW_ECNT;
    const int gw = F.bid * 8 + F.wave, NGW = F.G * 8;
    for (int t = gw; t < T_TOK; t += NGW) {
        f32x4 v[4]; float ss = 0.f;
#pragma unroll
        for (int j = 0; j < 4; ++j) { v[j] = ((const f32x4*)(F.out + (size_t)t * DM))[F.lane + 64 * j]; ss += v[j].x * v[j].x + v[j].y * v[j].y + v[j].z * v[j].z + v[j].w * v[j].w; }
        const float rstd = rsqrtf(wave_sum(ss) * (1.f / DM) + EPS);
        float lg[4] = {0.f, 0.f, 0.f, 0.f};
#pragma unroll
        for (int j = 0; j < 4; ++j) { const f32x4 gg = ((const f32x4*)F.in[I_FFN_G])[F.lane + 64 * j]; v[j] = v[j] * rstd * gg;
            u32x2 o; o.x = pk2(v[j].x, v[j].y); o.y = pk2(v[j].z, v[j].w); ((u32x2*)(H2 + (size_t)t * DM))[F.lane + 64 * j] = o;
#pragma unroll
            for (int e = 0; e < 4; ++e) { const f32x4 w = ((const f32x4*)F.in[I_WRG])[4 * (F.lane + 64 * j) + e];
                lg[0] += v[j][e] * w.x; lg[1] += v[j][e] * w.y; lg[2] += v[j][e] * w.z; lg[3] += v[j][e] * w.w; } }
#pragma unroll
        for (int i = 0; i < 4; ++i) lg[i] = wave_sum(lg[i]) + F.in[I_BRG][i];
        int gs = 0; float gm = lg[0];
#pragma unroll
        for (int i = 1; i < 4; ++i) if (lg[i] > gm) { gm = lg[i]; gs = i; }
        float den = 0.f;
#pragma unroll
        for (int i = 0; i < 4; ++i) den += __expf(lg[i] - gm);
        const float pg = 1.f / den;
        float le[8];
#pragma unroll
        for (int i = 0; i < 8; ++i) le[i] = 0.f;
        const float* wre = F.in[I_WRE] + (size_t)gs * DM * 8;
#pragma unroll
        for (int j = 0; j < 4; ++j)
#pragma unroll
            for (int e = 0; e < 4; ++e) { const int d = 4 * (F.lane + 64 * j) + e; const f32x4 w0 = ((const f32x4*)wre)[2 * d], w1 = ((const f32x4*)wre)[2 * d + 1];
                le[0] += v[j][e] * w0.x; le[1] += v[j][e] * w0.y; le[2] += v[j][e] * w0.z; le[3] += v[j][e] * w0.w; le[4] += v[j][e] * w1.x; le[5] += v[j][e] * w1.y; le[6] += v[j][e] * w1.z; le[7] += v[j][e] * w1.w; }
#pragma unroll
        for (int i = 0; i < 8; ++i) le[i] = wave_sum(le[i]) + F.in[I_BRE][gs * 8 + i];
        int i0 = 0; float m0 = le[0];
#pragma unroll
        for (int i = 1; i < 8; ++i) if (le[i] > m0) { m0 = le[i]; i0 = i; }
        int i1 = -1; float m1 = -INFINITY;
#pragma unroll
        for (int i = 0; i < 8; ++i) if (i != i0 && le[i] > m1) { m1 = le[i]; i1 = i; }
        const float w0 = 1.f / (1.f + __expf(m1 - m0)), w1 = 1.f - w0;
        if (F.lane == 0) {
            const int e0 = gs * 8 + i0, e1 = gs * 8 + i1;
            const unsigned p0 = atomicAdd(&ECNT[e0], 1u), p1 = atomicAdd(&ECNT[e1], 1u);
            ETOK[e0 * T_TOK + p0] = (unsigned)t; EGATE[e0 * T_TOK + p0] = pg * w0; ETOK[e1 * T_TOK + p1] = (unsigned)t; EGATE[e1 * T_TOK + p1] = pg * w1;
            TLOC[t * 2] = ((unsigned)e0 << 16) | p0; TLOC[t * 2 + 1] = ((unsigned)e1 << 16) | p1;
        }
    }
}

__device__ __forceinline__ void ph_experts_naive(Frame& F) {
    const bf16_t* H2 = (const bf16_t*)(F.ws + WS_H2); const unsigned* ETOK = (const unsigned*)(F.ws + WS_ETOK); const float* EGATE = (const float*)(F.ws + WS_EGATE);
    LAS float* hs = (LAS float*)F.lds; LAS float* hid = hs + 4096; LAS int* pre = (LAS int*)(hid + 2048); LAS int* itk = pre + 40;
    if (F.tid == 0) { int a = 0; for (int e = 0; e < 32; ++e) { pre[e] = a; a += ((int)xb_ld(F.ctl + CW_ECNT + e) + 3) / 4; } pre[32] = a; }
    __syncthreads();
    const int total = pre[32];
    for (int item = F.bid; item < total; item += F.G) {
        int e = 0; while (pre[e + 1] <= item) ++e;
        const int grp = item - pre[e]; const int ne = (int)xb_ld(F.ctl + CW_ECNT + e);
        __syncthreads();
        if (F.tid < 4) { const int pos = grp * 4 + F.tid; itk[F.tid] = pos < ne ? (int)ETOK[e * T_TOK + pos] : -1; }
        __syncthreads();
        for (int i = F.tid; i < 4096; i += 512) { const int j = i >> 10, tk = itk[j]; hs[i] = tk >= 0 ? bf2f(H2[(size_t)tk * DM + (i & 1023)]) : 0.f; }
        __syncthreads();
        {
            const float* wg = F.in[I_WGATE] + (size_t)e * DM * 512 + F.tid; const float* wu = F.in[I_WUP] + (size_t)e * DM * 512 + F.tid;
            float g0 = 0.f, g1 = 0.f, g2 = 0.f, g3 = 0.f, u0 = 0.f, u1 = 0.f, u2 = 0.f, u3 = 0.f;
            for (int k = 0; k < DM; k += 4) {
                const f32x4 x0 = *(LAS f32x4*)(hs + k), x1 = *(LAS f32x4*)(hs + 1024 + k), x2 = *(LAS f32x4*)(hs + 2048 + k), x3 = *(LAS f32x4*)(hs + 3072 + k);
#pragma unroll
                for (int q = 0; q < 4; ++q) { const float a = wg[(size_t)(k + q) * 512], c = wu[(size_t)(k + q) * 512];
                    g0 += x0[q] * a; g1 += x1[q] * a; g2 += x2[q] * a; g3 += x3[q] * a; u0 += x0[q] * c; u1 += x1[q] * c; u2 += x2[q] * c; u3 += x3[q] * c; }
            }
            hid[F.tid] = bf2f(f2bf(silu_f(g0) * u0)); hid[512 + F.tid] = bf2f(f2bf(silu_f(g1) * u1)); hid[1024 + F.tid] = bf2f(f2bf(silu_f(g2) * u2)); hid[1536 + F.tid] = bf2f(f2bf(silu_f(g3) * u3));
        }
        __syncthreads();
        for (int c = F.tid; c < DM; c += 512) {
            const float* wd = F.in[I_WDOWN] + (size_t)e * 512 * DM + c; float y0 = 0.f, y1 = 0.f, y2 = 0.f, y3 = 0.f;
            for (int i = 0; i < 512; i += 4) {
                const f32x4 h0 = *(LAS f32x4*)(hid + i), h1 = *(LAS f32x4*)(hid + 512 + i), h2 = *(LAS f32x4*)(hid + 1024 + i), h3 = *(LAS f32x4*)(hid + 1536 + i);
#pragma unroll
                for (int q = 0; q < 4; ++q) { const float w = wd[(size_t)(i + q) * DM]; y0 += h0[q] * w; y1 += h1[q] * w; y2 += h2[q] * w; y3 += h3[q] * w; }
            }
            const float yy[4] = {y0, y1, y2, y3};
#pragma unroll
            for (int j = 0; j < 4; ++j) { const int tk = itk[j]; if (tk >= 0) atomicAdd(&F.out[(size_t)tk * DM + c], EGATE[e * T_TOK + grp * 4 + j] * yy[j]); }
        }
    }
}

__global__ void __launch_bounds__(512, 2) fwd(Args args) {
    extern __shared__ __attribute__((aligned(16))) unsigned char lds_raw[];
    Frame F;
    F.lds = (LAS unsigned char*)lds_raw; F.tid = threadIdx.x; F.lane = F.tid & 63; F.wave = __builtin_amdgcn_readfirstlane(F.tid >> 6);
    F.G = gridDim.x; F.bid = blockIdx.x; F.in = args.in; F.out = args.out; F.ws = args.ws; F.ctl = (unsigned*)(args.ws + WS_CTL);
    for (int u = F.tid; u < (LDS_BYTES - LDSCTL_OFF) / 4; u += 512) ((LAS unsigned*)(F.lds + LDSCTL_OFF))[u] = 0u;
    __syncthreads();
    XcdBarrier bar = xcd_barrier_post(F.ctl + CW_BAR, (volatile LAS unsigned*)(F.lds + LDSCTL_OFF + 32));
    const int lo = args.ph_lo, hi = args.ph_hi;
#define IN(k) (lo <= (k) && (k) < hi)
#define SEAM(k) do { if (IN(k) && IN((k) + 1)) xcd_barrier(bar); } while (0)
    if (IN(0)) ph_norm_in(F);
    SEAM(0);
    if (IN(1)) ph_proj_naive(F);
    SEAM(1);
    if (IN(2)) ph_kmean_g_naive(F);
    SEAM(2);
    if (IN(3)) ph_mixers_naive(F);
    SEAM(3);
    if (IN(4)) ph_outproj_naive(F);
    SEAM(4);
    if (IN(5)) ph_router(F);
    SEAM(5);
    if (IN(6)) ph_experts_naive(F);
#undef IN
#undef SEAM
}

extern "C" void kernel_launch(void* const* d_in, const int* in_sizes, int n_in, void* d_out, int out_size, void* d_ws, size_t ws_size, hipStream_t stream) {
    static int grid = 0;
    if (grid == 0) {
        if (n_in != 22 || out_size != T_TOK * DM || ws_size < WS_END) { fprintf(stderr, "kernel_launch: unexpected shapes (n_in %d, out %d, ws %zu)\n", n_in, out_size, ws_size); grid = -1; return; }
        int dev = 0, cus = 0;
        if (hipGetDevice(&dev) != hipSuccess || hipDeviceGetAttribute(&cus, hipDeviceAttributeMultiprocessorCount, dev) != hipSuccess) { grid = -1; return; }
        if (hipFuncSetAttribute((const void*)fwd, hipFuncAttributeMaxDynamicSharedMemorySize, LDS_BYTES) != hipSuccess) { grid = -1; return; }
        int per_cu = 0;
        (void)hipOccupancyMaxActiveBlocksPerMultiprocessor(&per_cu, (const void*)fwd, 512, LDS_BYTES);
        (void)hipGetLastError();
        grid = cus;
    }
    if (grid < 0) return;
    (void)hipMemsetAsync((char*)d_ws + WS_CTL, 0, CTL_ZERO_BYTES, stream);
    Args a{};
    for (int i = 0; i < 22; ++i) a.in[i] = (const float*)d_in[i];
    a.out = (float*)d_out; a.ws = (unsigned char*)d_ws; a.ph_lo = 0; a.ph_hi = 7;
    hipLaunchKernelGGL(fwd, dim3(grid), dim3(512), LDS_BYTES, stream, a);
}
```

```cpp
#include <hip/hip_runtime.h>
#include <cstdio>
#include <cstdint>

#define LAS __attribute__((address_space(3)))
#define GAS __attribute__((address_space(1)))
typedef unsigned short bf16_t;
typedef float f32x4 __attribute__((ext_vector_type(4)));
typedef unsigned u32x4 __attribute__((ext_vector_type(4)));
typedef unsigned u32x2 __attribute__((ext_vector_type(2)));

constexpr int T_TOK = 16384, SEQ = 8192, DM = 1024, DIN = 2576, NMEM = 256;
constexpr int PROJ_LD = 2560;
constexpr int C_GQ = 0, C_GK = 256, C_GV = 512, C_GR = 1024, C_MBQ = 1536, C_MBK = 1792, C_MBV = 2048, C_MEMQ = 2304;
constexpr float EPS = 1e-6f;
constexpr float LOG2E = 1.4426950408889634f;
constexpr float C2 = 0.125f * LOG2E;

constexpr size_t MiB = 1u << 20;
constexpr size_t WS_CTL = 0, CTL_ZERO_BYTES = 1 * MiB;
constexpr size_t WS_LR = 1 * MiB;
constexpr size_t WS_MEMKV = 2 * MiB;
constexpr size_t WS_ETOK = 3 * MiB;
constexpr size_t WS_EGATE = 5 * MiB;
constexpr size_t WS_TLOC = 7 * MiB;
constexpr size_t WS_WOUT_T = 16 * MiB;
constexpr size_t WS_WGU_T = 18 * MiB;
constexpr size_t WS_WD_T = 82 * MiB;
constexpr size_t WS_WIN_T = 227 * MiB;
constexpr size_t WS_PROJ = 114 * MiB;
constexpr size_t WS_XN = 194 * MiB;
constexpr size_t WS_MIX = 194 * MiB;
constexpr size_t WS_H2 = 114 * MiB;
constexpr size_t WS_HID = 146 * MiB;
constexpr size_t WS_YBUF = 186 * MiB;
constexpr size_t WS_G = 242 * MiB;
constexpr size_t WS_END = 266 * MiB;
constexpr int CW_BAR = 4096;
constexpr int CW_ECNT = 8192;
constexpr int CW_KMEAN = 16384;

constexpr int LDS_BYTES = 147456;
constexpr int LDSCTL_OFF = 131072;

__device__ __forceinline__ unsigned f2bf(float f) { unsigned u = __builtin_bit_cast(unsigned, f); return (u + 0x7fffu + ((u >> 16) & 1u)) >> 16; }
__device__ __forceinline__ float bf2f(unsigned h) { return __builtin_bit_cast(float, h << 16); }
__device__ __forceinline__ unsigned pk2(float lo, float hi) { return f2bf(lo) | (f2bf(hi) << 16); }
__device__ __forceinline__ float wave_sum(float v) {
#pragma unroll
    for (int o = 1; o < 64; o <<= 1) v += __shfl_xor(v, o);
    return v;
}
__device__ __forceinline__ float silu_f(float x) { return x / (1.f + __expf(-x)); }

#define XB_TMO      128
#define XB_XCNT(j)  (256  + 64 * (j))
#define XB_XSUB(j)  (1280 + 64 * (j))
#define XB_XGEN(j)  (2304 + 64 * (j))
#define XB_TOP      3328
#define XB_TOPGEN   3392
#define XCD_BAR_WORDS 3456
#define XB_SPIN_CAP (1u << 18)
__device__ __forceinline__ unsigned xb_ld(unsigned* p)              { return __hip_atomic_load(p, __ATOMIC_RELAXED, __HIP_MEMORY_SCOPE_AGENT); }
__device__ __forceinline__ unsigned xb_add(unsigned* p, unsigned v) { return __hip_atomic_fetch_add(p, v, __ATOMIC_RELAXED, __HIP_MEMORY_SCOPE_AGENT); }
__device__ __forceinline__ unsigned xb_xcc_id() { return (unsigned)__builtin_amdgcn_s_getreg((3 << 11) | 20) & 0xFu; }
#define XB_SPIN(cond, bar) do { unsigned _sp = 0; while (cond) { __builtin_amdgcn_s_sleep(1); \
    if ((++_sp & 255u) == 0u) { if (xb_ld(&(bar)[XB_TMO])) break; if (_sp > XB_SPIN_CAP) { atomicAdd(&(bar)[XB_TMO], 1u); break; } } } } while (0)
struct XcdBarrier { unsigned* bar; unsigned x; volatile LAS unsigned* st; };
__device__ __forceinline__ XcdBarrier xcd_barrier_post(unsigned* bar, volatile LAS unsigned* st) {
    XcdBarrier b; b.bar = bar; b.x = xb_xcc_id(); b.st = st;
    if (threadIdx.x == 0) (void)xb_add(&bar[XB_XCNT(b.x)], 1u);
    return b;
}
__device__ __forceinline__ void xcd_barrier_complete(unsigned* bar, unsigned x, unsigned& nloc, unsigned& nx) {
    const unsigned G = gridDim.x * gridDim.y * gridDim.z;
    unsigned sum, cnt, mine, sp = 0u;
    for (;;) {
        sum = 0u; cnt = 0u; mine = 0u;
#pragma unroll
        for (unsigned j = 0; j < 16; ++j) { const unsigned c = xb_ld(&bar[XB_XCNT(j)]); sum += c; cnt += (c > 0u) ? 1u : 0u; mine = (j == x) ? c : mine; }
        if (sum == G) break;
        __builtin_amdgcn_s_sleep(1);
        if ((++sp & 255u) == 0u) { if (xb_ld(&bar[XB_TMO])) break; if (sp > XB_SPIN_CAP) { atomicAdd(&bar[XB_TMO], 1u); break; } }
    }
    nloc = mine > 0u ? mine : 1u; nx = cnt > 0u ? cnt : 1u;
}
__device__ __forceinline__ void xcd_barrier(const XcdBarrier& b) {
    asm volatile("s_waitcnt vmcnt(0)" ::: "memory");
    __syncthreads();
    if (threadIdx.x == 0) {
        unsigned* bar = b.bar;
        __builtin_amdgcn_s_waitcnt(0);
        unsigned nloc = b.st[0], nx = b.st[1];
        if (nloc == 0u) { xcd_barrier_complete(bar, b.x, nloc, nx); b.st[0] = nloc; b.st[1] = nx; }
        const unsigned old = xb_add(&bar[XB_XSUB(b.x)], 1u);
        const unsigned gen = old / nloc;
        if (old + 1u == (gen + 1u) * nloc) {
            __builtin_amdgcn_fence(__ATOMIC_RELEASE, "agent");
            asm volatile("s_waitcnt vmcnt(0)" ::: "memory");
            const unsigned og = xb_add(&bar[XB_TOP], 1u);
            const unsigned tg = og / nx;
            if (og + 1u == (tg + 1u) * nx) xb_add(&bar[XB_TOPGEN], 1u);
            else XB_SPIN(xb_ld(&bar[XB_TOPGEN]) == tg, bar);
            __builtin_amdgcn_fence(__ATOMIC_ACQUIRE, "agent");
            xb_add(&bar[XB_XGEN(b.x)], 1u);
            asm volatile("s_waitcnt vmcnt(0)" ::: "memory");
        } else {
            XB_SPIN(xb_ld(&bar[XB_XGEN(b.x)]) == gen, bar);
            __builtin_amdgcn_fence(__ATOMIC_ACQUIRE, "agent");
            asm volatile("s_waitcnt vmcnt(0)" ::: "memory");
        }
    }
    __syncthreads();
}

namespace pg8 {
#define PG8_LAS __attribute__((address_space(3)))
typedef unsigned short bf16_t;
typedef short bf16x8 __attribute__((ext_vector_type(8)));
typedef float f32x4 __attribute__((ext_vector_type(4)));
typedef unsigned u32x4 __attribute__((ext_vector_type(4)));
constexpr int BM = 256, BK = 64, HALF = 128, HTB = HALF * BK * 2  , STAGE_BYTES = 8 * HTB, NXCD = 8, WGM = 8;

__host__ __device__ __forceinline__ int lds_byte(int r, int c) { const int st = (r >> 4) * 2 + (c >> 5), rr = r & 15, cc = c & 31, ob = rr * 64 + cc * 2; return st * 1024 + (ob ^ (((ob >> 9) & 1) << 5)); }
__host__ __device__ __forceinline__ void stage_rc(int b, int& R, int& C) { const int st = b / 1024, sb = b % 1024, swz = sb ^ (((sb >> 9) & 1) << 5); R = (st >> 1) * 16 + swz / 64; C = (st & 1) * 32 + (swz % 64) / 2; }
__host__ __device__ __forceinline__ int perm32(int rho) { const int n = rho >> 4, i = rho & 15; return 8 * (i >> 2) + 4 * n + (i & 3); }

struct Unit { int pm, pn, aux; };
struct Gemm { const bf16_t* A; const bf16_t* Bt; int M, N, K; };

struct StaticOrder {
    int nM, nN, nwg, G, c;
    __host__ __device__ void init(int M, int N, int G_, int c_) { nM = M / BM; nN = N / BM; nwg = nM * nN; G = G_; c = c_; }
    __host__ __device__ bool next(int i, Unit& u) const {
        const long L = (long)i * G + c; if (L >= nwg) return false;
        int wgid = (int)L; { const int q = nwg / NXCD, r = nwg % NXCD, xcd = wgid % NXCD, off = wgid / NXCD; wgid = (xcd < r ? xcd * (q + 1) : r * (q + 1) + (xcd - r) * q) + off; }
        const int nig = WGM * nN, gid = wgid / nig, fm = gid * WGM, gsz = (nM - fm) < WGM ? (nM - fm) : WGM;
        u.pm = fm + ((wgid % nig) % gsz); u.pn = (wgid % nig) / gsz; u.aux = 0; return true;
    }
    __device__ __forceinline__ void a_ready(const Unit&) const {}
    __device__ __forceinline__ void done(const Unit&) const {}
};

__device__ __forceinline__ unsigned cvt_pk_bf16(float lo, float hi) { unsigned r; asm volatile("v_cvt_pk_bf16_f32 %0, %1, %2" : "=v"(r) : "v"(lo), "v"(hi)); return r; }
typedef float f32x2 __attribute__((ext_vector_type(2)));

template <class Epi, class Sched, bool ALIGN_EPI = false, bool SP2 = false>
__device__ __forceinline__ void gemm_phase(PG8_LAS unsigned char* lds, const Gemm g, const Sched& S, const Epi& E) {
    const int tid = threadIdx.x, wid = __builtin_amdgcn_readfirstlane(tid >> 6), lane = tid & 63, wr = wid >> 2, wc = wid & 3, fr = lane & 15, fq = lane >> 4;
    const int K = g.K, nt = K / BK;
    unsigned voffA[2], voffB[2];
#pragma unroll
    for (int i = 0; i < 2; ++i) { int R, C; stage_rc(tid * 16 + i * 8192, R, C); const int Rb = Epi::PERM ? ((R & ~31) + perm32(R & 31)) : R;
        voffA[i] = (unsigned)(R * K + C) * 2u; voffB[i] = (unsigned)(Rb * K + C) * 2u; }
    const size_t kstep = (size_t)(BK * 2);
    const size_t hstep = (size_t)HALF * K * 2;
    const size_t tstep = 2 * hstep;
    const unsigned ldsw = (unsigned)wid * 1024u;
    const int aoff = lds_byte(wr * 64 + fr, fq * 8), boff = lds_byte(wc * 32 + fr, fq * 8);
#define PG8_SA(b, h) (((b) * 2 + (h)) * HTB)
#define PG8_SB(b, h) ((4 + (b) * 2 + (h)) * HTB)
#define PG8_STAGE(bufoff, gbase, voff) do { _Pragma("unroll") for (int _i = 0; _i < 2; ++_i) \
        __builtin_amdgcn_global_load_lds((const unsigned*)((const char*)(gbase) + (voff)[_i]), (PG8_LAS unsigned*)(lds + (bufoff) + ldsw + _i * 8192), 16, 0, 0); } while (0)
#define PG8_LDA(dst, b, h) do { _Pragma("unroll") for (int m = 0; m < 4; ++m) _Pragma("unroll") for (int k = 0; k < 2; ++k) dst[m][k] = *(const PG8_LAS bf16x8*)(lds + PG8_SA(b, h) + aoff + m * 2048 + k * 1024); } while (0)
#define PG8_LDB(dst, b, h) do { _Pragma("unroll") for (int n = 0; n < 2; ++n) _Pragma("unroll") for (int k = 0; k < 2; ++k) dst[n][k] = *(const PG8_LAS bf16x8*)(lds + PG8_SB(b, h) + boff + n * 2048 + k * 1024); } while (0)
#define PG8_MMA(ai, bj, At, Bt) do { __builtin_amdgcn_s_setprio(1); _Pragma("unroll") for (int m = 0; m < 4; ++m) _Pragma("unroll") for (int n = 0; n < 2; ++n) _Pragma("unroll") for (int k = 0; k < 2; ++k) \
        acc[ai][bj][m][n] = __builtin_amdgcn_mfma_f32_16x16x32_bf16(Bt[n][k], At[m][k], acc[ai][bj][m][n], 0, 0, 0); __builtin_amdgcn_s_setprio(0); } while (0)
#define PG8_WAIT_V(n) asm volatile("s_waitcnt vmcnt(" #n ")" ::: "memory")
#define PG8_WAIT_L(n) asm volatile("s_waitcnt lgkmcnt(" #n ")" ::: "memory")
#define PG8_BAR __builtin_amdgcn_s_barrier()
#define PG8_SCHED __builtin_amdgcn_sched_barrier(0)
    Unit cur, nxt; int ui = 0;
    if (!S.next(0, cur)) return;
    f32x4 acc[2][2][4][2];
#pragma unroll
    for (int a = 0; a < 2; ++a)
#pragma unroll
        for (int b = 0; b < 2; ++b)
#pragma unroll
            for (int m = 0; m < 4; ++m)
#pragma unroll
                for (int n = 0; n < 2; ++n) acc[a][b][m][n] = (f32x4){0.f, 0.f, 0.f, 0.f};
    bf16x8 At[4][2], B0[2][2], B1[2][2];
    const char* cA = (const char*)g.A + (size_t)cur.pm * tstep; const char* cB = (const char*)g.Bt + (size_t)cur.pn * tstep;
    S.a_ready(cur);
    if constexpr (SP2) {
        PG8_STAGE(PG8_SB(0, 0), cB, voffB); PG8_STAGE(PG8_SB(0, 1), cB + hstep, voffB); PG8_STAGE(PG8_SA(0, 0), cA, voffA); PG8_STAGE(PG8_SA(0, 1), cA + hstep, voffA);
        if (wr == 1) PG8_BAR;
        PG8_WAIT_V(2); PG8_BAR;
        PG8_STAGE(PG8_SB(1, 0), cB + kstep, voffB); PG8_STAGE(PG8_SA(1, 0), cA + kstep, voffA); PG8_STAGE(PG8_SB(1, 1), cB + hstep + kstep, voffB);
        PG8_WAIT_V(6); PG8_BAR;
    } else {
        PG8_STAGE(PG8_SB(0, 0), cB, voffB); PG8_STAGE(PG8_SA(0, 0), cA, voffA); PG8_STAGE(PG8_SB(0, 1), cB + hstep, voffB); PG8_STAGE(PG8_SA(0, 1), cA + hstep, voffA);
        if (wr == 1) PG8_BAR;
        PG8_WAIT_V(4); PG8_BAR;
        PG8_STAGE(PG8_SB(1, 0), cB + kstep, voffB); PG8_STAGE(PG8_SA(1, 0), cA + kstep, voffA); PG8_STAGE(PG8_SB(1, 1), cB + hstep + kstep, voffB);
        PG8_WAIT_V(6); PG8_BAR;
    }
    for (;;) {
        const bool has_next = S.next(ui + 1, nxt);
        const char* nA = has_next ? (const char*)g.A + (size_t)nxt.pm * tstep : cA; const char* nB = has_next ? (const char*)g.Bt + (size_t)nxt.pn * tstep : cB;
        for (int t = 0; t < nt; t += 2) {
            const bool last = (t == nt - 2);
            const char* a1 = cA + (size_t)(t + 1) * kstep;
            const char* a2 = last ? nA : cA + (size_t)(t + 2) * kstep; const char* b2 = last ? nB : cB + (size_t)(t + 2) * kstep;
            const char* a3 = a2 + kstep; const char* b3 = b2 + kstep;
            if (last && has_next) S.a_ready(nxt);
            if constexpr (SP2) {
            PG8_LDB(B0, 0, 0); PG8_LDB(B1, 0, 1); PG8_SCHED; PG8_LDA(At, 0, 0); PG8_STAGE(PG8_SA(1, 1), a1 + hstep, voffA);
            PG8_WAIT_V(8); PG8_WAIT_L(0); PG8_BAR; PG8_MMA(0, 0, At, B0); PG8_MMA(0, 1, At, B1); PG8_BAR; PG8_SCHED;
            PG8_LDA(At, 0, 1); PG8_STAGE(PG8_SB(0, 0), b2, voffB); PG8_STAGE(PG8_SB(0, 1), b2 + hstep, voffB); PG8_STAGE(PG8_SA(0, 0), a2, voffA);
            PG8_WAIT_V(8); PG8_WAIT_L(0); PG8_BAR; PG8_MMA(1, 0, At, B0); PG8_MMA(1, 1, At, B1); PG8_BAR; PG8_SCHED;
            PG8_LDB(B0, 1, 0); PG8_LDB(B1, 1, 1); PG8_SCHED; PG8_LDA(At, 1, 0); PG8_STAGE(PG8_SA(0, 1), a2 + hstep, voffA);
            PG8_WAIT_V(8); PG8_WAIT_L(0); PG8_BAR; PG8_MMA(0, 0, At, B0); PG8_MMA(0, 1, At, B1); PG8_BAR; PG8_SCHED;
            PG8_LDA(At, 1, 1); PG8_STAGE(PG8_SB(1, 0), b3, voffB); PG8_STAGE(PG8_SB(1, 1), b3 + hstep, voffB); PG8_STAGE(PG8_SA(1, 0), a3, voffA);
            PG8_WAIT_V(8); PG8_WAIT_L(0); PG8_BAR; PG8_MMA(1, 0, At, B0); PG8_MMA(1, 1, At, B1); PG8_BAR; PG8_SCHED;
            } else {
            PG8_LDB(B0, 0, 0); PG8_SCHED; PG8_LDA(At, 0, 0); PG8_STAGE(PG8_SA(1, 1), a1 + hstep, voffA);
            PG8_WAIT_L(8); PG8_BAR; PG8_WAIT_L(0); PG8_MMA(0, 0, At, B0); PG8_BAR; PG8_SCHED;
            PG8_LDB(B1, 0, 1); PG8_STAGE(PG8_SB(0, 0), b2, voffB);
            PG8_BAR; PG8_WAIT_L(0); PG8_MMA(0, 1, At, B1); PG8_BAR;
            PG8_LDA(At, 0, 1); PG8_STAGE(PG8_SA(0, 0), a2, voffA);
            PG8_BAR; PG8_WAIT_L(0); PG8_MMA(1, 0, At, B0); PG8_BAR; PG8_SCHED;
            PG8_STAGE(PG8_SB(0, 1), b2 + hstep, voffB);
            PG8_WAIT_V(6); PG8_BAR; PG8_MMA(1, 1, At, B1); PG8_BAR;
            PG8_LDB(B0, 1, 0); PG8_SCHED; PG8_LDA(At, 1, 0); PG8_STAGE(PG8_SA(0, 1), a2 + hstep, voffA);
            PG8_WAIT_L(8); PG8_BAR; PG8_WAIT_L(0); PG8_MMA(0, 0, At, B0); PG8_BAR; PG8_SCHED;
            PG8_LDB(B1, 1, 1); PG8_STAGE(PG8_SB(1, 0), b3, voffB);
            PG8_BAR; PG8_WAIT_L(0); PG8_MMA(0, 1, At, B1); PG8_BAR;
            PG8_LDA(At, 1, 1); PG8_STAGE(PG8_SA(1, 0), a3, voffA);
            PG8_BAR; PG8_WAIT_L(0); PG8_MMA(1, 0, At, B0); PG8_BAR; PG8_SCHED;
            PG8_STAGE(PG8_SB(1, 1), b3 + hstep, voffB);
            PG8_WAIT_V(6); PG8_BAR; PG8_MMA(1, 1, At, B1); PG8_BAR;
            }
        }
        if constexpr (ALIGN_EPI) { if (wr == 0) PG8_BAR; }
        if constexpr (!Epi::AFTER_DRAIN) { E(acc, cur, wr, wc, fr, fq); S.done(cur); }
        if (!has_next) break;
#pragma unroll
        for (int a = 0; a < 2; ++a)
#pragma unroll
            for (int b = 0; b < 2; ++b)
#pragma unroll
                for (int m = 0; m < 4; ++m)
#pragma unroll
                    for (int n = 0; n < 2; ++n) acc[a][b][m][n] = (f32x4){0.f, 0.f, 0.f, 0.f};
        cur = nxt; cA = nA; cB = nB; ++ui;
        if constexpr (ALIGN_EPI) { if (wr == 1) PG8_BAR; }
    }
    PG8_WAIT_V(0);
    if constexpr (!ALIGN_EPI) { if (wr == 0) PG8_BAR; }
    PG8_BAR;
    if constexpr (Epi::AFTER_DRAIN) { E.fused(acc, cur, wr, wc, fr, fq, lds, wid, lane); S.done(cur); }
#undef PG8_SA
#undef PG8_SB
#undef PG8_STAGE
#undef PG8_LDA
#undef PG8_LDB
#undef PG8_MMA
#undef PG8_WAIT_V
#undef PG8_WAIT_L
#undef PG8_BAR
#undef PG8_SCHED
}
template <class Epi, class Sched, bool ALIGN_EPI = false, bool SP2 = false>
__device__ __forceinline__ void gemm_phase_gather(PG8_LAS unsigned char* lds, const Gemm g, const Sched& S, const Epi& E) {
    const int tid = threadIdx.x, wid = __builtin_amdgcn_readfirstlane(tid >> 6), lane = tid & 63, wr = wid >> 2, wc = wid & 3, fr = lane & 15, fq = lane >> 4;
    const int K = g.K, nt = K / BK;
    unsigned voffA[2], voffB[2]; int RA[2];
#pragma unroll
    for (int i = 0; i < 2; ++i) { int R, C; stage_rc(tid * 16 + i * 8192, R, C); const int Rb = Epi::PERM ? ((R & ~31) + perm32(R & 31)) : R;
        RA[i] = R; voffA[i] = (unsigned)C * 2u; voffB[i] = (unsigned)(Rb * K + C) * 2u; }
    const size_t kstep = (size_t)(BK * 2);
    const size_t hstep = (size_t)HALF * K * 2;
    const size_t tstep = 2 * hstep;
    const unsigned ldsw = (unsigned)wid * 1024u;
    const int aoff = lds_byte(wr * 64 + fr, fq * 8), boff = lds_byte(wc * 32 + fr, fq * 8);
#define PG8_SA(b, h) (((b) * 2 + (h)) * HTB)
#define PG8_SB(b, h) ((4 + (b) * 2 + (h)) * HTB)
#define PG8_STAGE(bufoff, gbase, voff) do { _Pragma("unroll") for (int _i = 0; _i < 2; ++_i) \
        __builtin_amdgcn_global_load_lds((const unsigned*)((const char*)(gbase) + (voff)[_i]), (PG8_LAS unsigned*)(lds + (bufoff) + ldsw + _i * 8192), 16, 0, 0); } while (0)
#define PG8_LDA(dst, b, h) do { _Pragma("unroll") for (int m = 0; m < 4; ++m) _Pragma("unroll") for (int k = 0; k < 2; ++k) dst[m][k] = *(const PG8_LAS bf16x8*)(lds + PG8_SA(b, h) + aoff + m * 2048 + k * 1024); } while (0)
#define PG8_LDB(dst, b, h) do { _Pragma("unroll") for (int n = 0; n < 2; ++n) _Pragma("unroll") for (int k = 0; k < 2; ++k) dst[n][k] = *(const PG8_LAS bf16x8*)(lds + PG8_SB(b, h) + boff + n * 2048 + k * 1024); } while (0)
#define PG8_MMA(ai, bj, At, Bt) do { __builtin_amdgcn_s_setprio(1); _Pragma("unroll") for (int m = 0; m < 4; ++m) _Pragma("unroll") for (int n = 0; n < 2; ++n) _Pragma("unroll") for (int k = 0; k < 2; ++k) \
        acc[ai][bj][m][n] = __builtin_amdgcn_mfma_f32_16x16x32_bf16(Bt[n][k], At[m][k], acc[ai][bj][m][n], 0, 0, 0); __builtin_amdgcn_s_setprio(0); } while (0)
#define PG8_WAIT_V(n) asm volatile("s_waitcnt vmcnt(" #n ")" ::: "memory")
#define PG8_WAIT_L(n) asm volatile("s_waitcnt lgkmcnt(" #n ")" ::: "memory")
#define PG8_BAR __builtin_amdgcn_s_barrier()
#define PG8_SCHED __builtin_amdgcn_sched_barrier(0)
    Unit cur, nxt; int ui = 0;
    if (!S.next(0, cur)) return;
    f32x4 acc[2][2][4][2];
#pragma unroll
    for (int a = 0; a < 2; ++a)
#pragma unroll
        for (int b = 0; b < 2; ++b)
#pragma unroll
            for (int m = 0; m < 4; ++m)
#pragma unroll
                for (int n = 0; n < 2; ++n) acc[a][b][m][n] = (f32x4){0.f, 0.f, 0.f, 0.f};
    bf16x8 At[4][2], B0[2][2], B1[2][2];
    const char* cA = (const char*)g.A; unsigned cvo0[2], cvo1[2], nvo0[2], nvo1[2];
    _Pragma("unroll") for (int i = 0; i < 2; ++i) { cvo0[i] = S.arow(cur, RA[i]) * (unsigned)(K * 2) + voffA[i]; cvo1[i] = S.arow(cur, HALF + RA[i]) * (unsigned)(K * 2) + voffA[i]; }
    const char* cB = (const char*)g.Bt + (size_t)cur.pn * tstep;
    S.a_ready(cur);
    if constexpr (SP2) {
        PG8_STAGE(PG8_SB(0, 0), cB, voffB); PG8_STAGE(PG8_SB(0, 1), cB + hstep, voffB); PG8_STAGE(PG8_SA(0, 0), cA, cvo0); PG8_STAGE(PG8_SA(0, 1), cA, cvo1);
        if (wr == 1) PG8_BAR;
        PG8_WAIT_V(2); PG8_BAR;
        PG8_STAGE(PG8_SB(1, 0), cB + kstep, voffB); PG8_STAGE(PG8_SA(1, 0), cA + kstep, cvo0); PG8_STAGE(PG8_SB(1, 1), cB + hstep + kstep, voffB);
        PG8_WAIT_V(6); PG8_BAR;
    } else {
        PG8_STAGE(PG8_SB(0, 0), cB, voffB); PG8_STAGE(PG8_SA(0, 0), cA, cvo0); PG8_STAGE(PG8_SB(0, 1), cB + hstep, voffB); PG8_STAGE(PG8_SA(0, 1), cA, cvo1);
        if (wr == 1) PG8_BAR;
        PG8_WAIT_V(4); PG8_BAR;
        PG8_STAGE(PG8_SB(1, 0), cB + kstep, voffB); PG8_STAGE(PG8_SA(1, 0), cA + kstep, cvo0); PG8_STAGE(PG8_SB(1, 1), cB + hstep + kstep, voffB);
        PG8_WAIT_V(6); PG8_BAR;
    }
    for (;;) {
        const bool has_next = S.next(ui + 1, nxt);
        _Pragma("unroll") for (int i = 0; i < 2; ++i) { nvo0[i] = has_next ? S.arow(nxt, RA[i]) * (unsigned)(K * 2) + voffA[i] : cvo0[i]; nvo1[i] = has_next ? S.arow(nxt, HALF + RA[i]) * (unsigned)(K * 2) + voffA[i] : cvo1[i]; }
        const char* nB = has_next ? (const char*)g.Bt + (size_t)nxt.pn * tstep : cB;
        for (int t = 0; t < nt; t += 2) {
            const bool last = (t == nt - 2);
            const char* a1 = cA + (size_t)(t + 1) * kstep;
            const char* a2 = last ? cA : cA + (size_t)(t + 2) * kstep; unsigned xo0[2], xo1[2]; _Pragma("unroll") for (int i = 0; i < 2; ++i) { xo0[i] = last ? nvo0[i] : cvo0[i]; xo1[i] = last ? nvo1[i] : cvo1[i]; } const char* b2 = last ? nB : cB + (size_t)(t + 2) * kstep;
            const char* a3 = a2 + kstep; const char* b3 = b2 + kstep;
            if (last && has_next) S.a_ready(nxt);
            if constexpr (SP2) {
            PG8_LDB(B0, 0, 0); PG8_LDB(B1, 0, 1); PG8_SCHED; PG8_LDA(At, 0, 0); PG8_STAGE(PG8_SA(1, 1), a1, cvo1);
            PG8_WAIT_V(8); PG8_WAIT_L(0); PG8_BAR; PG8_MMA(0, 0, At, B0); PG8_MMA(0, 1, At, B1); PG8_BAR; PG8_SCHED;
            PG8_LDA(At, 0, 1); PG8_STAGE(PG8_SB(0, 0), b2, voffB); PG8_STAGE(PG8_SB(0, 1), b2 + hstep, voffB); PG8_STAGE(PG8_SA(0, 0), a2, xo0);
            PG8_WAIT_V(8); PG8_WAIT_L(0); PG8_BAR; PG8_MMA(1, 0, At, B0); PG8_MMA(1, 1, At, B1); PG8_BAR; PG8_SCHED;
            PG8_LDB(B0, 1, 0); PG8_LDB(B1, 1, 1); PG8_SCHED; PG8_LDA(At, 1, 0); PG8_STAGE(PG8_SA(0, 1), a2, xo1);
            PG8_WAIT_V(8); PG8_WAIT_L(0); PG8_BAR; PG8_MMA(0, 0, At, B0); PG8_MMA(0, 1, At, B1); PG8_BAR; PG8_SCHED;
            PG8_LDA(At, 1, 1); PG8_STAGE(PG8_SB(1, 0), b3, voffB); PG8_STAGE(PG8_SB(1, 1), b3 + hstep, voffB); PG8_STAGE(PG8_SA(1, 0), a3, xo0);
            PG8_WAIT_V(8); PG8_WAIT_L(0); PG8_BAR; PG8_MMA(1, 0, At, B0); PG8_MMA(1, 1, At, B1); PG8_BAR; PG8_SCHED;
            } else {
            PG8_LDB(B0, 0, 0); PG8_SCHED; PG8_LDA(At, 0, 0); PG8_STAGE(PG8_SA(1, 1), a1, cvo1);
            PG8_WAIT_L(8); PG8_BAR; PG8_WAIT_L(0); PG8_MMA(0, 0, At, B0); PG8_BAR; PG8_SCHED;
            PG8_LDB(B1, 0, 1); PG8_STAGE(PG8_SB(0, 0), b2, voffB);
            PG8_BAR; PG8_WAIT_L(0); PG8_MMA(0, 1, At, B1); PG8_BAR;
            PG8_LDA(At, 0, 1); PG8_STAGE(PG8_SA(0, 0), a2, xo0);
            PG8_BAR; PG8_WAIT_L(0); PG8_MMA(1, 0, At, B0); PG8_BAR; PG8_SCHED;
            PG8_STAGE(PG8_SB(0, 1), b2 + hstep, voffB);
            PG8_WAIT_V(6); PG8_BAR; PG8_MMA(1, 1, At, B1); PG8_BAR;
            PG8_LDB(B0, 1, 0); PG8_SCHED; PG8_LDA(At, 1, 0); PG8_STAGE(PG8_SA(0, 1), a2, xo1);
            PG8_WAIT_L(8); PG8_BAR; PG8_WAIT_L(0); PG8_MMA(0, 0, At, B0); PG8_BAR; PG8_SCHED;
            PG8_LDB(B1, 1, 1); PG8_STAGE(PG8_SB(1, 0), b3, voffB);
            PG8_BAR; PG8_WAIT_L(0); PG8_MMA(0, 1, At, B1); PG8_BAR;
            PG8_LDA(At, 1, 1); PG8_STAGE(PG8_SA(1, 0), a3, xo0);
            PG8_BAR; PG8_WAIT_L(0); PG8_MMA(1, 0, At, B0); PG8_BAR; PG8_SCHED;
            PG8_STAGE(PG8_SB(1, 1), b3 + hstep, voffB);
            PG8_WAIT_V(6); PG8_BAR; PG8_MMA(1, 1, At, B1); PG8_BAR;
            }
        }
        if constexpr (ALIGN_EPI) { if (wr == 0) PG8_BAR; }
        if constexpr (!Epi::AFTER_DRAIN) { E(acc, cur, wr, wc, fr, fq); S.done(cur); }
        if (!has_next) break;
#pragma unroll
        for (int a = 0; a < 2; ++a)
#pragma unroll
            for (int b = 0; b < 2; ++b)
#pragma unroll
                for (int m = 0; m < 4; ++m)
#pragma unroll
                    for (int n = 0; n < 2; ++n) acc[a][b][m][n] = (f32x4){0.f, 0.f, 0.f, 0.f};
        cur = nxt; cB = nB; ++ui; _Pragma("unroll") for (int i = 0; i < 2; ++i) { cvo0[i] = nvo0[i]; cvo1[i] = nvo1[i]; }
        if constexpr (ALIGN_EPI) { if (wr == 1) PG8_BAR; }
    }
    PG8_WAIT_V(0);
    if constexpr (!ALIGN_EPI) { if (wr == 0) PG8_BAR; }
    PG8_BAR;
    if constexpr (Epi::AFTER_DRAIN) { E.fused(acc, cur, wr, wc, fr, fq, lds, wid, lane); S.done(cur); }
#undef PG8_SA
#undef PG8_SB
#undef PG8_STAGE
#undef PG8_LDA
#undef PG8_LDB
#undef PG8_MMA
#undef PG8_WAIT_V
#undef PG8_WAIT_L
#undef PG8_BAR
#undef PG8_SCHED
}
}

struct Args {
    const float* in[22];
    float* out; unsigned char* ws;
    int ph_lo, ph_hi;
};
enum { I_X = 0, I_MEM, I_ATTN_G, I_MEM_G, I_WIN, I_WGK, I_BGK, I_GLA_OG, I_MBQ_G, I_MBK_G, I_WMEMKV, I_MEMQ_G, I_MEMK_G, I_WOUT, I_FFN_G,
       I_WRG, I_BRG, I_WRE, I_BRE, I_WGATE, I_WUP, I_WDOWN };

struct Frame {
    LAS unsigned char* lds; int tid, lane, wave, G, bid;
    const float* const* in; float* out; unsigned char* ws; unsigned* ctl;
};

__device__ __forceinline__ void ph_norm_in(Frame& F) {
    bf16_t* XN = (bf16_t*)(F.ws + WS_XN); float* LR = (float*)(F.ws + WS_LR);
    const int gw = F.bid * 8 + F.wave, NGW = F.G * 8;
    for (int r = gw; r < T_TOK + 512; r += NGW) {
        const float* src = r < T_TOK ? F.in[I_X] + (size_t)r * DM : F.in[I_MEM] + (size_t)(r - T_TOK) * DM;
        const float* g = r < T_TOK ? F.in[I_ATTN_G] : F.in[I_MEM_G];
        f32x4 v[4]; float ss = 0.f;
#pragma unroll
        for (int j = 0; j < 4; ++j) { v[j] = ((const f32x4*)src)[F.lane + 64 * j]; ss += v[j].x * v[j].x + v[j].y * v[j].y + v[j].z * v[j].z + v[j].w * v[j].w; }
        const float rstd = rsqrtf(wave_sum(ss) * (1.f / DM) + EPS);
#pragma unroll
        for (int j = 0; j < 4; ++j) { const f32x4 gg = ((const f32x4*)g)[F.lane + 64 * j]; v[j] = v[j] * rstd * gg;
            u32x2 o; o.x = pk2(v[j].x, v[j].y); o.y = pk2(v[j].z, v[j].w);
            ((u32x2*)(XN + (size_t)r * DM))[F.lane + 64 * j] = o; }
        if (r < T_TOK) {
            f32x4 a0 = {0.f, 0.f, 0.f, 0.f}, a1 = a0, a2 = a0, a3 = a0;
#pragma unroll
            for (int j = 0; j < 4; ++j)
#pragma unroll
                for (int e = 0; e < 4; ++e) { const f32x4* w = (const f32x4*)(F.in[I_WIN] + (size_t)(4 * (F.lane + 64 * j) + e) * DIN + 1536); const float hv = v[j][e];
                    a0 += w[0] * hv; a1 += w[1] * hv; a2 += w[2] * hv; a3 += w[3] * hv; }
#pragma unroll
            for (int e = 0; e < 4; ++e) { a0[e] = wave_sum(a0[e]); a1[e] = wave_sum(a1[e]); a2[e] = wave_sum(a2[e]); a3[e] = wave_sum(a3[e]); }
            if (F.lane == 0) { f32x4* o = (f32x4*)(LR + (size_t)r * 16); o[0] = a0; o[1] = a1; o[2] = a2; o[3] = a3; }
        }
    }
}

__device__ __forceinline__ void tr_item(const float* W, int ldw, int scol0, bf16_t* WT, int K, int drow0, int k0, LAS float* scr, int lane) {
#pragma unroll 8
    for (int i = 0; i < 32; ++i) { const int kk = 2 * i + (lane >> 5); scr[kk * 33 + (lane & 31)] = W[(size_t)(k0 + kk) * ldw + scol0 + (lane & 31)]; }
    asm volatile("s_waitcnt lgkmcnt(0)" ::: "memory");
    const int c = lane & 7;
#pragma unroll
    for (int j = 0; j < 4; ++j) { const int n = (lane >> 3) + 8 * j; const LAS float* s = scr + (8 * c) * 33 + n;
        u32x4 o; o.x = pk2(s[0 * 33], s[1 * 33]); o.y = pk2(s[2 * 33], s[3 * 33]); o.z = pk2(s[4 * 33], s[5 * 33]); o.w = pk2(s[6 * 33], s[7 * 33]);
        *(u32x4*)(WT + (size_t)(drow0 + n) * K + k0 + 8 * c) = o; }
    asm volatile("s_waitcnt lgkmcnt(0)" ::: "memory");
}
__device__ __forceinline__ void ph_prep_weights(Frame& F) {
    LAS float* scr = (LAS float*)(F.lds + F.wave * 16384);
    bf16_t* WIN_T = (bf16_t*)(F.ws + WS_WIN_T); bf16_t* WOUT_T = (bf16_t*)(F.ws + WS_WOUT_T); bf16_t* WGU_T = (bf16_t*)(F.ws + WS_WGU_T); bf16_t* WD_T = (bf16_t*)(F.ws + WS_WD_T);
    const int gw = F.bid * 8 + F.wave, NGW = F.G * 8;
    constexpr int N_IN = 12 * 8 * 16, N_OUT = 4 * 8 * 16, N_GU = 32 * 4 * 8 * 16, N_DN = 32 * 4 * 8 * 8;
    for (int it = gw; it < N_IN + N_OUT + N_GU + N_DN; it += NGW) {
        int r = it;
        if (r < N_IN) { const int kb = r & 15, g32 = (r >> 4) & 7, pn = r >> 7, bj = g32 >> 2, wc = g32 & 3; const int L0 = 256 * pn + 64 * wc + 32 * bj;
            if (pn < 10) tr_item(F.in[I_WIN], DIN, L0 < 1536 ? L0 : L0 + 16, WIN_T, 1024, 256 * pn + 32 * g32, 64 * kb, scr, F.lane);
            else tr_item(F.in[I_WMEMKV], 512, L0 - 2560, WIN_T, 1024, 256 * pn + 32 * g32, 64 * kb, scr, F.lane);
            continue; }
        r -= N_IN;
        if (r < N_OUT) { const int kb = r & 15, g32 = (r >> 4) & 7, pn = r >> 7, bj = g32 >> 2, wc = g32 & 3;
            tr_item(F.in[I_WOUT], 1024, 256 * pn + 64 * wc + 32 * bj, WOUT_T, 1024, 256 * pn + 32 * g32, 64 * kb, scr, F.lane); continue; }
        r -= N_OUT;
        if (r < N_GU) { const int kb = r & 15, g32 = (r >> 4) & 7, pn = (r >> 7) & 3, e = r >> 9, bj = g32 >> 2, wc = g32 & 3;
            tr_item((bj ? F.in[I_WUP] : F.in[I_WGATE]) + (size_t)e * 1024 * 512, 512, 128 * pn + 32 * wc, WGU_T, 1024, e * 1024 + 256 * pn + 32 * g32, 64 * kb, scr, F.lane); continue; }
        r -= N_GU;
        { const int kb = r & 7, g32 = (r >> 3) & 7, pn = (r >> 6) & 3, e = r >> 8, bj = g32 >> 2, wc = g32 & 3;
            tr_item(F.in[I_WDOWN] + (size_t)e * 512 * 1024, 1024, 256 * pn + 64 * wc + 32 * bj, WD_T, 512, e * 1024 + 256 * pn + 32 * g32, 64 * kb, scr, F.lane); }
    }
}

struct ProjOrder {
    pg8::StaticOrder s;
    __device__ __forceinline__ void init(int G, int c) { s.init(T_TOK, PROJ_LD, G, c); }
    __device__ __forceinline__ bool next(int i, pg8::Unit& u) const {
        if (s.next(i, u)) return true;
        const long L = (long)i * s.G + s.c - s.nwg;
        if (L >= 0 && L < 4) { u.pm = 64 + (int)(L >> 1); u.pn = 10 + (int)(L & 1); u.aux = 0; return true; }
        return false;
    }
    __device__ __forceinline__ void a_ready(const pg8::Unit&) const {}
    __device__ __forceinline__ void done(const pg8::Unit&) const {}
};
struct EpiProj {
    static constexpr bool PERM = true, AFTER_DRAIN = false;
    bf16_t* PROJ; bf16_t* MEMKV; float* KMEAN; const float* g_mbq; const float* g_mbk; const float* g_memq; const float* g_memk;
    __device__ __forceinline__ void operator()(const pg8::f32x4 (&acc)[2][2][4][2], const pg8::Unit& u, int wr, int wc, int fr, int fq) const {
        const int pn = u.pn;
        const float* gain = pn == 6 ? g_mbq : pn == 7 ? g_mbk : pn == 9 ? g_memq : pn == 10 ? g_memk : nullptr;
        const float post = (pn == 6 || pn == 9) ? C2 : (pn == 0 ? 0.125f : 1.f);
        float gv[2][8];
#pragma unroll
        for (int bj = 0; bj < 2; ++bj)
#pragma unroll
            for (int j = 0; j < 8; ++j) gv[bj][j] = (gain ? gain[32 * bj + 8 * fq + j] : 1.f) * post;
        bf16_t* base; int ld;
        if (pn < 10) { base = PROJ + (size_t)(u.pm * 256) * PROJ_LD + 256 * pn; ld = PROJ_LD; } else { base = MEMKV + (size_t)((u.pm - 64) * 256) * 512 + 256 * (pn - 10); ld = 512; }
        base += 64 * wc + 8 * fq;
        float ks[2][8];
#pragma unroll
        for (int bj = 0; bj < 2; ++bj)
#pragma unroll
            for (int j = 0; j < 8; ++j) ks[bj][j] = 0.f;
#pragma unroll
        for (int ai = 0; ai < 2; ++ai)
#pragma unroll
            for (int m = 0; m < 4; ++m) {
                const int row = 128 * ai + 64 * wr + 16 * m + fr; float rstd = 1.f;
                if (gain) { float ss = 0.f;
#pragma unroll
                    for (int bj = 0; bj < 2; ++bj)
#pragma unroll
                        for (int n = 0; n < 2; ++n) { const pg8::f32x4 x = acc[ai][bj][m][n]; ss += (x[0] * x[0] + x[1] * x[1]) + (x[2] * x[2] + x[3] * x[3]); }
                    ss += __shfl_xor(ss, 16); ss += __shfl_xor(ss, 32); rstd = rsqrtf(ss * (1.f / 64.f) + EPS); }
#pragma unroll
                for (int bj = 0; bj < 2; ++bj) { float o[8];
#pragma unroll
                    for (int j = 0; j < 8; ++j) o[j] = acc[ai][bj][m][j >> 2][j & 3] * rstd * gv[bj][j];
                    if (pn == 7) {
#pragma unroll
                        for (int j = 0; j < 8; ++j) ks[bj][j] += o[j]; }
                    u32x4 w; w.x = pg8::cvt_pk_bf16(o[0], o[1]); w.y = pg8::cvt_pk_bf16(o[2], o[3]); w.z = pg8::cvt_pk_bf16(o[4], o[5]); w.w = pg8::cvt_pk_bf16(o[6], o[7]);
                    *(u32x4*)(base + (size_t)row * ld + 32 * bj) = w; }
            }
        if (pn == 7) {
            float* km = KMEAN + (((u.pm >> 5) * 4 + wc) * 32 + (u.pm & 31)) * 64 + 8 * fq;
#pragma unroll
            for (int bj = 0; bj < 2; ++bj)
#pragma unroll
                for (int j = 0; j < 8; ++j) { float v = ks[bj][j]; v += __shfl_xor(v, 1); v += __shfl_xor(v, 2); v += __shfl_xor(v, 4); v += __shfl_xor(v, 8);
                    if (fr == 0) atomicAdd(km + 32 * bj + j, v * (1.f / 256.f)); }
        }
    }
};
__device__ __forceinline__ void ph_proj_gemm(Frame& F) {
    pg8::Gemm g{(const bf16_t*)(F.ws + WS_XN), (const bf16_t*)(F.ws + WS_WIN_T), T_TOK + 512, 3072, 1024};
    ProjOrder S; S.init(F.G, F.bid);
    EpiProj E{(bf16_t*)(F.ws + WS_PROJ), (bf16_t*)(F.ws + WS_MEMKV), (float*)(F.ctl + CW_KMEAN), F.in[I_MBQ_G], F.in[I_MBK_G], F.in[I_MEMQ_G], F.in[I_MEMK_G]};
    pg8::gemm_phase<EpiProj, ProjOrder, true, true>(F.lds, g, S, E);
}

__device__ __forceinline__ void ph_kmean_g_naive(Frame& F) {
    const float* LR = (const float*)(F.ws + WS_LR); float* Gb = (float*)(F.ws + WS_G);
    const int gt = F.bid * 512 + F.tid, NT = F.G * 512;
    for (int idx = gt; idx < T_TOK * 256; idx += NT) {
        const int t = idx >> 8, c = idx & 255; float z = F.in[I_BGK][c];
#pragma unroll
        for (int i = 0; i < 16; ++i) z += LR[(size_t)t * 16 + i] * F.in[I_WGK][i * 256 + c];
        const float ls = fminf(z, 0.f) - log1pf(__expf(-fabsf(z)));
        Gb[idx] = ls * (1.f / 16.f);
    }
}

__device__ __forceinline__ void attend_naive(const float (&q)[64], float (&o)[64], float& m, float& l, const bf16_t* kp, const bf16_t* vp, int ld, int s0, int s1, int t, float slope2) {
    for (int s = s0; s < s1; ++s) {
        const u32x4* kr = (const u32x4*)(kp + (size_t)s * ld); float sc = 0.f;
#pragma unroll
        for (int c = 0; c < 8; ++c) { const u32x4 w = kr[c];
            sc += q[8 * c + 0] * bf2f(w.x & 0xffffu) + q[8 * c + 1] * bf2f(w.x >> 16) + q[8 * c + 2] * bf2f(w.y & 0xffffu) + q[8 * c + 3] * bf2f(w.y >> 16)
                + q[8 * c + 4] * bf2f(w.z & 0xffffu) + q[8 * c + 5] * bf2f(w.z >> 16) + q[8 * c + 6] * bf2f(w.w & 0xffffu) + q[8 * c + 7] * bf2f(w.w >> 16); }
        sc -= slope2 * (float)(t - s);
        float p;
        if (sc > m) { const float f = exp2f(m - sc); l *= f;
#pragma unroll
            for (int d = 0; d < 64; ++d) o[d] *= f;
            m = sc; p = 1.f; } else p = exp2f(sc - m);
        l += p;
        const u32x4* vr = (const u32x4*)(vp + (size_t)s * ld);
#pragma unroll
        for (int c = 0; c < 8; ++c) { const u32x4 w = vr[c];
            o[8 * c + 0] += p * bf2f(w.x & 0xffffu); o[8 * c + 1] += p * bf2f(w.x >> 16); o[8 * c + 2] += p * bf2f(w.y & 0xffffu); o[8 * c + 3] += p * bf2f(w.y >> 16);
            o[8 * c + 4] += p * bf2f(w.z & 0xffffu); o[8 * c + 5] += p * bf2f(w.z >> 16); o[8 * c + 6] += p * bf2f(w.w & 0xffffu); o[8 * c + 7] += p * bf2f(w.w >> 16); }
    }
}
__device__ __forceinline__ void load_q64(float (&q)[64], const bf16_t* p) {
#pragma unroll
    for (int c = 0; c < 8; ++c) { const u32x4 w = ((const u32x4*)p)[c];
        q[8 * c + 0] = bf2f(w.x & 0xffffu); q[8 * c + 1] = bf2f(w.x >> 16); q[8 * c + 2] = bf2f(w.y & 0xffffu); q[8 * c + 3] = bf2f(w.y >> 16);
        q[8 * c + 4] = bf2f(w.z & 0xffffu); q[8 * c + 5] = bf2f(w.z >> 16); q[8 * c + 6] = bf2f(w.w & 0xffffu); q[8 * c + 7] = bf2f(w.w >> 16); }
}
__device__ __forceinline__ void store_o64(const float (&o)[64], float inv, bf16_t* p) {
#pragma unroll
    for (int c = 0; c < 8; ++c) { u32x4 w; w.x = pk2(o[8 * c] * inv, o[8 * c + 1] * inv); w.y = pk2(o[8 * c + 2] * inv, o[8 * c + 3] * inv); w.z = pk2(o[8 * c + 4] * inv, o[8 * c + 5] * inv); w.w = pk2(o[8 * c + 6] * inv, o[8 * c + 7] * inv);
        ((u32x4*)p)[c] = w; }
}

__device__ __forceinline__ void ph_mixers_naive(Frame& F) {
    const bf16_t* PROJ = (const bf16_t*)(F.ws + WS_PROJ); bf16_t* MIX = (bf16_t*)(F.ws + WS_MIX);
    if (F.bid < 8) {
        const int b = F.bid >> 2, h = F.bid & 3; const float* Gb = (const float*)(F.ws + WS_G);
        LAS float* qs = (LAS float*)F.lds; LAS float* ks = qs + 4096; LAS float* eg = ks + 4096; LAS float* vs = eg + 4096; LAS float* os = vs + 8192;
        float S[64];
#pragma unroll
        for (int d = 0; d < 64; ++d) S[d] = 0.f;
        for (int n = 0; n < 128; ++n) {
            const int t0 = b * SEQ + 64 * n;
            for (int i = F.tid; i < 4096; i += 512) { const int c = i >> 6, d = i & 63; const size_t row = (size_t)(t0 + c) * PROJ_LD;
                qs[i] = bf2f(PROJ[row + C_GQ + h * 64 + d]); ks[i] = bf2f(PROJ[row + C_GK + h * 64 + d]); eg[i] = __expf(Gb[(size_t)(t0 + c) * 256 + h * 64 + d]); }
            for (int i = F.tid; i < 8192; i += 512) { const int c = i >> 7, v = i & 127; vs[i] = bf2f(PROJ[(size_t)(t0 + c) * PROJ_LD + C_GV + h * 128 + v]); }
            __syncthreads();
            if (F.tid < 128) {
                for (int c = 0; c < 64; ++c) { const float vv = vs[c * 128 + F.tid]; float o = 0.f;
#pragma unroll
                    for (int d = 0; d < 64; ++d) { S[d] = S[d] * eg[c * 64 + d] + ks[c * 64 + d] * vv; o += qs[c * 64 + d] * S[d]; }
                    os[c * 128 + F.tid] = o; }
            }
            __syncthreads();
            for (int rr = 0; rr < 8; ++rr) { const int c = F.wave * 8 + rr; const float o0 = os[c * 128 + F.lane], o1 = os[c * 128 + 64 + F.lane];
                const float rstd = rsqrtf(wave_sum(o0 * o0 + o1 * o1) * (1.f / 128.f) + EPS); const size_t row = (size_t)(t0 + c);
                const float r0 = bf2f(PROJ[row * PROJ_LD + C_GR + h * 128 + F.lane]), r1 = bf2f(PROJ[row * PROJ_LD + C_GR + h * 128 + 64 + F.lane]);
                MIX[row * DM + h * 128 + F.lane] = (bf16_t)f2bf(o0 * rstd * F.in[I_GLA_OG][F.lane] * silu_f(r0));
                MIX[row * DM + h * 128 + 64 + F.lane] = (bf16_t)f2bf(o1 * rstd * F.in[I_GLA_OG][64 + F.lane] * silu_f(r1)); }
            __syncthreads();
        }
    } else {
        const float* KMEAN = (const float*)(F.ctl + CW_KMEAN); const bf16_t* MEMKV = (const bf16_t*)(F.ws + WS_MEMKV);
        const int gt = (F.bid - 8) * 512 + F.tid, NT = (F.G - 8) * 512;
        for (int gi = gt; gi < 2 * 65536; gi += NT) {
            const bool moba = gi < 65536; const int g2 = gi & 65535; const int t = g2 & 8191, h = (g2 >> 13) & 3, b = g2 >> 15;
            const size_t row = (size_t)(b * SEQ + t);
            float q[64], o[64]; float m = -INFINITY, l = 0.f;
#pragma unroll
            for (int d = 0; d < 64; ++d) o[d] = 0.f;
            if (moba) {
                load_q64(q, PROJ + row * PROJ_LD + C_MBQ + h * 64);
                const int own = t >> 8; float b0 = -INFINITY, b1 = -INFINITY, b2 = -INFINITY; int i0 = 0, i1 = 0, i2 = 0;
                for (int j = 0; j < own; ++j) { const float* km = KMEAN + ((b * 4 + h) * 32 + j) * 64; float gsc = 0.f;
#pragma unroll
                    for (int d = 0; d < 64; ++d) gsc += q[d] * km[d];
                    if (gsc > b0) { b2 = b1; i2 = i1; b1 = b0; i1 = i0; b0 = gsc; i0 = j; } else if (gsc > b1) { b2 = b1; i2 = i1; b1 = gsc; i1 = j; } else if (gsc > b2) { b2 = gsc; i2 = j; } }
                const int nsel = own < 3 ? own : 3; const float slope2 = exp2f(-2.f * (float)(h + 1)) * LOG2E;
                const bf16_t* kp = PROJ + (size_t)(b * SEQ) * PROJ_LD + C_MBK + h * 64; const bf16_t* vp = PROJ + (size_t)(b * SEQ) * PROJ_LD + C_MBV + h * 64;
                if (nsel > 0) attend_naive(q, o, m, l, kp, vp, PROJ_LD, i0 * 256, i0 * 256 + 256, t, slope2);
                if (nsel > 1) attend_naive(q, o, m, l, kp, vp, PROJ_LD, i1 * 256, i1 * 256 + 256, t, slope2);
                if (nsel > 2) attend_naive(q, o, m, l, kp, vp, PROJ_LD, i2 * 256, i2 * 256 + 256, t, slope2);
                attend_naive(q, o, m, l, kp, vp, PROJ_LD, own * 256, t + 1, t, slope2);
                store_o64(o, 1.f / l, MIX + row * DM + 512 + h * 64);
            } else {
                load_q64(q, PROJ + row * PROJ_LD + C_MEMQ + h * 64);
                attend_naive(q, o, m, l, MEMKV + (size_t)(b * NMEM) * 512 + h * 64, MEMKV + (size_t)(b * NMEM) * 512 + 256 + h * 64, 512, 0, NMEM, 0, 0.f);
                store_o64(o, 1.f / l, MIX + row * DM + 768 + h * 64);
            }
        }
    }
}

__device__ __forceinline__ void ph_router(Frame& F) {
    bf16_t* H2 = (bf16_t*)(F.ws + WS_H2); unsigned* ETOK = (unsigned*)(F.ws + WS_ETOK); float* EGATE = (float*)(F.ws + WS_EGATE); unsigned* TLOC = (unsigned*)(F.ws + WS_TLOC);
    unsigned* ECNT = F.ctl + CW_ECNT;
    const int gw = F.bid * 8 + F.wave, NGW = F.G * 8;
    for (int t = gw; t < T_TOK; t += NGW) {
        f32x4 v[4]; float ss = 0.f;
#pragma unroll
        for (int j = 0; j < 4; ++j) { v[j] = ((const f32x4*)(F.out + (size_t)t * DM))[F.lane + 64 * j]; ss += v[j].x * v[j].x + v[j].y * v[j].y + v[j].z * v[j].z + v[j].w * v[j].w; }
        const float rstd = rsqrtf(wave_sum(ss) * (1.f / DM) + EPS);
        float lg[4] = {0.f, 0.f, 0.f, 0.f};
#pragma unroll
        for (int j = 0; j < 4; ++j) { const f32x4 gg = ((const f32x4*)F.in[I_FFN_G])[F.lane + 64 * j]; v[j] = v[j] * rstd * gg;
            u32x2 o; o.x = pk2(v[j].x, v[j].y); o.y = pk2(v[j].z, v[j].w); ((u32x2*)(H2 + (size_t)t * DM))[F.lane + 64 * j] = o;
#pragma unroll
            for (int e = 0; e < 4; ++e) { const f32x4 w = ((const f32x4*)F.in[I_WRG])[4 * (F.lane + 64 * j) + e];
                lg[0] += v[j][e] * w.x; lg[1] += v[j][e] * w.y; lg[2] += v[j][e] * w.z; lg[3] += v[j][e] * w.w; } }
#pragma unroll
        for (int i = 0; i < 4; ++i) lg[i] = wave_sum(lg[i]) + F.in[I_BRG][i];
        int gs = 0; float gm = lg[0];
#pragma unroll
        for (int i = 1; i < 4; ++i) if (lg[i] > gm) { gm = lg[i]; gs = i; }
        float den = 0.f;
#pragma unroll
        for (int i = 0; i < 4; ++i) den += __expf(lg[i] - gm);
        const float pg = 1.f / den;
        float le[8];
#pragma unroll
        for (int i = 0; i < 8; ++i) le[i] = 0.f;
        const float* wre = F.in[I_WRE] + (size_t)gs * DM * 8;
#pragma unroll
        for (int j = 0; j < 4; ++j)
#pragma unroll
            for (int e = 0; e < 4; ++e) { const int d = 4 * (F.lane + 64 * j) + e; const f32x4 w0 = ((const f32x4*)wre)[2 * d], w1 = ((const f32x4*)wre)[2 * d + 1];
                le[0] += v[j][e] * w0.x; le[1] += v[j][e] * w0.y; le[2] += v[j][e] * w0.z; le[3] += v[j][e] * w0.w; le[4] += v[j][e] * w1.x; le[5] += v[j][e] * w1.y; le[6] += v[j][e] * w1.z; le[7] += v[j][e] * w1.w; }
#pragma unroll
        for (int i = 0; i < 8; ++i) le[i] = wave_sum(le[i]) + F.in[I_BRE][gs * 8 + i];
        int i0 = 0; float m0 = le[0];
#pragma unroll
        for (int i = 1; i < 8; ++i) if (le[i] > m0) { m0 = le[i]; i0 = i; }
        int i1 = -1; float m1 = -INFINITY;
#pragma unroll
        for (int i = 0; i < 8; ++i) if (i != i0 && le[i] > m1) { m1 = le[i]; i1 = i; }
        const float w0 = 1.f / (1.f + __expf(m1 - m0)), w1 = 1.f - w0;
        if (F.lane == 0) {
            const int e0 = gs * 8 + i0, e1 = gs * 8 + i1;
            const unsigned p0 = atomicAdd(&ECNT[e0], 1u), p1 = atomicAdd(&ECNT[e1], 1u);
            ETOK[e0 * T_TOK + p0] = (unsigned)t; EGATE[e0 * T_TOK + p0] = pg * w0; ETOK[e1 * T_TOK + p1] = (unsigned)t; EGATE[e1 * T_TOK + p1] = pg * w1;
            TLOC[t * 2] = ((unsigned)e0 << 16) | p0; TLOC[t * 2 + 1] = ((unsigned)e1 << 16) | p1;
        }
    }
}


struct EpiOut {
    static constexpr bool PERM = true, AFTER_DRAIN = false;
    const float* x; float* out;
    __device__ __forceinline__ void operator()(const pg8::f32x4 (&acc)[2][2][4][2], const pg8::Unit& u, int wr, int wc, int fr, int fq) const {
#pragma unroll
        for (int ai = 0; ai < 2; ++ai)
#pragma unroll
            for (int m = 0; m < 4; ++m) { const size_t off = (size_t)(u.pm * 256 + 128 * ai + 64 * wr + 16 * m + fr) * DM + u.pn * 256 + 64 * wc + 8 * fq;
#pragma unroll
                for (int bj = 0; bj < 2; ++bj) { const f32x4 x0 = *(const f32x4*)(x + off + 32 * bj), x1 = *(const f32x4*)(x + off + 32 * bj + 4);
                    *(f32x4*)(out + off + 32 * bj) = x0 + acc[ai][bj][m][0]; *(f32x4*)(out + off + 32 * bj + 4) = x1 + acc[ai][bj][m][1]; } }
    }
};
__device__ __forceinline__ void ph_outproj_gemm(Frame& F) {
    pg8::Gemm g{(const bf16_t*)(F.ws + WS_MIX), (const bf16_t*)(F.ws + WS_WOUT_T), T_TOK, DM, DM};
    pg8::StaticOrder S; S.init(T_TOK, DM, F.G, F.bid);
    EpiOut E{F.in[I_X], F.out};
    pg8::gemm_phase<EpiOut, pg8::StaticOrder, true, true>(F.lds, g, S, E);
}

constexpr int ML_PTILE = LDSCTL_OFF + 256, ML_CNT = LDSCTL_OFF + 512, ML_UT = LDSCTL_OFF + 768, ML_TOK = LDSCTL_OFF + 1024;
struct MoeOrder {
    LAS const int* ut; LAS const unsigned* tokl;
    __device__ __forceinline__ bool next(int i, pg8::Unit& u) const { if (i >= 4 || ut[4 * i + 2] == 0) return false; u.pm = ut[4 * i]; u.pn = ut[4 * i + 1]; u.aux = i; return true; }
    __device__ __forceinline__ unsigned arow(const pg8::Unit& u, int r) const { return tokl[u.aux * 256 + r]; }
    __device__ __forceinline__ void a_ready(const pg8::Unit&) const {}
    __device__ __forceinline__ void done(const pg8::Unit&) const {}
};
__device__ __forceinline__ void moe_setup(Frame& F, bool want_tok) {
    LAS int* ptile = (LAS int*)(F.lds + ML_PTILE); LAS int* cnt = (LAS int*)(F.lds + ML_CNT); LAS int* ut = (LAS int*)(F.lds + ML_UT); LAS unsigned* tokl = (LAS unsigned*)(F.lds + ML_TOK);
    const unsigned* ETOK = (const unsigned*)(F.ws + WS_ETOK);
    __syncthreads();
    if (F.tid < 32) cnt[F.tid] = (int)xb_ld(F.ctl + CW_ECNT + F.tid);
    __syncthreads();
    if (F.tid == 0) {
        int a = 0; for (int e = 0; e < 32; ++e) { ptile[e] = a; a += (cnt[e] + 255) >> 8; } ptile[32] = a;
        for (int i = 0; i < 4; ++i) { const int L = i * F.G + F.bid;
            if (L < 4 * a) { const int tl = L >> 2; int e = 0; while (ptile[e + 1] <= tl) ++e; ut[4 * i] = tl; ut[4 * i + 1] = e * 4 + (L & 3); ut[4 * i + 2] = 1; ut[4 * i + 3] = tl - ptile[e]; }
            else { ut[4 * i] = 0; ut[4 * i + 1] = 0; ut[4 * i + 2] = 0; ut[4 * i + 3] = 0; } }
    }
    __syncthreads();
    if (want_tok)
        for (int idx = F.tid; idx < 1024; idx += 512) { const int i = idx >> 8, r = idx & 255;
            if (ut[4 * i + 2]) { const int e = ut[4 * i + 1] >> 2; int p = 256 * ut[4 * i + 3] + r; if (p >= cnt[e]) p = 0; tokl[idx] = ETOK[e * T_TOK + p]; } else tokl[idx] = 0u; }
    __syncthreads();
}
struct EpiSwiGLU {
    static constexpr bool PERM = true, AFTER_DRAIN = false;
    bf16_t* HID;
    __device__ __forceinline__ void operator()(const pg8::f32x4 (&acc)[2][2][4][2], const pg8::Unit& u, int wr, int wc, int fr, int fq) const {
        bf16_t* base = HID + (size_t)(u.pm * 256 + 64 * wr + fr) * 512 + (u.pn & 3) * 128 + 32 * wc + 8 * fq;
#pragma unroll
        for (int ai = 0; ai < 2; ++ai)
#pragma unroll
            for (int m = 0; m < 4; ++m) { float o[8];
#pragma unroll
                for (int j = 0; j < 8; ++j) { const float gt = acc[ai][0][m][j >> 2][j & 3], up = acc[ai][1][m][j >> 2][j & 3]; o[j] = gt * __builtin_amdgcn_rcpf(1.f + __expf(-gt)) * up; }
                u32x4 w; w.x = pg8::cvt_pk_bf16(o[0], o[1]); w.y = pg8::cvt_pk_bf16(o[2], o[3]); w.z = pg8::cvt_pk_bf16(o[4], o[5]); w.w = pg8::cvt_pk_bf16(o[6], o[7]);
                *(u32x4*)(base + (size_t)(128 * ai + 16 * m) * 512) = w; }
    }
};
__device__ __forceinline__ void ph_moe_gateup(Frame& F) {
    moe_setup(F, true);
    pg8::Gemm g{(const bf16_t*)(F.ws + WS_H2), (const bf16_t*)(F.ws + WS_WGU_T), T_TOK, 32 * 1024, DM};
    MoeOrder S{(LAS const int*)(F.lds + ML_UT), (LAS const unsigned*)(F.lds + ML_TOK)};
    EpiSwiGLU E{(bf16_t*)(F.ws + WS_HID)};
    pg8::gemm_phase_gather<EpiSwiGLU, MoeOrder, true, true>(F.lds, g, S, E);
}
struct EpiDown {
    static constexpr bool PERM = true, AFTER_DRAIN = false;
    bf16_t* Y; const float* EGATE; LAS const int* ptile; LAS const int* cnt;
    __device__ __forceinline__ void operator()(const pg8::f32x4 (&acc)[2][2][4][2], const pg8::Unit& u, int wr, int wc, int fr, int fq) const {
        const int e = u.pn >> 2, p0 = 256 * (u.pm - ptile[e]) + 64 * wr + fr, ne = cnt[e];
        float gw[2][4];
#pragma unroll
        for (int ai = 0; ai < 2; ++ai)
#pragma unroll
            for (int m = 0; m < 4; ++m) { const int p = p0 + 128 * ai + 16 * m; gw[ai][m] = p < ne ? EGATE[e * T_TOK + p] : 0.f; }
        bf16_t* base = Y + (size_t)(u.pm * 256 + 64 * wr + fr) * DM + (u.pn & 3) * 256 + 64 * wc + 8 * fq;
#pragma unroll
        for (int ai = 0; ai < 2; ++ai)
#pragma unroll
            for (int m = 0; m < 4; ++m)
#pragma unroll
                for (int bj = 0; bj < 2; ++bj) { const pg8::f32x4 a = acc[ai][bj][m][0] * gw[ai][m], b = acc[ai][bj][m][1] * gw[ai][m];
                    u32x4 w; w.x = pg8::cvt_pk_bf16(a[0], a[1]); w.y = pg8::cvt_pk_bf16(a[2], a[3]); w.z = pg8::cvt_pk_bf16(b[0], b[1]); w.w = pg8::cvt_pk_bf16(b[2], b[3]);
                    *(u32x4*)(base + (size_t)(128 * ai + 16 * m) * DM + 32 * bj) = w; }
    }
};
__device__ __forceinline__ void ph_moe_down(Frame& F) {
    moe_setup(F, false);
    pg8::Gemm g{(const bf16_t*)(F.ws + WS_HID), (const bf16_t*)(F.ws + WS_WD_T), 40960, 32 * 1024, 512};
    MoeOrder S{(LAS const int*)(F.lds + ML_UT), (LAS const unsigned*)(F.lds + ML_TOK)};
    EpiDown E{(bf16_t*)(F.ws + WS_YBUF), (const float*)(F.ws + WS_EGATE), (LAS const int*)(F.lds + ML_PTILE), (LAS const int*)(F.lds + ML_CNT)};
    pg8::gemm_phase<EpiDown, MoeOrder, true, true>(F.lds, g, S, E);
}
__device__ __forceinline__ void ph_combine(Frame& F) {
    LAS int* ptile = (LAS int*)(F.lds + ML_PTILE);
    const unsigned* TLOC = (const unsigned*)(F.ws + WS_TLOC); const bf16_t* Y = (const bf16_t*)(F.ws + WS_YBUF);
    const int gw = F.bid * 8 + F.wave, NGW = F.G * 8;
    for (int t = gw; t < T_TOK; t += NGW) {
        const unsigned l0 = TLOC[t * 2], l1 = TLOC[t * 2 + 1];
        const size_t r0 = (size_t)(256 * ptile[l0 >> 16] + (int)(l0 & 0xffffu)), r1 = (size_t)(256 * ptile[l1 >> 16] + (int)(l1 & 0xffffu));
#pragma unroll
        for (int j = 0; j < 4; ++j) { const int c4 = F.lane + 64 * j; f32x4 v = ((const f32x4*)(F.out + (size_t)t * DM))[c4];
            const u32x2 a = ((const u32x2*)(Y + r0 * DM))[c4], b = ((const u32x2*)(Y + r1 * DM))[c4];
            v.x += bf2f(a.x & 0xffffu); v.y += bf2f(a.x >> 16); v.z += bf2f(a.y & 0xffffu); v.w += bf2f(a.y >> 16);
            v.x += bf2f(b.x & 0xffffu); v.y += bf2f(b.x >> 16); v.z += bf2f(b.y & 0xffffu); v.w += bf2f(b.y >> 16);
            ((f32x4*)(F.out + (size_t)t * DM))[c4] = v; }
    }
}

__global__ void __launch_bounds__(512, 2) fwd(Args args) {
    extern __shared__ __attribute__((aligned(16))) unsigned char lds_raw[];
    Frame F;
    F.lds = (LAS unsigned char*)lds_raw; F.tid = threadIdx.x; F.lane = F.tid & 63; F.wave = __builtin_amdgcn_readfirstlane(F.tid >> 6);
    F.G = gridDim.x; F.bid = blockIdx.x; F.in = args.in; F.out = args.out; F.ws = args.ws; F.ctl = (unsigned*)(args.ws + WS_CTL);
    for (int u = F.tid; u < (LDS_BYTES - LDSCTL_OFF) / 4; u += 512) ((LAS unsigned*)(F.lds + LDSCTL_OFF))[u] = 0u;
    __syncthreads();
    XcdBarrier bar = xcd_barrier_post(F.ctl + CW_BAR, (volatile LAS unsigned*)(F.lds + LDSCTL_OFF + 32));
    const int lo = args.ph_lo, hi = args.ph_hi;
#define IN(k) (lo <= (k) && (k) < hi)
#define SEAM(k) do { if (IN(k) && IN((k) + 1)) xcd_barrier(bar); } while (0)
    if (IN(0)) { ph_norm_in(F); ph_prep_weights(F); }
    SEAM(0);
    if (IN(1)) ph_proj_gemm(F);
    SEAM(1);
    if (IN(2)) ph_kmean_g_naive(F);
    SEAM(2);
    if (IN(3)) ph_mixers_naive(F);
    SEAM(3);
    if (IN(4)) ph_outproj_gemm(F);
    SEAM(4);
    if (IN(5)) ph_router(F);
    SEAM(5);
    if (IN(6)) ph_moe_gateup(F);
    SEAM(6);
    if (IN(7)) ph_moe_down(F);
    SEAM(7);
    if (IN(8)) { moe_setup(F, false); ph_combine(F); }
#undef IN
#undef SEAM
}

extern "C" void kernel_launch(void* const* d_in, const int* in_sizes, int n_in, void* d_out, int out_size, void* d_ws, size_t ws_size, hipStream_t stream) {
    static int grid = 0;
    if (grid == 0) {
        if (n_in != 22 || out_size != T_TOK * DM || ws_size < WS_END) { fprintf(stderr, "kernel_launch: unexpected shapes (n_in %d, out %d, ws %zu)\n", n_in, out_size, ws_size); grid = -1; return; }
        int dev = 0, cus = 0;
        if (hipGetDevice(&dev) != hipSuccess || hipDeviceGetAttribute(&cus, hipDeviceAttributeMultiprocessorCount, dev) != hipSuccess) { grid = -1; return; }
        if (hipFuncSetAttribute((const void*)fwd, hipFuncAttributeMaxDynamicSharedMemorySize, LDS_BYTES) != hipSuccess) { grid = -1; return; }
        int per_cu = 0;
        (void)hipOccupancyMaxActiveBlocksPerMultiprocessor(&per_cu, (const void*)fwd, 512, LDS_BYTES);
        (void)hipGetLastError();
        grid = cus;
    }
    if (grid < 0) return;
    (void)hipMemsetAsync((char*)d_ws + WS_CTL, 0, CTL_ZERO_BYTES, stream);
    Args a{};
    for (int i = 0; i < 22; ++i) a.in[i] = (const float*)d_in[i];
    a.out = (float*)d_out; a.ws = (unsigned char*)d_ws; a.ph_lo = 0; a.ph_hi = 9;
    hipLaunchKernelGGL(fwd, dim3(grid), dim3(512), LDS_BYTES, stream, a);
}
```

```cpp
#include <hip/hip_runtime.h>
#include <cstdio>
#include <cstdint>

#define LAS __attribute__((address_space(3)))
#define GAS __attribute__((address_space(1)))
typedef unsigned short bf16_t;
typedef float f32x4 __attribute__((ext_vector_type(4)));
typedef unsigned u32x4 __attribute__((ext_vector_type(4)));
typedef unsigned u32x2 __attribute__((ext_vector_type(2)));

constexpr int T_TOK = 16384, SEQ = 8192, DM = 1024, DIN = 2576, NMEM = 256;
constexpr int PROJ_LD = 2560;
constexpr int C_GQ = 0, C_GK = 256, C_GV = 512, C_GR = 1024, C_MBQ = 1536, C_MBK = 1792, C_MBV = 2048, C_MEMQ = 2304;
constexpr float EPS = 1e-6f;
constexpr float LOG2E = 1.4426950408889634f;
constexpr float C2 = 0.125f * LOG2E;

constexpr size_t MiB = 1u << 20;
constexpr size_t WS_CTL = 0, CTL_ZERO_BYTES = 1 * MiB;
constexpr size_t WS_LR = 1 * MiB;
constexpr size_t WS_MEMKV = 2 * MiB;
constexpr size_t WS_ETOK = 3 * MiB;
constexpr size_t WS_EGATE = 5 * MiB;
constexpr size_t WS_TLOC = 7 * MiB;
constexpr size_t WS_MLIST = 8 * MiB;
constexpr size_t WS_PML = 12 * MiB;
constexpr size_t WS_PO = 242 * MiB;
constexpr size_t WS_WOUT_T = 16 * MiB;
constexpr size_t WS_WGU_T = 18 * MiB;
constexpr size_t WS_WD_T = 82 * MiB;
constexpr size_t WS_WIN_T = 227 * MiB;
constexpr size_t WS_PROJ = 114 * MiB;
constexpr size_t WS_XN = 194 * MiB;
constexpr size_t WS_MIX = 194 * MiB;
constexpr size_t WS_H2 = 114 * MiB;
constexpr size_t WS_HID = 146 * MiB;
constexpr size_t WS_YBUF = 186 * MiB;
constexpr size_t WS_DEC = 14 * MiB;
constexpr size_t WS_DS = 194 * MiB;
constexpr size_t WS_SP = 226 * MiB;
constexpr size_t WS_END = 266 * MiB;
constexpr int CW_BAR = 4096;
constexpr int CW_ECNT = 8192;
constexpr int CW_MCNT = 12288;
constexpr int CW_KMEAN = 16384;

constexpr int LDS_BYTES = 147456;
constexpr int LDSCTL_OFF = 131072;

__device__ __forceinline__ unsigned f2bf(float f) { unsigned u = __builtin_bit_cast(unsigned, f); return (u + 0x7fffu + ((u >> 16) & 1u)) >> 16; }
__device__ __forceinline__ float bf2f(unsigned h) { return __builtin_bit_cast(float, h << 16); }
__device__ __forceinline__ unsigned pk2(float lo, float hi) { return f2bf(lo) | (f2bf(hi) << 16); }
__device__ __forceinline__ float wave_sum(float v) {
#pragma unroll
    for (int o = 1; o < 64; o <<= 1) v += __shfl_xor(v, o);
    return v;
}
__device__ __forceinline__ float silu_f(float x) { return x / (1.f + __expf(-x)); }

#define XB_TMO      128
#define XB_XCNT(j)  (256  + 64 * (j))
#define XB_XSUB(j)  (1280 + 64 * (j))
#define XB_XGEN(j)  (2304 + 64 * (j))
#define XB_TOP      3328
#define XB_TOPGEN   3392
#define XCD_BAR_WORDS 3456
#define XB_SPIN_CAP (1u << 18)
__device__ __forceinline__ unsigned xb_ld(unsigned* p)              { return __hip_atomic_load(p, __ATOMIC_RELAXED, __HIP_MEMORY_SCOPE_AGENT); }
__device__ __forceinline__ unsigned xb_add(unsigned* p, unsigned v) { return __hip_atomic_fetch_add(p, v, __ATOMIC_RELAXED, __HIP_MEMORY_SCOPE_AGENT); }
__device__ __forceinline__ unsigned xb_xcc_id() { return (unsigned)__builtin_amdgcn_s_getreg((3 << 11) | 20) & 0xFu; }
#define XB_SPIN(cond, bar) do { unsigned _sp = 0; while (cond) { __builtin_amdgcn_s_sleep(1); \
    if ((++_sp & 255u) == 0u) { if (xb_ld(&(bar)[XB_TMO])) break; if (_sp > XB_SPIN_CAP) { atomicAdd(&(bar)[XB_TMO], 1u); break; } } } } while (0)
struct XcdBarrier { unsigned* bar; unsigned x; volatile LAS unsigned* st; };
__device__ __forceinline__ XcdBarrier xcd_barrier_post(unsigned* bar, volatile LAS unsigned* st) {
    XcdBarrier b; b.bar = bar; b.x = xb_xcc_id(); b.st = st;
    if (threadIdx.x == 0) (void)xb_add(&bar[XB_XCNT(b.x)], 1u);
    return b;
}
__device__ __forceinline__ void xcd_barrier_complete(unsigned* bar, unsigned x, unsigned& nloc, unsigned& nx) {
    const unsigned G = gridDim.x * gridDim.y * gridDim.z;
    unsigned sum, cnt, mine, sp = 0u;
    for (;;) {
        sum = 0u; cnt = 0u; mine = 0u;
#pragma unroll
        for (unsigned j = 0; j < 16; ++j) { const unsigned c = xb_ld(&bar[XB_XCNT(j)]); sum += c; cnt += (c > 0u) ? 1u : 0u; mine = (j == x) ? c : mine; }
        if (sum == G) break;
        __builtin_amdgcn_s_sleep(1);
        if ((++sp & 255u) == 0u) { if (xb_ld(&bar[XB_TMO])) break; if (sp > XB_SPIN_CAP) { atomicAdd(&bar[XB_TMO], 1u); break; } }
    }
    nloc = mine > 0u ? mine : 1u; nx = cnt > 0u ? cnt : 1u;
}
__device__ __forceinline__ void xcd_barrier(const XcdBarrier& b) {
    asm volatile("s_waitcnt vmcnt(0)" ::: "memory");
    __syncthreads();
    if (threadIdx.x == 0) {
        unsigned* bar = b.bar;
        __builtin_amdgcn_s_waitcnt(0);
        unsigned nloc = b.st[0], nx = b.st[1];
        if (nloc == 0u) { xcd_barrier_complete(bar, b.x, nloc, nx); b.st[0] = nloc; b.st[1] = nx; }
        const unsigned old = xb_add(&bar[XB_XSUB(b.x)], 1u);
        const unsigned gen = old / nloc;
        if (old + 1u == (gen + 1u) * nloc) {
            __builtin_amdgcn_fence(__ATOMIC_RELEASE, "agent");
            asm volatile("s_waitcnt vmcnt(0)" ::: "memory");
            const unsigned og = xb_add(&bar[XB_TOP], 1u);
            const unsigned tg = og / nx;
            if (og + 1u == (tg + 1u) * nx) xb_add(&bar[XB_TOPGEN], 1u);
            else XB_SPIN(xb_ld(&bar[XB_TOPGEN]) == tg, bar);
            __builtin_amdgcn_fence(__ATOMIC_ACQUIRE, "agent");
            xb_add(&bar[XB_XGEN(b.x)], 1u);
            asm volatile("s_waitcnt vmcnt(0)" ::: "memory");
        } else {
            XB_SPIN(xb_ld(&bar[XB_XGEN(b.x)]) == gen, bar);
            __builtin_amdgcn_fence(__ATOMIC_ACQUIRE, "agent");
            asm volatile("s_waitcnt vmcnt(0)" ::: "memory");
        }
    }
    __syncthreads();
}

namespace pg8 {
#define PG8_LAS __attribute__((address_space(3)))
typedef unsigned short bf16_t;
typedef short bf16x8 __attribute__((ext_vector_type(8)));
typedef float f32x4 __attribute__((ext_vector_type(4)));
typedef unsigned u32x4 __attribute__((ext_vector_type(4)));
constexpr int BM = 256, BK = 64, HALF = 128, HTB = HALF * BK * 2  , STAGE_BYTES = 8 * HTB, NXCD = 8, WGM = 8;

__host__ __device__ __forceinline__ int lds_byte(int r, int c) { const int st = (r >> 4) * 2 + (c >> 5), rr = r & 15, cc = c & 31, ob = rr * 64 + cc * 2; return st * 1024 + (ob ^ (((ob >> 9) & 1) << 5)); }
__host__ __device__ __forceinline__ void stage_rc(int b, int& R, int& C) { const int st = b / 1024, sb = b % 1024, swz = sb ^ (((sb >> 9) & 1) << 5); R = (st >> 1) * 16 + swz / 64; C = (st & 1) * 32 + (swz % 64) / 2; }
__host__ __device__ __forceinline__ int perm32(int rho) { const int n = rho >> 4, i = rho & 15; return 8 * (i >> 2) + 4 * n + (i & 3); }

struct Unit { int pm, pn, aux; };
struct Gemm { const bf16_t* A; const bf16_t* Bt; int M, N, K; };

struct StaticOrder {
    int nM, nN, nwg, G, c;
    __host__ __device__ void init(int M, int N, int G_, int c_) { nM = M / BM; nN = N / BM; nwg = nM * nN; G = G_; c = c_; }
    __host__ __device__ bool next(int i, Unit& u) const {
        const long L = (long)i * G + c; if (L >= nwg) return false;
        int wgid = (int)L; { const int q = nwg / NXCD, r = nwg % NXCD, xcd = wgid % NXCD, off = wgid / NXCD; wgid = (xcd < r ? xcd * (q + 1) : r * (q + 1) + (xcd - r) * q) + off; }
        const int nig = WGM * nN, gid = wgid / nig, fm = gid * WGM, gsz = (nM - fm) < WGM ? (nM - fm) : WGM;
        u.pm = fm + ((wgid % nig) % gsz); u.pn = (wgid % nig) / gsz; u.aux = 0; return true;
    }
    __device__ __forceinline__ void a_ready(const Unit&) const {}
    __device__ __forceinline__ void done(const Unit&) const {}
};

__device__ __forceinline__ unsigned cvt_pk_bf16(float lo, float hi) { unsigned r; asm volatile("v_cvt_pk_bf16_f32 %0, %1, %2" : "=v"(r) : "v"(lo), "v"(hi)); return r; }
typedef float f32x2 __attribute__((ext_vector_type(2)));

template <class Epi, class Sched, bool ALIGN_EPI = false, bool SP2 = false>
__device__ __forceinline__ void gemm_phase(PG8_LAS unsigned char* lds, const Gemm g, const Sched& S, const Epi& E) {
    const int tid = threadIdx.x, wid = __builtin_amdgcn_readfirstlane(tid >> 6), lane = tid & 63, wr = wid >> 2, wc = wid & 3, fr = lane & 15, fq = lane >> 4;
    const int K = g.K, nt = K / BK;
    unsigned voffA[2], voffB[2];
#pragma unroll
    for (int i = 0; i < 2; ++i) { int R, C; stage_rc(tid * 16 + i * 8192, R, C); const int Rb = Epi::PERM ? ((R & ~31) + perm32(R & 31)) : R;
        voffA[i] = (unsigned)(R * K + C) * 2u; voffB[i] = (unsigned)(Rb * K + C) * 2u; }
    const size_t kstep = (size_t)(BK * 2);
    const size_t hstep = (size_t)HALF * K * 2;
    const size_t tstep = 2 * hstep;
    const unsigned ldsw = (unsigned)wid * 1024u;
    const int aoff = lds_byte(wr * 64 + fr, fq * 8), boff = lds_byte(wc * 32 + fr, fq * 8);
#define PG8_SA(b, h) (((b) * 2 + (h)) * HTB)
#define PG8_SB(b, h) ((4 + (b) * 2 + (h)) * HTB)
#define PG8_STAGE(bufoff, gbase, voff) do { _Pragma("unroll") for (int _i = 0; _i < 2; ++_i) \
        __builtin_amdgcn_global_load_lds((const unsigned*)((const char*)(gbase) + (voff)[_i]), (PG8_LAS unsigned*)(lds + (bufoff) + ldsw + _i * 8192), 16, 0, 0); } while (0)
#define PG8_LDA(dst, b, h) do { _Pragma("unroll") for (int m = 0; m < 4; ++m) _Pragma("unroll") for (int k = 0; k < 2; ++k) dst[m][k] = *(const PG8_LAS bf16x8*)(lds + PG8_SA(b, h) + aoff + m * 2048 + k * 1024); } while (0)
#define PG8_LDB(dst, b, h) do { _Pragma("unroll") for (int n = 0; n < 2; ++n) _Pragma("unroll") for (int k = 0; k < 2; ++k) dst[n][k] = *(const PG8_LAS bf16x8*)(lds + PG8_SB(b, h) + boff + n * 2048 + k * 1024); } while (0)
#define PG8_MMA(ai, bj, At, Bt) do { __builtin_amdgcn_s_setprio(1); _Pragma("unroll") for (int m = 0; m < 4; ++m) _Pragma("unroll") for (int n = 0; n < 2; ++n) _Pragma("unroll") for (int k = 0; k < 2; ++k) \
        acc[ai][bj][m][n] = __builtin_amdgcn_mfma_f32_16x16x32_bf16(Bt[n][k], At[m][k], acc[ai][bj][m][n], 0, 0, 0); __builtin_amdgcn_s_setprio(0); } while (0)
#define PG8_WAIT_V(n) asm volatile("s_waitcnt vmcnt(" #n ")" ::: "memory")
#define PG8_WAIT_L(n) asm volatile("s_waitcnt lgkmcnt(" #n ")" ::: "memory")
#define PG8_BAR __builtin_amdgcn_s_barrier()
#define PG8_SCHED __builtin_amdgcn_sched_barrier(0)
    Unit cur, nxt; int ui = 0;
    if (!S.next(0, cur)) return;
    f32x4 acc[2][2][4][2];
#pragma unroll
    for (int a = 0; a < 2; ++a)
#pragma unroll
        for (int b = 0; b < 2; ++b)
#pragma unroll
            for (int m = 0; m < 4; ++m)
#pragma unroll
                for (int n = 0; n < 2; ++n) acc[a][b][m][n] = (f32x4){0.f, 0.f, 0.f, 0.f};
    bf16x8 At[4][2], B0[2][2], B1[2][2];
    const char* cA = (const char*)g.A + (size_t)cur.pm * tstep; const char* cB = (const char*)g.Bt + (size_t)cur.pn * tstep;
    S.a_ready(cur);
    if constexpr (SP2) {
        PG8_STAGE(PG8_SB(0, 0), cB, voffB); PG8_STAGE(PG8_SB(0, 1), cB + hstep, voffB); PG8_STAGE(PG8_SA(0, 0), cA, voffA); PG8_STAGE(PG8_SA(0, 1), cA + hstep, voffA);
        if (wr == 1) PG8_BAR;
        PG8_WAIT_V(2); PG8_BAR;
        PG8_STAGE(PG8_SB(1, 0), cB + kstep, voffB); PG8_STAGE(PG8_SA(1, 0), cA + kstep, voffA); PG8_STAGE(PG8_SB(1, 1), cB + hstep + kstep, voffB);
        PG8_WAIT_V(6); PG8_BAR;
    } else {
        PG8_STAGE(PG8_SB(0, 0), cB, voffB); PG8_STAGE(PG8_SA(0, 0), cA, voffA); PG8_STAGE(PG8_SB(0, 1), cB + hstep, voffB); PG8_STAGE(PG8_SA(0, 1), cA + hstep, voffA);
        if (wr == 1) PG8_BAR;
        PG8_WAIT_V(4); PG8_BAR;
        PG8_STAGE(PG8_SB(1, 0), cB + kstep, voffB); PG8_STAGE(PG8_SA(1, 0), cA + kstep, voffA); PG8_STAGE(PG8_SB(1, 1), cB + hstep + kstep, voffB);
        PG8_WAIT_V(6); PG8_BAR;
    }
    for (;;) {
        const bool has_next = S.next(ui + 1, nxt);
        const char* nA = has_next ? (const char*)g.A + (size_t)nxt.pm * tstep : cA; const char* nB = has_next ? (const char*)g.Bt + (size_t)nxt.pn * tstep : cB;
        for (int t = 0; t < nt; t += 2) {
            const bool last = (t == nt - 2);
            const char* a1 = cA + (size_t)(t + 1) * kstep;
            const char* a2 = last ? nA : cA + (size_t)(t + 2) * kstep; const char* b2 = last ? nB : cB + (size_t)(t + 2) * kstep;
            const char* a3 = a2 + kstep; const char* b3 = b2 + kstep;
            if (last && has_next) S.a_ready(nxt);
            if constexpr (SP2) {
            PG8_LDB(B0, 0, 0); PG8_LDB(B1, 0, 1); PG8_SCHED; PG8_LDA(At, 0, 0); PG8_STAGE(PG8_SA(1, 1), a1 + hstep, voffA);
            PG8_WAIT_V(8); PG8_WAIT_L(0); PG8_BAR; PG8_MMA(0, 0, At, B0); PG8_MMA(0, 1, At, B1); PG8_BAR; PG8_SCHED;
            PG8_LDA(At, 0, 1); PG8_STAGE(PG8_SB(0, 0), b2, voffB); PG8_STAGE(PG8_SB(0, 1), b2 + hstep, voffB); PG8_STAGE(PG8_SA(0, 0), a2, voffA);
            PG8_WAIT_V(8); PG8_WAIT_L(0); PG8_BAR; PG8_MMA(1, 0, At, B0); PG8_MMA(1, 1, At, B1); PG8_BAR; PG8_SCHED;
            PG8_LDB(B0, 1, 0); PG8_LDB(B1, 1, 1); PG8_SCHED; PG8_LDA(At, 1, 0); PG8_STAGE(PG8_SA(0, 1), a2 + hstep, voffA);
            PG8_WAIT_V(8); PG8_WAIT_L(0); PG8_BAR; PG8_MMA(0, 0, At, B0); PG8_MMA(0, 1, At, B1); PG8_BAR; PG8_SCHED;
            PG8_LDA(At, 1, 1); PG8_STAGE(PG8_SB(1, 0), b3, voffB); PG8_STAGE(PG8_SB(1, 1), b3 + hstep, voffB); PG8_STAGE(PG8_SA(1, 0), a3, voffA);
            PG8_WAIT_V(8); PG8_WAIT_L(0); PG8_BAR; PG8_MMA(1, 0, At, B0); PG8_MMA(1, 1, At, B1); PG8_BAR; PG8_SCHED;
            } else {
            PG8_LDB(B0, 0, 0); PG8_SCHED; PG8_LDA(At, 0, 0); PG8_STAGE(PG8_SA(1, 1), a1 + hstep, voffA);
            PG8_WAIT_L(8); PG8_BAR; PG8_WAIT_L(0); PG8_MMA(0, 0, At, B0); PG8_BAR; PG8_SCHED;
            PG8_LDB(B1, 0, 1); PG8_STAGE(PG8_SB(0, 0), b2, voffB);
            PG8_BAR; PG8_WAIT_L(0); PG8_MMA(0, 1, At, B1); PG8_BAR;
            PG8_LDA(At, 0, 1); PG8_STAGE(PG8_SA(0, 0), a2, voffA);
            PG8_BAR; PG8_WAIT_L(0); PG8_MMA(1, 0, At, B0); PG8_BAR; PG8_SCHED;
            PG8_STAGE(PG8_SB(0, 1), b2 + hstep, voffB);
            PG8_WAIT_V(6); PG8_BAR; PG8_MMA(1, 1, At, B1); PG8_BAR;
            PG8_LDB(B0, 1, 0); PG8_SCHED; PG8_LDA(At, 1, 0); PG8_STAGE(PG8_SA(0, 1), a2 + hstep, voffA);
            PG8_WAIT_L(8); PG8_BAR; PG8_WAIT_L(0); PG8_MMA(0, 0, At, B0); PG8_BAR; PG8_SCHED;
            PG8_LDB(B1, 1, 1); PG8_STAGE(PG8_SB(1, 0), b3, voffB);
            PG8_BAR; PG8_WAIT_L(0); PG8_MMA(0, 1, At, B1); PG8_BAR;
            PG8_LDA(At, 1, 1); PG8_STAGE(PG8_SA(1, 0), a3, voffA);
            PG8_BAR; PG8_WAIT_L(0); PG8_MMA(1, 0, At, B0); PG8_BAR; PG8_SCHED;
            PG8_STAGE(PG8_SB(1, 1), b3 + hstep, voffB);
            PG8_WAIT_V(6); PG8_BAR; PG8_MMA(1, 1, At, B1); PG8_BAR;
            }
        }
        if constexpr (ALIGN_EPI) { if (wr == 0) PG8_BAR; }
        if constexpr (!Epi::AFTER_DRAIN) { E(acc, cur, wr, wc, fr, fq); S.done(cur); }
        if (!has_next) break;
#pragma unroll
        for (int a = 0; a < 2; ++a)
#pragma unroll
            for (int b = 0; b < 2; ++b)
#pragma unroll
                for (int m = 0; m < 4; ++m)
#pragma unroll
                    for (int n = 0; n < 2; ++n) acc[a][b][m][n] = (f32x4){0.f, 0.f, 0.f, 0.f};
        cur = nxt; cA = nA; cB = nB; ++ui;
        if constexpr (ALIGN_EPI) { if (wr == 1) PG8_BAR; }
    }
    PG8_WAIT_V(0);
    if constexpr (!ALIGN_EPI) { if (wr == 0) PG8_BAR; }
    PG8_BAR;
    if constexpr (Epi::AFTER_DRAIN) { E.fused(acc, cur, wr, wc, fr, fq, lds, wid, lane); S.done(cur); }
#undef PG8_SA
#undef PG8_SB
#undef PG8_STAGE
#undef PG8_LDA
#undef PG8_LDB
#undef PG8_MMA
#undef PG8_WAIT_V
#undef PG8_WAIT_L
#undef PG8_BAR
#undef PG8_SCHED
}
template <class Epi, class Sched, bool ALIGN_EPI = false, bool SP2 = false>
__device__ __forceinline__ void gemm_phase_gather(PG8_LAS unsigned char* lds, const Gemm g, const Sched& S, const Epi& E) {
    const int tid = threadIdx.x, wid = __builtin_amdgcn_readfirstlane(tid >> 6), lane = tid & 63, wr = wid >> 2, wc = wid & 3, fr = lane & 15, fq = lane >> 4;
    const int K = g.K, nt = K / BK;
    unsigned voffA[2], voffB[2]; int RA[2];
#pragma unroll
    for (int i = 0; i < 2; ++i) { int R, C; stage_rc(tid * 16 + i * 8192, R, C); const int Rb = Epi::PERM ? ((R & ~31) + perm32(R & 31)) : R;
        RA[i] = R; voffA[i] = (unsigned)C * 2u; voffB[i] = (unsigned)(Rb * K + C) * 2u; }
    const size_t kstep = (size_t)(BK * 2);
    const size_t hstep = (size_t)HALF * K * 2;
    const size_t tstep = 2 * hstep;
    const unsigned ldsw = (unsigned)wid * 1024u;
    const int aoff = lds_byte(wr * 64 + fr, fq * 8), boff = lds_byte(wc * 32 + fr, fq * 8);
#define PG8_SA(b, h) (((b) * 2 + (h)) * HTB)
#define PG8_SB(b, h) ((4 + (b) * 2 + (h)) * HTB)
#define PG8_STAGE(bufoff, gbase, voff) do { _Pragma("unroll") for (int _i = 0; _i < 2; ++_i) \
        __builtin_amdgcn_global_load_lds((const unsigned*)((const char*)(gbase) + (voff)[_i]), (PG8_LAS unsigned*)(lds + (bufoff) + ldsw + _i * 8192), 16, 0, 0); } while (0)
#define PG8_LDA(dst, b, h) do { _Pragma("unroll") for (int m = 0; m < 4; ++m) _Pragma("unroll") for (int k = 0; k < 2; ++k) dst[m][k] = *(const PG8_LAS bf16x8*)(lds + PG8_SA(b, h) + aoff + m * 2048 + k * 1024); } while (0)
#define PG8_LDB(dst, b, h) do { _Pragma("unroll") for (int n = 0; n < 2; ++n) _Pragma("unroll") for (int k = 0; k < 2; ++k) dst[n][k] = *(const PG8_LAS bf16x8*)(lds + PG8_SB(b, h) + boff + n * 2048 + k * 1024); } while (0)
#define PG8_MMA(ai, bj, At, Bt) do { __builtin_amdgcn_s_setprio(1); _Pragma("unroll") for (int m = 0; m < 4; ++m) _Pragma("unroll") for (int n = 0; n < 2; ++n) _Pragma("unroll") for (int k = 0; k < 2; ++k) \
        acc[ai][bj][m][n] = __builtin_amdgcn_mfma_f32_16x16x32_bf16(Bt[n][k], At[m][k], acc[ai][bj][m][n], 0, 0, 0); __builtin_amdgcn_s_setprio(0); } while (0)
#define PG8_WAIT_V(n) asm volatile("s_waitcnt vmcnt(" #n ")" ::: "memory")
#define PG8_WAIT_L(n) asm volatile("s_waitcnt lgkmcnt(" #n ")" ::: "memory")
#define PG8_BAR __builtin_amdgcn_s_barrier()
#define PG8_SCHED __builtin_amdgcn_sched_barrier(0)
    Unit cur, nxt; int ui = 0;
    if (!S.next(0, cur)) return;
    f32x4 acc[2][2][4][2];
#pragma unroll
    for (int a = 0; a < 2; ++a)
#pragma unroll
        for (int b = 0; b < 2; ++b)
#pragma unroll
            for (int m = 0; m < 4; ++m)
#pragma unroll
                for (int n = 0; n < 2; ++n) acc[a][b][m][n] = (f32x4){0.f, 0.f, 0.f, 0.f};
    bf16x8 At[4][2], B0[2][2], B1[2][2];
    const char* cA = (const char*)g.A; unsigned cvo0[2], cvo1[2], nvo0[2], nvo1[2];
    _Pragma("unroll") for (int i = 0; i < 2; ++i) { cvo0[i] = S.arow(cur, RA[i]) * (unsigned)(K * 2) + voffA[i]; cvo1[i] = S.arow(cur, HALF + RA[i]) * (unsigned)(K * 2) + voffA[i]; }
    const char* cB = (const char*)g.Bt + (size_t)cur.pn * tstep;
    S.a_ready(cur);
    if constexpr (SP2) {
        PG8_STAGE(PG8_SB(0, 0), cB, voffB); PG8_STAGE(PG8_SB(0, 1), cB + hstep, voffB); PG8_STAGE(PG8_SA(0, 0), cA, cvo0); PG8_STAGE(PG8_SA(0, 1), cA, cvo1);
        if (wr == 1) PG8_BAR;
        PG8_WAIT_V(2); PG8_BAR;
        PG8_STAGE(PG8_SB(1, 0), cB + kstep, voffB); PG8_STAGE(PG8_SA(1, 0), cA + kstep, cvo0); PG8_STAGE(PG8_SB(1, 1), cB + hstep + kstep, voffB);
        PG8_WAIT_V(6); PG8_BAR;
    } else {
        PG8_STAGE(PG8_SB(0, 0), cB, voffB); PG8_STAGE(PG8_SA(0, 0), cA, cvo0); PG8_STAGE(PG8_SB(0, 1), cB + hstep, voffB); PG8_STAGE(PG8_SA(0, 1), cA, cvo1);
        if (wr == 1) PG8_BAR;
        PG8_WAIT_V(4); PG8_BAR;
        PG8_STAGE(PG8_SB(1, 0), cB + kstep, voffB); PG8_STAGE(PG8_SA(1, 0), cA + kstep, cvo0); PG8_STAGE(PG8_SB(1, 1), cB + hstep + kstep, voffB);
        PG8_WAIT_V(6); PG8_BAR;
    }
    for (;;) {
        const bool has_next = S.next(ui + 1, nxt);
        _Pragma("unroll") for (int i = 0; i < 2; ++i) { nvo0[i] = has_next ? S.arow(nxt, RA[i]) * (unsigned)(K * 2) + voffA[i] : cvo0[i]; nvo1[i] = has_next ? S.arow(nxt, HALF + RA[i]) * (unsigned)(K * 2) + voffA[i] : cvo1[i]; }
        const char* nB = has_next ? (const char*)g.Bt + (size_t)nxt.pn * tstep : cB;
        for (int t = 0; t < nt; t += 2) {
            const bool last = (t == nt - 2);
            const char* a1 = cA + (size_t)(t + 1) * kstep;
            const char* a2 = last ? cA : cA + (size_t)(t + 2) * kstep; unsigned xo0[2], xo1[2]; _Pragma("unroll") for (int i = 0; i < 2; ++i) { xo0[i] = last ? nvo0[i] : cvo0[i]; xo1[i] = last ? nvo1[i] : cvo1[i]; } const char* b2 = last ? nB : cB + (size_t)(t + 2) * kstep;
            const char* a3 = a2 + kstep; const char* b3 = b2 + kstep;
            if (last && has_next) S.a_ready(nxt);
            if constexpr (SP2) {
            PG8_LDB(B0, 0, 0); PG8_LDB(B1, 0, 1); PG8_SCHED; PG8_LDA(At, 0, 0); PG8_STAGE(PG8_SA(1, 1), a1, cvo1);
            PG8_WAIT_V(8); PG8_WAIT_L(0); PG8_BAR; PG8_MMA(0, 0, At, B0); PG8_MMA(0, 1, At, B1); PG8_BAR; PG8_SCHED;
            PG8_LDA(At, 0, 1); PG8_STAGE(PG8_SB(0, 0), b2, voffB); PG8_STAGE(PG8_SB(0, 1), b2 + hstep, voffB); PG8_STAGE(PG8_SA(0, 0), a2, xo0);
            PG8_WAIT_V(8); PG8_WAIT_L(0); PG8_BAR; PG8_MMA(1, 0, At, B0); PG8_MMA(1, 1, At, B1); PG8_BAR; PG8_SCHED;
            PG8_LDB(B0, 1, 0); PG8_LDB(B1, 1, 1); PG8_SCHED; PG8_LDA(At, 1, 0); PG8_STAGE(PG8_SA(0, 1), a2, xo1);
            PG8_WAIT_V(8); PG8_WAIT_L(0); PG8_BAR; PG8_MMA(0, 0, At, B0); PG8_MMA(0, 1, At, B1); PG8_BAR; PG8_SCHED;
            PG8_LDA(At, 1, 1); PG8_STAGE(PG8_SB(1, 0), b3, voffB); PG8_STAGE(PG8_SB(1, 1), b3 + hstep, voffB); PG8_STAGE(PG8_SA(1, 0), a3, xo0);
            PG8_WAIT_V(8); PG8_WAIT_L(0); PG8_BAR; PG8_MMA(1, 0, At, B0); PG8_MMA(1, 1, At, B1); PG8_BAR; PG8_SCHED;
            } else {
            PG8_LDB(B0, 0, 0); PG8_SCHED; PG8_LDA(At, 0, 0); PG8_STAGE(PG8_SA(1, 1), a1, cvo1);
            PG8_WAIT_L(8); PG8_BAR; PG8_WAIT_L(0); PG8_MMA(0, 0, At, B0); PG8_BAR; PG8_SCHED;
            PG8_LDB(B1, 0, 1); PG8_STAGE(PG8_SB(0, 0), b2, voffB);
            PG8_BAR; PG8_WAIT_L(0); PG8_MMA(0, 1, At, B1); PG8_BAR;
            PG8_LDA(At, 0, 1); PG8_STAGE(PG8_SA(0, 0), a2, xo0);
            PG8_BAR; PG8_WAIT_L(0); PG8_MMA(1, 0, At, B0); PG8_BAR; PG8_SCHED;
            PG8_STAGE(PG8_SB(0, 1), b2 + hstep, voffB);
            PG8_WAIT_V(6); PG8_BAR; PG8_MMA(1, 1, At, B1); PG8_BAR;
            PG8_LDB(B0, 1, 0); PG8_SCHED; PG8_LDA(At, 1, 0); PG8_STAGE(PG8_SA(0, 1), a2, xo1);
            PG8_WAIT_L(8); PG8_BAR; PG8_WAIT_L(0); PG8_MMA(0, 0, At, B0); PG8_BAR; PG8_SCHED;
            PG8_LDB(B1, 1, 1); PG8_STAGE(PG8_SB(1, 0), b3, voffB);
            PG8_BAR; PG8_WAIT_L(0); PG8_MMA(0, 1, At, B1); PG8_BAR;
            PG8_LDA(At, 1, 1); PG8_STAGE(PG8_SA(1, 0), a3, xo0);
            PG8_BAR; PG8_WAIT_L(0); PG8_MMA(1, 0, At, B0); PG8_BAR; PG8_SCHED;
            PG8_STAGE(PG8_SB(1, 1), b3 + hstep, voffB);
            PG8_WAIT_V(6); PG8_BAR; PG8_MMA(1, 1, At, B1); PG8_BAR;
            }
        }
        if constexpr (ALIGN_EPI) { if (wr == 0) PG8_BAR; }
        if constexpr (!Epi::AFTER_DRAIN) { E(acc, cur, wr, wc, fr, fq); S.done(cur); }
        if (!has_next) break;
#pragma unroll
        for (int a = 0; a < 2; ++a)
#pragma unroll
            for (int b = 0; b < 2; ++b)
#pragma unroll
                for (int m = 0; m < 4; ++m)
#pragma unroll
                    for (int n = 0; n < 2; ++n) acc[a][b][m][n] = (f32x4){0.f, 0.f, 0.f, 0.f};
        cur = nxt; cB = nB; ++ui; _Pragma("unroll") for (int i = 0; i < 2; ++i) { cvo0[i] = nvo0[i]; cvo1[i] = nvo1[i]; }
        if constexpr (ALIGN_EPI) { if (wr == 1) PG8_BAR; }
    }
    PG8_WAIT_V(0);
    if constexpr (!ALIGN_EPI) { if (wr == 0) PG8_BAR; }
    PG8_BAR;
    if constexpr (Epi::AFTER_DRAIN) { E.fused(acc, cur, wr, wc, fr, fq, lds, wid, lane); S.done(cur); }
#undef PG8_SA
#undef PG8_SB
#undef PG8_STAGE
#undef PG8_LDA
#undef PG8_LDB
#undef PG8_MMA
#undef PG8_WAIT_V
#undef PG8_WAIT_L
#undef PG8_BAR
#undef PG8_SCHED
}
}

struct Args {
    const float* in[22];
    float* out; unsigned char* ws;
    int ph_lo, ph_hi;
};
enum { I_X = 0, I_MEM, I_ATTN_G, I_MEM_G, I_WIN, I_WGK, I_BGK, I_GLA_OG, I_MBQ_G, I_MBK_G, I_WMEMKV, I_MEMQ_G, I_MEMK_G, I_WOUT, I_FFN_G,
       I_WRG, I_BRG, I_WRE, I_BRE, I_WGATE, I_WUP, I_WDOWN };

struct Frame {
    LAS unsigned char* lds; int tid, lane, wave, G, bid;
    const float* const* in; float* out; unsigned char* ws; unsigned* ctl;
};

__device__ __forceinline__ void ph_norm_in(Frame& F) {
    bf16_t* XN = (bf16_t*)(F.ws + WS_XN); float* LR = (float*)(F.ws + WS_LR);
    const int gw = F.bid * 8 + F.wave, NGW = F.G * 8;
    for (int r = gw; r < T_TOK + 512; r += NGW) {
        const float* src = r < T_TOK ? F.in[I_X] + (size_t)r * DM : F.in[I_MEM] + (size_t)(r - T_TOK) * DM;
        const float* g = r < T_TOK ? F.in[I_ATTN_G] : F.in[I_MEM_G];
        f32x4 v[4]; float ss = 0.f;
#pragma unroll
        for (int j = 0; j < 4; ++j) { v[j] = ((const f32x4*)src)[F.lane + 64 * j]; ss += v[j].x * v[j].x + v[j].y * v[j].y + v[j].z * v[j].z + v[j].w * v[j].w; }
        const float rstd = rsqrtf(wave_sum(ss) * (1.f / DM) + EPS);
#pragma unroll
        for (int j = 0; j < 4; ++j) { const f32x4 gg = ((const f32x4*)g)[F.lane + 64 * j]; v[j] = v[j] * rstd * gg;
            u32x2 o; o.x = pk2(v[j].x, v[j].y); o.y = pk2(v[j].z, v[j].w);
            ((u32x2*)(XN + (size_t)r * DM))[F.lane + 64 * j] = o; }
        if (r < T_TOK) {
            f32x4 a0 = {0.f, 0.f, 0.f, 0.f}, a1 = a0, a2 = a0, a3 = a0;
#pragma unroll
            for (int j = 0; j < 4; ++j)
#pragma unroll
                for (int e = 0; e < 4; ++e) { const f32x4* w = (const f32x4*)(F.in[I_WIN] + (size_t)(4 * (F.lane + 64 * j) + e) * DIN + 1536); const float hv = v[j][e];
                    a0 += w[0] * hv; a1 += w[1] * hv; a2 += w[2] * hv; a3 += w[3] * hv; }
#pragma unroll
            for (int e = 0; e < 4; ++e) { a0[e] = wave_sum(a0[e]); a1[e] = wave_sum(a1[e]); a2[e] = wave_sum(a2[e]); a3[e] = wave_sum(a3[e]); }
            if (F.lane == 0) { f32x4* o = (f32x4*)(LR + (size_t)r * 16); o[0] = a0; o[1] = a1; o[2] = a2; o[3] = a3; }
        }
    }
}

__device__ __forceinline__ void tr_item(const float* W, int ldw, int scol0, bf16_t* WT, int K, int drow0, int k0, LAS float* scr, int lane) {
#pragma unroll 8
    for (int i = 0; i < 32; ++i) { const int kk = 2 * i + (lane >> 5); scr[kk * 33 + (lane & 31)] = W[(size_t)(k0 + kk) * ldw + scol0 + (lane & 31)]; }
    asm volatile("s_waitcnt lgkmcnt(0)" ::: "memory");
    const int c = lane & 7;
#pragma unroll
    for (int j = 0; j < 4; ++j) { const int n = (lane >> 3) + 8 * j; const LAS float* s = scr + (8 * c) * 33 + n;
        u32x4 o; o.x = pk2(s[0 * 33], s[1 * 33]); o.y = pk2(s[2 * 33], s[3 * 33]); o.z = pk2(s[4 * 33], s[5 * 33]); o.w = pk2(s[6 * 33], s[7 * 33]);
        *(u32x4*)(WT + (size_t)(drow0 + n) * K + k0 + 8 * c) = o; }
    asm volatile("s_waitcnt lgkmcnt(0)" ::: "memory");
}
__device__ __forceinline__ void ph_prep_weights(Frame& F) {
    LAS float* scr = (LAS float*)(F.lds + F.wave * 16384);
    bf16_t* WIN_T = (bf16_t*)(F.ws + WS_WIN_T); bf16_t* WOUT_T = (bf16_t*)(F.ws + WS_WOUT_T); bf16_t* WGU_T = (bf16_t*)(F.ws + WS_WGU_T); bf16_t* WD_T = (bf16_t*)(F.ws + WS_WD_T);
    const int gw = F.bid * 8 + F.wave, NGW = F.G * 8;
    constexpr int N_IN = 12 * 8 * 16, N_OUT = 4 * 8 * 16, N_GU = 32 * 4 * 8 * 16, N_DN = 32 * 4 * 8 * 8;
    for (int it = gw; it < N_IN + N_OUT + N_GU + N_DN; it += NGW) {
        int r = it;
        if (r < N_IN) { const int kb = r & 15, g32 = (r >> 4) & 7, pn = r >> 7, bj = g32 >> 2, wc = g32 & 3; const int L0 = 256 * pn + 64 * wc + 32 * bj;
            if (pn < 10) tr_item(F.in[I_WIN], DIN, L0 < 1536 ? L0 : L0 + 16, WIN_T, 1024, 256 * pn + 32 * g32, 64 * kb, scr, F.lane);
            else tr_item(F.in[I_WMEMKV], 512, L0 - 2560, WIN_T, 1024, 256 * pn + 32 * g32, 64 * kb, scr, F.lane);
            continue; }
        r -= N_IN;
        if (r < N_OUT) { const int kb = r & 15, g32 = (r >> 4) & 7, pn = r >> 7, bj = g32 >> 2, wc = g32 & 3;
            tr_item(F.in[I_WOUT], 1024, 256 * pn + 64 * wc + 32 * bj, WOUT_T, 1024, 256 * pn + 32 * g32, 64 * kb, scr, F.lane); continue; }
        r -= N_OUT;
        if (r < N_GU) { const int kb = r & 15, g32 = (r >> 4) & 7, pn = (r >> 7) & 3, e = r >> 9, bj = g32 >> 2, wc = g32 & 3;
            tr_item((bj ? F.in[I_WUP] : F.in[I_WGATE]) + (size_t)e * 1024 * 512, 512, 128 * pn + 32 * wc, WGU_T, 1024, e * 1024 + 256 * pn + 32 * g32, 64 * kb, scr, F.lane); continue; }
        r -= N_GU;
        { const int kb = r & 7, g32 = (r >> 3) & 7, pn = (r >> 6) & 3, e = r >> 8, bj = g32 >> 2, wc = g32 & 3;
            tr_item(F.in[I_WDOWN] + (size_t)e * 512 * 1024, 1024, 256 * pn + 64 * wc + 32 * bj, WD_T, 512, e * 1024 + 256 * pn + 32 * g32, 64 * kb, scr, F.lane); }
    }
}

struct ProjOrder {
    pg8::StaticOrder s;
    __device__ __forceinline__ void init(int G, int c) { s.init(T_TOK, PROJ_LD, G, c); }
    __device__ __forceinline__ bool next(int i, pg8::Unit& u) const {
        if (s.next(i, u)) return true;
        const long L = (long)i * s.G + s.c - s.nwg;
        if (L >= 0 && L < 4) { u.pm = 64 + (int)(L >> 1); u.pn = 10 + (int)(L & 1); u.aux = 0; return true; }
        return false;
    }
    __device__ __forceinline__ void a_ready(const pg8::Unit&) const {}
    __device__ __forceinline__ void done(const pg8::Unit&) const {}
};
struct EpiProj {
    static constexpr bool PERM = true, AFTER_DRAIN = false;
    bf16_t* PROJ; bf16_t* MEMKV; float* KMEAN; const float* g_mbq; const float* g_mbk; const float* g_memq; const float* g_memk;
    __device__ __forceinline__ void operator()(const pg8::f32x4 (&acc)[2][2][4][2], const pg8::Unit& u, int wr, int wc, int fr, int fq) const {
        const int pn = u.pn;
        const float* gain = pn == 6 ? g_mbq : pn == 7 ? g_mbk : pn == 9 ? g_memq : pn == 10 ? g_memk : nullptr;
        const float post = (pn == 6 || pn == 9) ? C2 : (pn == 0 ? 0.125f : 1.f);
        float gv[2][8];
#pragma unroll
        for (int bj = 0; bj < 2; ++bj)
#pragma unroll
            for (int j = 0; j < 8; ++j) gv[bj][j] = (gain ? gain[32 * bj + 8 * fq + j] : 1.f) * post;
        bf16_t* base; int ld;
        if (pn < 10) { base = PROJ + (size_t)(u.pm * 256) * PROJ_LD + 256 * pn; ld = PROJ_LD; } else { base = MEMKV + (size_t)((u.pm - 64) * 256) * 512 + 256 * (pn - 10); ld = 512; }
        base += 64 * wc + 8 * fq;
        float ks[2][8];
#pragma unroll
        for (int bj = 0; bj < 2; ++bj)
#pragma unroll
            for (int j = 0; j < 8; ++j) ks[bj][j] = 0.f;
#pragma unroll
        for (int ai = 0; ai < 2; ++ai)
#pragma unroll
            for (int m = 0; m < 4; ++m) {
                const int row = 128 * ai + 64 * wr + 16 * m + fr; float rstd = 1.f;
                if (gain) { float ss = 0.f;
#pragma unroll
                    for (int bj = 0; bj < 2; ++bj)
#pragma unroll
                        for (int n = 0; n < 2; ++n) { const pg8::f32x4 x = acc[ai][bj][m][n]; ss += (x[0] * x[0] + x[1] * x[1]) + (x[2] * x[2] + x[3] * x[3]); }
                    ss += __shfl_xor(ss, 16); ss += __shfl_xor(ss, 32); rstd = rsqrtf(ss * (1.f / 64.f) + EPS); }
#pragma unroll
                for (int bj = 0; bj < 2; ++bj) { float o[8];
#pragma unroll
                    for (int j = 0; j < 8; ++j) o[j] = acc[ai][bj][m][j >> 2][j & 3] * rstd * gv[bj][j];
                    if (pn == 7) {
#pragma unroll
                        for (int j = 0; j < 8; ++j) ks[bj][j] += o[j]; }
                    u32x4 w; w.x = pg8::cvt_pk_bf16(o[0], o[1]); w.y = pg8::cvt_pk_bf16(o[2], o[3]); w.z = pg8::cvt_pk_bf16(o[4], o[5]); w.w = pg8::cvt_pk_bf16(o[6], o[7]);
                    *(u32x4*)(base + (size_t)row * ld + 32 * bj) = w; }
            }
        if (pn == 7) {
            float* km = KMEAN + (((u.pm >> 5) * 4 + wc) * 32 + (u.pm & 31)) * 64 + 8 * fq;
#pragma unroll
            for (int bj = 0; bj < 2; ++bj)
#pragma unroll
                for (int j = 0; j < 8; ++j) { float v = ks[bj][j]; v += __shfl_xor(v, 1); v += __shfl_xor(v, 2); v += __shfl_xor(v, 4); v += __shfl_xor(v, 8);
                    if (fr == 0) atomicAdd(km + 32 * bj + j, v * (1.f / 256.f)); }
        }
    }
};
__device__ __forceinline__ void ph_proj_gemm(Frame& F) {
    pg8::Gemm g{(const bf16_t*)(F.ws + WS_XN), (const bf16_t*)(F.ws + WS_WIN_T), T_TOK + 512, 3072, 1024};
    ProjOrder S; S.init(F.G, F.bid);
    EpiProj E{(bf16_t*)(F.ws + WS_PROJ), (bf16_t*)(F.ws + WS_MEMKV), (float*)(F.ctl + CW_KMEAN), F.in[I_MBQ_G], F.in[I_MBK_G], F.in[I_MEMQ_G], F.in[I_MEMK_G]};
    pg8::gemm_phase<EpiProj, ProjOrder, true, true>(F.lds, g, S, E);
}

__device__ __forceinline__ void attend_naive(const float (&q)[64], float (&o)[64], float& m, float& l, const bf16_t* kp, const bf16_t* vp, int ld, int s0, int s1, int t, float slope2) {
    for (int s = s0; s < s1; ++s) {
        const u32x4* kr = (const u32x4*)(kp + (size_t)s * ld); float sc = 0.f;
#pragma unroll
        for (int c = 0; c < 8; ++c) { const u32x4 w = kr[c];
            sc += q[8 * c + 0] * bf2f(w.x & 0xffffu) + q[8 * c + 1] * bf2f(w.x >> 16) + q[8 * c + 2] * bf2f(w.y & 0xffffu) + q[8 * c + 3] * bf2f(w.y >> 16)
                + q[8 * c + 4] * bf2f(w.z & 0xffffu) + q[8 * c + 5] * bf2f(w.z >> 16) + q[8 * c + 6] * bf2f(w.w & 0xffffu) + q[8 * c + 7] * bf2f(w.w >> 16); }
        sc -= slope2 * (float)(t - s);
        float p;
        if (sc > m) { const float f = exp2f(m - sc); l *= f;
#pragma unroll
            for (int d = 0; d < 64; ++d) o[d] *= f;
            m = sc; p = 1.f; } else p = exp2f(sc - m);
        l += p;
        const u32x4* vr = (const u32x4*)(vp + (size_t)s * ld);
#pragma unroll
        for (int c = 0; c < 8; ++c) { const u32x4 w = vr[c];
            o[8 * c + 0] += p * bf2f(w.x & 0xffffu); o[8 * c + 1] += p * bf2f(w.x >> 16); o[8 * c + 2] += p * bf2f(w.y & 0xffffu); o[8 * c + 3] += p * bf2f(w.y >> 16);
            o[8 * c + 4] += p * bf2f(w.z & 0xffffu); o[8 * c + 5] += p * bf2f(w.z >> 16); o[8 * c + 6] += p * bf2f(w.w & 0xffffu); o[8 * c + 7] += p * bf2f(w.w >> 16); }
    }
}
__device__ __forceinline__ void load_q64(float (&q)[64], const bf16_t* p) {
#pragma unroll
    for (int c = 0; c < 8; ++c) { const u32x4 w = ((const u32x4*)p)[c];
        q[8 * c + 0] = bf2f(w.x & 0xffffu); q[8 * c + 1] = bf2f(w.x >> 16); q[8 * c + 2] = bf2f(w.y & 0xffffu); q[8 * c + 3] = bf2f(w.y >> 16);
        q[8 * c + 4] = bf2f(w.z & 0xffffu); q[8 * c + 5] = bf2f(w.z >> 16); q[8 * c + 6] = bf2f(w.w & 0xffffu); q[8 * c + 7] = bf2f(w.w >> 16); }
}
__device__ __forceinline__ void store_o64(const float (&o)[64], float inv, bf16_t* p) {
#pragma unroll
    for (int c = 0; c < 8; ++c) { u32x4 w; w.x = pk2(o[8 * c] * inv, o[8 * c + 1] * inv); w.y = pk2(o[8 * c + 2] * inv, o[8 * c + 3] * inv); w.z = pk2(o[8 * c + 4] * inv, o[8 * c + 5] * inv); w.w = pk2(o[8 * c + 6] * inv, o[8 * c + 7] * inv);
        ((u32x4*)p)[c] = w; }
}


typedef short bf16x8 __attribute__((ext_vector_type(8)));
typedef short s16x4 __attribute__((ext_vector_type(4)));
typedef float f32x16 __attribute__((ext_vector_type(16)));
typedef float f32x2_t __attribute__((ext_vector_type(2)));
typedef __bf16 bf16x2_t __attribute__((ext_vector_type(2)));
__device__ __forceinline__ unsigned cvtpk(float lo, float hi) { f32x2_t v = {lo, hi}; bf16x2_t b = __builtin_convertvector(v, bf16x2_t); return __builtin_bit_cast(unsigned, b); }
__device__ __forceinline__ int crow(int r, int hi) { return (r & 3) + 8 * (r >> 2) + 4 * hi; }
constexpr int MLIST_CAP = 126976;
__device__ __forceinline__ int mlist_off(int j) { return 256 * (31 * j - (j * (j - 1)) / 2); }
constexpr int AL_K = 0, AL_V = 32768, AL_ENT = 65536, AL_WSF = 66560, AL_PRE = 70656;
__device__ __forceinline__ void attn_fill_kv(Frame& F, const bf16_t* kb, const bf16_t* vb, int ld) {
    for (int i = F.tid; i < 2048; i += 512) { const int key = i >> 3, c = i & 7;
        const u32x4 kk = *(const u32x4*)(kb + (size_t)key * ld + c * 8), vv = *(const u32x4*)(vb + (size_t)key * ld + c * 8);
        *(LAS u32x4*)(F.lds + AL_K + key * 128 + ((c ^ ((key >> 1) & 7)) << 4)) = kk;
        *(LAS u32x4*)(F.lds + AL_V + key * 128 + ((c ^ (((key >> 1) & 1) << 2)) << 4)) = vv; }
}
template <int MODE>
__device__ __forceinline__ void attn_unit(Frame& F, const bf16_t* qbase  , int brow  , int h, int t0, int kpos0, float slope2, int nvalid, int nsel,
                                          bf16_t* outp  ) {
    const int lane = F.lane, r32 = lane & 31, hi = lane >> 5, w = F.wave;
    LAS const unsigned* ent = (LAS const unsigned*)(F.lds + AL_ENT);
    LAS float* wsf = (LAS float*)(F.lds + AL_WSF) + w * 128;
    float* PML = (float*)(F.ws + WS_PML); bf16_t* PO = (bf16_t*)(F.ws + WS_PO);
    int tq, myslot = 0;
    if (MODE == 0) { int ei = 32 * w + r32; if (ei >= nvalid) ei = 0; const unsigned e = ent[ei]; tq = (int)(e & 0x1fffu); myslot = (int)(e >> 13); }
    else tq = t0 + 32 * w + r32;
    bf16x8 qf[4];
    { const bf16_t* qp = qbase + (size_t)tq * PROJ_LD + 8 * hi;
#pragma unroll
      for (int d0 = 0; d0 < 4; ++d0) qf[d0] = *(const bf16x8*)(qp + 16 * d0); }
    const float lanec = (MODE == 2) ? 0.f : slope2 * (float)(kpos0 + 4 * hi - tq);
    float mref = 0.f, lsum = 0.f; bool first = true;
    f32x16 o0, o1;
#pragma unroll
    for (int r = 0; r < 16; ++r) { o0[r] = 0.f; o1[r] = 0.f; }
    if (MODE == 1 && nsel > 0) {
        first = false;
        const float* pm = PML + ((size_t)(brow + tq) * 4 + h) * 6;
        float ms[3], ls[3]; float M0 = -INFINITY;
#pragma unroll
        for (int s = 0; s < 3; ++s) { if (s < nsel) { ms[s] = pm[2 * s]; ls[s] = pm[2 * s + 1]; } else { ms[s] = -INFINITY; ls[s] = 0.f; } M0 = fmaxf(M0, ms[s]); }
        float l0 = 0.f;
#pragma unroll
        for (int s = 0; s < 3; ++s) { const float ws_ = ls[s] * exp2f(ms[s] - M0); l0 += ws_; if (hi == 0) wsf[32 * s + r32] = ws_; }
        mref = M0; lsum = hi == 0 ? l0 : 0.f;
#pragma unroll
        for (int r = 0; r < 16; ++r) { const int qr = 32 * w + crow(r, hi); const bf16_t* pp = PO + ((size_t)(brow + t0 + qr) * 4 + h) * 192 + r32;
#pragma unroll
            for (int s = 0; s < 3; ++s) if (s < nsel) { const float ws_ = wsf[32 * s + crow(r, hi)]; o0[r] += ws_ * bf2f(pp[64 * s]); o1[r] += ws_ * bf2f(pp[64 * s + 32]); } }
    }
    const int kswz = (r32 >> 1) & 7;
    const unsigned kaddr0 = AL_K + r32 * 128 + ((hi ^ kswz) << 4);
    (void)kaddr0;
    const int q4 = (lane & 15) >> 2, p4 = lane & 3, blk = (lane >> 4) & 1, vsw = ((q4 >> 1) & 1) << 2, vx = 2 * blk + (p4 >> 1);
    const unsigned vb = AL_V + (4 * hi + q4) * 128 + 8 * (p4 & 1);
    const unsigned voff0 = vb + ((vsw + vx) << 4), voff1 = vb + (((4 ^ vsw) + vx) << 4);
    const int jmax = (MODE == 1) ? ((32 * w + 31) >> 6) : 3;
    for (int j = 0; j <= jmax; ++j) {
        const float c0 = lanec + slope2 * (float)(64 * j) - mref;
        f32x16 p0, p1;
#pragma unroll
        for (int r = 0; r < 16; ++r) { p0[r] = c0; p1[r] = c0 + 32.f * slope2; }
#pragma unroll
        for (int d0 = 0; d0 < 4; ++d0) {
            const unsigned ka = AL_K + (64 * j + r32) * 128 + (((2 * d0 + hi) ^ kswz) << 4);
            const bf16x8 k0 = *(LAS const bf16x8*)(F.lds + ka), k1 = *(LAS const bf16x8*)(F.lds + ka + 32 * 128);
            p0 = __builtin_amdgcn_mfma_f32_32x32x16_bf16(k0, qf[d0], p0, 0, 0, 0);
            p1 = __builtin_amdgcn_mfma_f32_32x32x16_bf16(k1, qf[d0], p1, 0, 0, 0);
        }
        if (MODE != 2) {
#pragma unroll
            for (int r = 0; r < 16; ++r) { const float a = slope2 * (float)((r & 3) + 8 * (r >> 2)); p0[r] += a; p1[r] += a; }
        }
        if (MODE == 1) { const int qpos = 32 * w + r32;
#pragma unroll
            for (int r = 0; r < 16; ++r) { const int kp = 64 * j + crow(r, hi); if (kp > qpos) p0[r] = -INFINITY; if (kp + 32 > qpos) p1[r] = -INFINITY; } }
        float mx = fmaxf(p0[0], p1[0]);
#pragma unroll
        for (int r = 1; r < 16; ++r) mx = fmaxf(mx, fmaxf(p0[r], p1[r]));
        mx = fmaxf(mx, __shfl_xor(mx, 32));
        if (first) {
            mref = mx;
#pragma unroll
            for (int r = 0; r < 16; ++r) { p0[r] -= mx; p1[r] -= mx; }
            first = false;
        } else if (__any(mx > 0.f)) {
            const float dl = fmaxf(mx, 0.f), f = __builtin_amdgcn_exp2f(-dl); mref += dl; lsum *= f;
#pragma unroll
            for (int r = 0; r < 16; ++r) { p0[r] -= dl; p1[r] -= dl; }
            if (hi == 0) wsf[r32] = f;
#pragma unroll
            for (int r = 0; r < 16; ++r) { const float fr = wsf[crow(r, hi)]; o0[r] *= fr; o1[r] *= fr; }
        }
        float ps = 0.f;
#pragma unroll
        for (int r = 0; r < 16; ++r) { p0[r] = __builtin_amdgcn_exp2f(p0[r]); p1[r] = __builtin_amdgcn_exp2f(p1[r]); ps += p0[r] + p1[r]; }
        lsum += ps;
        u32x4 a00, a01, a10, a11;
        a00.x = cvtpk(p0[0], p0[1]); a00.y = cvtpk(p0[2], p0[3]); a00.z = cvtpk(p0[4], p0[5]); a00.w = cvtpk(p0[6], p0[7]);
        a01.x = cvtpk(p0[8], p0[9]); a01.y = cvtpk(p0[10], p0[11]); a01.z = cvtpk(p0[12], p0[13]); a01.w = cvtpk(p0[14], p0[15]);
        a10.x = cvtpk(p1[0], p1[1]); a10.y = cvtpk(p1[2], p1[3]); a10.z = cvtpk(p1[4], p1[5]); a10.w = cvtpk(p1[6], p1[7]);
        a11.x = cvtpk(p1[8], p1[9]); a11.y = cvtpk(p1[10], p1[11]); a11.z = cvtpk(p1[12], p1[13]); a11.w = cvtpk(p1[14], p1[15]);
#define VFRAG(dst, voff, rowoff) do { const s16x4 lo_ = __builtin_bit_cast(s16x4, __builtin_amdgcn_ds_read_tr16_b64_v4i16((LAS s16x4*)(F.lds + (voff) + (rowoff) * 128))); \
        const s16x4 hi_ = __builtin_bit_cast(s16x4, __builtin_amdgcn_ds_read_tr16_b64_v4i16((LAS s16x4*)(F.lds + (voff) + ((rowoff) + 8) * 128))); \
        dst = (bf16x8){lo_[0], lo_[1], lo_[2], lo_[3], hi_[0], hi_[1], hi_[2], hi_[3]}; } while (0)
#pragma unroll
        for (int ks = 0; ks < 4; ++ks) {
            const int ro = 64 * j + 16 * ks; bf16x8 v0, v1; VFRAG(v0, voff0, ro); VFRAG(v1, voff1, ro);
            const bf16x8 pa = __builtin_bit_cast(bf16x8, ks == 0 ? a00 : ks == 1 ? a01 : ks == 2 ? a10 : a11);
            o0 = __builtin_amdgcn_mfma_f32_32x32x16_bf16(pa, v0, o0, 0, 0, 0);
            o1 = __builtin_amdgcn_mfma_f32_32x32x16_bf16(pa, v1, o1, 0, 0, 0);
        }
#undef VFRAG
    }
    const float ltot = lsum + __shfl_xor(lsum, 32);
    if (hi == 0) wsf[r32] = 1.f / ltot;
    if (MODE == 0) {
        if (hi == 0 && 32 * w + r32 < nvalid) { float* pm = PML + ((size_t)(brow + tq) * 4 + h) * 6 + 2 * myslot; pm[0] = mref; pm[1] = ltot; }
#pragma unroll
        for (int r = 0; r < 16; ++r) { const int qi = 32 * w + crow(r, hi); const float ri = wsf[crow(r, hi)];
            if (qi < nvalid) { const unsigned e = ent[qi]; bf16_t* pp = PO + (((size_t)(brow + (int)(e & 0x1fffu)) * 4 + h) * 3 + (e >> 13)) * 64 + r32;
                pp[0] = (bf16_t)f2bf(o0[r] * ri); pp[32] = (bf16_t)f2bf(o1[r] * ri); } }
    } else {
#pragma unroll
        for (int r = 0; r < 16; ++r) { const float ri = wsf[crow(r, hi)]; bf16_t* pp = outp + (size_t)(brow + t0 + 32 * w + crow(r, hi)) * DM + r32;
            pp[0] = (bf16_t)f2bf(o0[r] * ri); pp[32] = (bf16_t)f2bf(o1[r] * ri); }
    }
}

__device__ __forceinline__ void ph_moba_route(Frame& F) {
    const bf16_t* PROJ = (const bf16_t*)(F.ws + WS_PROJ); const float* KMEAN = (const float*)(F.ctl + CW_KMEAN);
    unsigned* MCNT = F.ctl + CW_MCNT; unsigned* MLIST = (unsigned*)(F.ws + WS_MLIST);
    LAS float* km = (LAS float*)F.lds;
    for (int item = F.bid; item < 128; item += F.G) {
        const int bh = item >> 4, b = bh >> 2, h = bh & 3, t = (item & 15) * 512 + F.tid;
        __syncthreads();
        for (int i = F.tid; i < 2048; i += 512) km[i] = KMEAN[bh * 2048 + i];
        __syncthreads();
        const int own = t >> 8; if (own == 0) continue;
        float q[64]; load_q64(q, PROJ + (size_t)(b * SEQ + t) * PROJ_LD + C_MBQ + h * 64);
        float b0 = -INFINITY, b1 = -INFINITY, b2 = -INFINITY; int i0 = 0, i1 = 0, i2 = 0;
        for (int j = 0; j < own; ++j) { float gsc = 0.f;
#pragma unroll
            for (int d = 0; d < 64; d += 4) { const f32x4 kk = *(LAS f32x4*)(km + j * 64 + d); gsc += q[d] * kk.x + q[d + 1] * kk.y + q[d + 2] * kk.z + q[d + 3] * kk.w; }
            if (gsc > b0) { b2 = b1; i2 = i1; b1 = b0; i1 = i0; b0 = gsc; i0 = j; } else if (gsc > b1) { b2 = b1; i2 = i1; b1 = gsc; i1 = j; } else if (gsc > b2) { b2 = gsc; i2 = j; } }
        const int nsel = own < 3 ? own : 3;
        for (int s = 0; s < nsel; ++s) { const int jb = s == 0 ? i0 : s == 1 ? i1 : i2;
            const unsigned pos = atomicAdd(&MCNT[bh * 32 + jb], 1u);
            MLIST[(size_t)bh * MLIST_CAP + mlist_off(jb) + pos] = (unsigned)t | ((unsigned)s << 13); }
    }
}
__device__ __forceinline__ void ph_mem_attn(Frame& F, int bid, int nb) {
    const bf16_t* PROJ = (const bf16_t*)(F.ws + WS_PROJ); const bf16_t* MEMKV = (const bf16_t*)(F.ws + WS_MEMKV); bf16_t* MIX = (bf16_t*)(F.ws + WS_MIX);
    for (int u = bid; u < 256; u += nb) {
        const int bh = u >> 5, b = bh >> 2, h = bh & 3, qb = u & 31;
        __syncthreads();
        attn_fill_kv(F, MEMKV + (size_t)(b * NMEM) * 512 + h * 64, MEMKV + (size_t)(b * NMEM) * 512 + 256 + h * 64, 512);
        __syncthreads();
        attn_unit<2>(F, PROJ + (size_t)(b * SEQ) * PROJ_LD + C_MEMQ + h * 64, b * SEQ, h, qb * 256, 0, 0.f, 256, 0, MIX + 768 + h * 64);
    }
}
__device__ __forceinline__ void ph_moba_gather(Frame& F, int bid, int nb) {
    const bf16_t* PROJ = (const bf16_t*)(F.ws + WS_PROJ); const unsigned* MLIST = (const unsigned*)(F.ws + WS_MLIST);
    LAS int* pre = (LAS int*)(F.lds + AL_PRE); LAS unsigned* ent = (LAS unsigned*)(F.lds + AL_ENT);
    __syncthreads();
    if (F.tid < 256) pre[F.tid + 1] = ((int)xb_ld(F.ctl + CW_MCNT + F.tid) + 255) >> 8;
    __syncthreads();
    if (F.tid == 0) { pre[0] = 0; for (int k = 0; k < 256; ++k) pre[k + 1] += pre[k]; }
    __syncthreads();
    const int total = pre[256];
    for (int u = bid; u < total; u += nb) {
        int lo = 0, hi_ = 256; while (hi_ - lo > 1) { const int mid = (lo + hi_) >> 1; if (pre[mid] <= u) lo = mid; else hi_ = mid; }
        const int k = lo, sl = u - pre[k], bh = k >> 5, j = k & 31, b = bh >> 2, h = bh & 3;
        const int cnt = (int)xb_ld(F.ctl + CW_MCNT + k); const int nvalid = (cnt - 256 * sl) < 256 ? (cnt - 256 * sl) : 256;
        __syncthreads();
        if (F.tid < 256) ent[F.tid] = F.tid < nvalid ? MLIST[(size_t)bh * MLIST_CAP + mlist_off(j) + 256 * sl + F.tid] : 0u;
        attn_fill_kv(F, PROJ + (size_t)(b * SEQ + 256 * j) * PROJ_LD + C_MBK + h * 64, PROJ + (size_t)(b * SEQ + 256 * j) * PROJ_LD + C_MBV + h * 64, PROJ_LD);
        __syncthreads();
        attn_unit<0>(F, PROJ + (size_t)(b * SEQ) * PROJ_LD + C_MBQ + h * 64, b * SEQ, h, 0, 256 * j, exp2f(-2.f * (float)(h + 1)) * LOG2E, nvalid, 0, nullptr);
    }
}
__device__ __forceinline__ void ph_moba_own(Frame& F, int bid, int nb) {
    const bf16_t* PROJ = (const bf16_t*)(F.ws + WS_PROJ); bf16_t* MIX = (bf16_t*)(F.ws + WS_MIX);
    for (int u = bid; u < 256; u += nb) {
        const int bh = u >> 5, b = bh >> 2, h = bh & 3, j = u & 31;
        __syncthreads();
        attn_fill_kv(F, PROJ + (size_t)(b * SEQ + 256 * j) * PROJ_LD + C_MBK + h * 64, PROJ + (size_t)(b * SEQ + 256 * j) * PROJ_LD + C_MBV + h * 64, PROJ_LD);
        __syncthreads();
        attn_unit<1>(F, PROJ + (size_t)(b * SEQ) * PROJ_LD + C_MBQ + h * 64, b * SEQ, h, 256 * j, 256 * j, exp2f(-2.f * (float)(h + 1)) * LOG2E, 256, j < 3 ? j : 3, MIX + 512 + h * 64);
    }
}


constexpr int GL_LR = 0, GL_TOT = 4096, GL_QD = 8192, GL_KI = 16384, GL_AM = 24576, GL_V = 32768, GL_SP = 49152, GL_SSQ = 65536;
typedef float f32x4a __attribute__((ext_vector_type(4)));
__device__ __forceinline__ unsigned offK(int row, int ch) { return (unsigned)(row * 128 + ((ch ^ ((row >> 1) & 7)) << 4)); }
__device__ __forceinline__ unsigned offB(int row, int ch) { return (unsigned)(256 * row + 16 * (ch ^ (((row & 3) << 2) | ((row >> 2) & 3)))); }
__device__ __forceinline__ bf16x8 rowfrag(LAS unsigned char* img, int lane, int rb, int s) { return *(LAS const bf16x8*)(img + offK(16 * rb + (lane & 15), 4 * s + (lane >> 4))); }
__device__ __forceinline__ bf16x8 trfrag(LAS unsigned char* img, int lane, int c, int ks) {
    const int g = lane >> 4, q = (lane & 15) >> 2, p = lane & 3;
    const unsigned a0 = offB(32 * ks + 8 * g + q, 2 * c + (p >> 1)) + 8 * (p & 1), a1 = offB(32 * ks + 8 * g + 4 + q, 2 * c + (p >> 1)) + 8 * (p & 1);
    const s16x4 lo = __builtin_bit_cast(s16x4, __builtin_amdgcn_ds_read_tr16_b64_v4i16((LAS s16x4*)(img + a0)));
    const s16x4 hi = __builtin_bit_cast(s16x4, __builtin_amdgcn_ds_read_tr16_b64_v4i16((LAS s16x4*)(img + a1)));
    return (bf16x8){lo[0], lo[1], lo[2], lo[3], hi[0], hi[1], hi[2], hi[3]};
}
__device__ __forceinline__ void gla_prep(Frame& F, int t0, int h, float (&cum)[8], float& cum_last) {
    LAS float* lrs = (LAS float*)(F.lds + GL_LR); LAS float* tot = (LAS float*)(F.lds + GL_TOT);
    const float* LR = (const float*)(F.ws + WS_LR);
    const int seg = F.tid >> 6, d = F.tid & 63;
    __syncthreads();
    for (int i = F.tid; i < 1024; i += 512) lrs[i] = LR[(size_t)t0 * 16 + i];
    float wg[16];
#pragma unroll
    for (int i = 0; i < 16; ++i) wg[i] = F.in[I_WGK][i * 256 + h * 64 + d];
    const float bias = F.in[I_BGK][h * 64 + d];
    __syncthreads();
    float run = 0.f;
#pragma unroll
    for (int i = 0; i < 8; ++i) { const int c = 8 * seg + i; float z = bias;
#pragma unroll
        for (int k = 0; k < 16; k += 4) { const f32x4 l4 = *(LAS f32x4*)(lrs + c * 16 + k); z += l4.x * wg[k] + l4.y * wg[k + 1] + l4.z * wg[k + 2] + l4.w * wg[k + 3]; }
        const float ls = fminf(z, 0.f) - log1pf(__expf(-fabsf(z)));
        run += ls * (1.f / 16.f); cum[i] = run; }
    tot[seg * 64 + d] = run;
    __syncthreads();
    float off = 0.f, all = 0.f;
#pragma unroll
    for (int s = 0; s < 8; ++s) { const float v = tot[s * 64 + d]; all += v; off += s < seg ? v : 0.f; }
#pragma unroll
    for (int i = 0; i < 8; ++i) cum[i] += off;
    cum_last = all;
}
__device__ __forceinline__ void gla_fill_b(Frame& F, int goff, const bf16_t* src, int ld) {
    for (int i = F.tid; i < 1024; i += 512) { const int row = i >> 4, ch = i & 15; *(LAS u32x4*)(F.lds + goff + offB(row, ch)) = *(const u32x4*)(src + (size_t)row * ld + ch * 8); }
}
__device__ __forceinline__ void gla_a_unit(Frame& F, int b, int h, int n) {
    const bf16_t* PROJ = (const bf16_t*)(F.ws + WS_PROJ); float* DS = (float*)(F.ws + WS_DS); float* DEC = (float*)(F.ws + WS_DEC);
    const int t0 = b * SEQ + 64 * n, seg = F.tid >> 6, d = F.tid & 63, lane = F.lane, w = F.wave;
    float cum[8], cl; gla_prep(F, t0, h, cum, cl);
    { float ke[8];
#pragma unroll
      for (int i = 0; i < 8; ++i) ke[i] = bf2f(PROJ[(size_t)(t0 + 8 * seg + i) * PROJ_LD + C_GK + h * 64 + d]) * __expf(cl - cum[i]);
      u32x4 pk; pk.x = cvtpk(ke[0], ke[1]); pk.y = cvtpk(ke[2], ke[3]); pk.z = cvtpk(ke[4], ke[5]); pk.w = cvtpk(ke[6], ke[7]);
      *(LAS u32x4*)(F.lds + GL_QD + offK(d, seg)) = pk; }
    gla_fill_b(F, GL_V, PROJ + (size_t)t0 * PROJ_LD + C_GV + h * 128, PROJ_LD);
    if (seg == 0) DEC[(size_t)((n * 8 + b * 4 + h) * 64) + d] = __expf(cl);
    __syncthreads();
    f32x4 acc[4];
#pragma unroll
    for (int mt = 0; mt < 4; ++mt) acc[mt] = (f32x4){0.f, 0.f, 0.f, 0.f};
#pragma unroll
    for (int ks = 0; ks < 2; ++ks) { const bf16x8 bfr = trfrag(F.lds + GL_V, lane, w, ks);
#pragma unroll
        for (int mt = 0; mt < 4; ++mt) acc[mt] = __builtin_amdgcn_mfma_f32_16x16x32_bf16(rowfrag(F.lds + GL_QD, lane, mt, ks), bfr, acc[mt], 0, 0, 0); }
    float* ds = DS + (size_t)((n * 8 + b * 4 + h) * 64) * 128 + 16 * w + (lane & 15);
#pragma unroll
    for (int mt = 0; mt < 4; ++mt)
#pragma unroll
        for (int e = 0; e < 4; ++e) ds[(16 * mt + 4 * (lane >> 4) + e) * 128] = acc[mt][e];
}
__device__ __forceinline__ void ph_gla_scan(Frame& F) {
    const float* DS = (const float*)(F.ws + WS_DS); const float* DEC = (const float*)(F.ws + WS_DEC); bf16_t* SP = (bf16_t*)(F.ws + WS_SP);
    if (F.tid < 256)
        for (int e = F.bid * 256 + F.tid; e < 65536; e += F.G * 256) {
            float S = 0.f; const int bhdk = e >> 7;
#pragma unroll 8
            for (int n = 0; n < 128; ++n) { const float dsv = DS[(size_t)n * 65536 + e], dc = DEC[n * 512 + bhdk]; SP[(size_t)n * 65536 + e] = (bf16_t)f2bf(S); S = S * dc + dsv; }
        }
}
__device__ __forceinline__ void gla_c_unit(Frame& F, int b, int h, int n) {
    const bf16_t* PROJ = (const bf16_t*)(F.ws + WS_PROJ); const bf16_t* SP = (const bf16_t*)(F.ws + WS_SP); bf16_t* MIX = (bf16_t*)(F.ws + WS_MIX);
    const int t0 = b * SEQ + 64 * n, seg = F.tid >> 6, d = F.tid & 63, lane = F.lane, w = F.wave, g4 = lane >> 4, l15 = lane & 15;
    float cum[8], cl; gla_prep(F, t0, h, cum, cl);
#pragma unroll
    for (int i = 0; i < 8; ++i) { const int c = 8 * seg + i; const size_t row = (size_t)(t0 + c) * PROJ_LD;
        const float qv = bf2f(PROJ[row + C_GQ + h * 64 + d]) * __expf(cum[i]), kv = bf2f(PROJ[row + C_GK + h * 64 + d]) * __expf(-cum[i]);
        const unsigned o = offK(c, d >> 3) + (d & 7) * 2;
        *(LAS bf16_t*)(F.lds + GL_QD + o) = (bf16_t)f2bf(qv); *(LAS bf16_t*)(F.lds + GL_KI + o) = (bf16_t)f2bf(kv); }
    gla_fill_b(F, GL_V, PROJ + (size_t)t0 * PROJ_LD + C_GV + h * 128, PROJ_LD);
    gla_fill_b(F, GL_SP, SP + (size_t)((n * 8 + b * 4 + h) * 64) * 128, 128);
    __syncthreads();
    {
        const int it = w & 3;
#pragma unroll
        for (int jj = 0; jj < 2; ++jj) { const int jt = 2 * (w >> 2) + jj; u32x2 pk; pk.x = 0u; pk.y = 0u;
            if (jt <= it) { f32x4 a = {0.f, 0.f, 0.f, 0.f};
#pragma unroll
                for (int ks = 0; ks < 2; ++ks) a = __builtin_amdgcn_mfma_f32_16x16x32_bf16(rowfrag(F.lds + GL_KI, lane, jt, ks), rowfrag(F.lds + GL_QD, lane, it, ks), a, 0, 0, 0);
                const int i = 16 * it + l15, j0 = 16 * jt + 4 * g4;
                pk.x = cvtpk(j0 <= i ? a[0] : 0.f, j0 + 1 <= i ? a[1] : 0.f); pk.y = cvtpk(j0 + 2 <= i ? a[2] : 0.f, j0 + 3 <= i ? a[3] : 0.f); }
            *(LAS u32x2*)(F.lds + GL_AM + offK(16 * it + l15, 2 * jt + (g4 >> 1)) + (g4 & 1) * 8) = pk; }
    }
    __syncthreads();
    f32x4 acc[4];
    {
        const bf16x8 bv0 = trfrag(F.lds + GL_V, lane, w, 0), bv1 = trfrag(F.lds + GL_V, lane, w, 1), bs0 = trfrag(F.lds + GL_SP, lane, w, 0), bs1 = trfrag(F.lds + GL_SP, lane, w, 1);
#pragma unroll
        for (int mt = 0; mt < 4; ++mt) { f32x4 a = {0.f, 0.f, 0.f, 0.f};
            a = __builtin_amdgcn_mfma_f32_16x16x32_bf16(rowfrag(F.lds + GL_AM, lane, mt, 0), bv0, a, 0, 0, 0);
            a = __builtin_amdgcn_mfma_f32_16x16x32_bf16(rowfrag(F.lds + GL_AM, lane, mt, 1), bv1, a, 0, 0, 0);
            a = __builtin_amdgcn_mfma_f32_16x16x32_bf16(rowfrag(F.lds + GL_QD, lane, mt, 0), bs0, a, 0, 0, 0);
            a = __builtin_amdgcn_mfma_f32_16x16x32_bf16(rowfrag(F.lds + GL_QD, lane, mt, 1), bs1, a, 0, 0, 0);
            acc[mt] = a; }
    }
    LAS float* ssq = (LAS float*)(F.lds + GL_SSQ);
#pragma unroll
    for (int mt = 0; mt < 4; ++mt)
#pragma unroll
        for (int e = 0; e < 4; ++e) { float ss = acc[mt][e] * acc[mt][e]; ss += __shfl_xor(ss, 1); ss += __shfl_xor(ss, 2); ss += __shfl_xor(ss, 4); ss += __shfl_xor(ss, 8);
            if (l15 == 0) ssq[w * 64 + 16 * mt + 4 * g4 + e] = ss; }
    __syncthreads();
    const int v = 16 * w + l15; const float gain = F.in[I_GLA_OG][v];
#pragma unroll
    for (int mt = 0; mt < 4; ++mt)
#pragma unroll
        for (int e = 0; e < 4; ++e) { const int row = 16 * mt + 4 * g4 + e; float tot = 0.f;
#pragma unroll
            for (int ww = 0; ww < 8; ++ww) tot += ssq[ww * 64 + row];
            const float rstd = rsqrtf(tot * (1.f / 128.f) + EPS), r = bf2f(PROJ[(size_t)(t0 + row) * PROJ_LD + C_GR + h * 128 + v]);
            MIX[(size_t)(t0 + row) * DM + h * 128 + v] = (bf16_t)f2bf(acc[mt][e] * rstd * gain * silu_f(r)); }
}
__device__ __forceinline__ void ph_gla_a(Frame& F) { for (int u = F.bid; u < 1024; u += F.G) gla_a_unit(F, u >> 9, (u >> 7) & 3, u & 127); }
__device__ __forceinline__ void ph_gla_c(Frame& F) { for (int u = F.bid; u < 1024; u += F.G) gla_c_unit(F, u >> 9, (u >> 7) & 3, u & 127); }

__device__ __forceinline__ void ph_router(Frame& F) {
    bf16_t* H2 = (bf16_t*)(F.ws + WS_H2); unsigned* ETOK = (unsigned*)(F.ws + WS_ETOK); float* EGATE = (float*)(F.ws + WS_EGATE); unsigned* TLOC = (unsigned*)(F.ws + WS_TLOC);
    unsigned* ECNT = F.ctl + CW_ECNT;
    const int gw = F.bid * 8 + F.wave, NGW = F.G * 8;
    for (int t = gw; t < T_TOK; t += NGW) {
        f32x4 v[4]; float ss = 0.f;
#pragma unroll
        for (int j = 0; j < 4; ++j) { v[j] = ((const f32x4*)(F.out + (size_t)t * DM))[F.lane + 64 * j]; ss += v[j].x * v[j].x + v[j].y * v[j].y + v[j].z * v[j].z + v[j].w * v[j].w; }
        const float rstd = rsqrtf(wave_sum(ss) * (1.f / DM) + EPS);
        float lg[4] = {0.f, 0.f, 0.f, 0.f};
#pragma unroll
        for (int j = 0; j < 4; ++j) { const f32x4 gg = ((const f32x4*)F.in[I_FFN_G])[F.lane + 64 * j]; v[j] = v[j] * rstd * gg;
            u32x2 o; o.x = pk2(v[j].x, v[j].y); o.y = pk2(v[j].z, v[j].w); ((u32x2*)(H2 + (size_t)t * DM))[F.lane + 64 * j] = o;
#pragma unroll
            for (int e = 0; e < 4; ++e) { const f32x4 w = ((const f32x4*)F.in[I_WRG])[4 * (F.lane + 64 * j) + e];
                lg[0] += v[j][e] * w.x; lg[1] += v[j][e] * w.y; lg[2] += v[j][e] * w.z; lg[3] += v[j][e] * w.w; } }
#pragma unroll
        for (int i = 0; i < 4; ++i) lg[i] = wave_sum(lg[i]) + F.in[I_BRG][i];
        int gs = 0; float gm = lg[0];
#pragma unroll
        for (int i = 1; i < 4; ++i) if (lg[i] > gm) { gm = lg[i]; gs = i; }
        float den = 0.f;
#pragma unroll
        for (int i = 0; i < 4; ++i) den += __expf(lg[i] - gm);
        const float pg = 1.f / den;
        float le[8];
#pragma unroll
        for (int i = 0; i < 8; ++i) le[i] = 0.f;
        const float* wre = F.in[I_WRE] + (size_t)gs * DM * 8;
#pragma unroll
        for (int j = 0; j < 4; ++j)
#pragma unroll
            for (int e = 0; e < 4; ++e) { const int d = 4 * (F.lane + 64 * j) + e; const f32x4 w0 = ((const f32x4*)wre)[2 * d], w1 = ((const f32x4*)wre)[2 * d + 1];
                le[0] += v[j][e] * w0.x; le[1] += v[j][e] * w0.y; le[2] += v[j][e] * w0.z; le[3] += v[j][e] * w0.w; le[4] += v[j][e] * w1.x; le[5] += v[j][e] * w1.y; le[6] += v[j][e] * w1.z; le[7] += v[j][e] * w1.w; }
#pragma unroll
        for (int i = 0; i < 8; ++i) le[i] = wave_sum(le[i]) + F.in[I_BRE][gs * 8 + i];
        int i0 = 0; float m0 = le[0];
#pragma unroll
        for (int i = 1; i < 8; ++i) if (le[i] > m0) { m0 = le[i]; i0 = i; }
        int i1 = i0 == 0 ? 1 : 0; float m1 = -INFINITY;
#pragma unroll
        for (int i = 0; i < 8; ++i) if (i != i0 && le[i] > m1) { m1 = le[i]; i1 = i; }
        const float w0 = 1.f / (1.f + __expf(m1 - m0)), w1 = 1.f - w0;
        if (F.lane == 0) {
            const int e0 = gs * 8 + i0, e1 = gs * 8 + i1;
            const unsigned p0 = atomicAdd(&ECNT[e0], 1u), p1 = atomicAdd(&ECNT[e1], 1u);
            ETOK[e0 * T_TOK + p0] = (unsigned)t; EGATE[e0 * T_TOK + p0] = pg * w0; ETOK[e1 * T_TOK + p1] = (unsigned)t; EGATE[e1 * T_TOK + p1] = pg * w1;
            TLOC[t * 2] = ((unsigned)e0 << 16) | p0; TLOC[t * 2 + 1] = ((unsigned)e1 << 16) | p1;
        }
    }
}


struct EpiOut {
    static constexpr bool PERM = true, AFTER_DRAIN = false;
    const float* x; float* out;
    __device__ __forceinline__ void operator()(const pg8::f32x4 (&acc)[2][2][4][2], const pg8::Unit& u, int wr, int wc, int fr, int fq) const {
#pragma unroll
        for (int ai = 0; ai < 2; ++ai)
#pragma unroll
            for (int m = 0; m < 4; ++m) { const size_t off = (size_t)(u.pm * 256 + 128 * ai + 64 * wr + 16 * m + fr) * DM + u.pn * 256 + 64 * wc + 8 * fq;
#pragma unroll
                for (int bj = 0; bj < 2; ++bj) { const f32x4 x0 = *(const f32x4*)(x + off + 32 * bj), x1 = *(const f32x4*)(x + off + 32 * bj + 4);
                    *(f32x4*)(out + off + 32 * bj) = x0 + acc[ai][bj][m][0]; *(f32x4*)(out + off + 32 * bj + 4) = x1 + acc[ai][bj][m][1]; } }
    }
};
__device__ __forceinline__ void ph_outproj_gemm(Frame& F) {
    pg8::Gemm g{(const bf16_t*)(F.ws + WS_MIX), (const bf16_t*)(F.ws + WS_WOUT_T), T_TOK, DM, DM};
    pg8::StaticOrder S; S.init(T_TOK, DM, F.G, F.bid);
    EpiOut E{F.in[I_X], F.out};
    pg8::gemm_phase<EpiOut, pg8::StaticOrder, true, true>(F.lds, g, S, E);
}

constexpr int ML_PTILE = LDSCTL_OFF + 256, ML_CNT = LDSCTL_OFF + 512, ML_UT = LDSCTL_OFF + 768, ML_TOK = LDSCTL_OFF + 1024;
struct MoeOrder {
    LAS const int* ut; LAS const unsigned* tokl;
    __device__ __forceinline__ bool next(int i, pg8::Unit& u) const { if (i >= 4 || ut[4 * i + 2] == 0) return false; u.pm = ut[4 * i]; u.pn = ut[4 * i + 1]; u.aux = i; return true; }
    __device__ __forceinline__ unsigned arow(const pg8::Unit& u, int r) const { return tokl[u.aux * 256 + r]; }
    __device__ __forceinline__ void a_ready(const pg8::Unit&) const {}
    __device__ __forceinline__ void done(const pg8::Unit&) const {}
};
__device__ __forceinline__ void moe_setup(Frame& F, bool want_tok) {
    LAS int* ptile = (LAS int*)(F.lds + ML_PTILE); LAS int* cnt = (LAS int*)(F.lds + ML_CNT); LAS int* ut = (LAS int*)(F.lds + ML_UT); LAS unsigned* tokl = (LAS unsigned*)(F.lds + ML_TOK);
    const unsigned* ETOK = (const unsigned*)(F.ws + WS_ETOK);
    __syncthreads();
    if (F.tid < 32) cnt[F.tid] = (int)xb_ld(F.ctl + CW_ECNT + F.tid);
    __syncthreads();
    if (F.tid == 0) {
        int a = 0; for (int e = 0; e < 32; ++e) { ptile[e] = a; a += (cnt[e] + 255) >> 8; } ptile[32] = a;
        for (int i = 0; i < 4; ++i) { const int L = i * F.G + F.bid;
            if (L < 4 * a) { const int tl = L >> 2; int e = 0; while (ptile[e + 1] <= tl) ++e; ut[4 * i] = tl; ut[4 * i + 1] = e * 4 + (L & 3); ut[4 * i + 2] = 1; ut[4 * i + 3] = tl - ptile[e]; }
            else { ut[4 * i] = 0; ut[4 * i + 1] = 0; ut[4 * i + 2] = 0; ut[4 * i + 3] = 0; } }
    }
    __syncthreads();
    if (want_tok)
        for (int idx = F.tid; idx < 1024; idx += 512) { const int i = idx >> 8, r = idx & 255;
            if (ut[4 * i + 2]) { const int e = ut[4 * i + 1] >> 2; int p = 256 * ut[4 * i + 3] + r; if (p >= cnt[e]) p = 0; tokl[idx] = ETOK[e * T_TOK + p]; } else tokl[idx] = 0u; }
    __syncthreads();
}
struct EpiSwiGLU {
    static constexpr bool PERM = true, AFTER_DRAIN = false;
    bf16_t* HID;
    __device__ __forceinline__ void operator()(const pg8::f32x4 (&acc)[2][2][4][2], const pg8::Unit& u, int wr, int wc, int fr, int fq) const {
        bf16_t* base = HID + (size_t)(u.pm * 256 + 64 * wr + fr) * 512 + (u.pn & 3) * 128 + 32 * wc + 8 * fq;
#pragma unroll
        for (int ai = 0; ai < 2; ++ai)
#pragma unroll
            for (int m = 0; m < 4; ++m) { float o[8];
#pragma unroll
                for (int j = 0; j < 8; ++j) { const float gt = acc[ai][0][m][j >> 2][j & 3], up = acc[ai][1][m][j >> 2][j & 3]; o[j] = gt * __builtin_amdgcn_rcpf(1.f + __expf(-gt)) * up; }
                u32x4 w; w.x = pg8::cvt_pk_bf16(o[0], o[1]); w.y = pg8::cvt_pk_bf16(o[2], o[3]); w.z = pg8::cvt_pk_bf16(o[4], o[5]); w.w = pg8::cvt_pk_bf16(o[6], o[7]);
                *(u32x4*)(base + (size_t)(128 * ai + 16 * m) * 512) = w; }
    }
};
__device__ __forceinline__ void ph_moe_gateup(Frame& F) {
    moe_setup(F, true);
    pg8::Gemm g{(const bf16_t*)(F.ws + WS_H2), (const bf16_t*)(F.ws + WS_WGU_T), T_TOK, 32 * 1024, DM};
    MoeOrder S{(LAS const int*)(F.lds + ML_UT), (LAS const unsigned*)(F.lds + ML_TOK)};
    EpiSwiGLU E{(bf16_t*)(F.ws + WS_HID)};
    pg8::gemm_phase_gather<EpiSwiGLU, MoeOrder, true, true>(F.lds, g, S, E);
}
struct EpiDown {
    static constexpr bool PERM = true, AFTER_DRAIN = false;
    bf16_t* Y; const float* EGATE; LAS const int* ptile; LAS const int* cnt;
    __device__ __forceinline__ void operator()(const pg8::f32x4 (&acc)[2][2][4][2], const pg8::Unit& u, int wr, int wc, int fr, int fq) const {
        const int e = u.pn >> 2, p0 = 256 * (u.pm - ptile[e]) + 64 * wr + fr, ne = cnt[e];
        float gw[2][4];
#pragma unroll
        for (int ai = 0; ai < 2; ++ai)
#pragma unroll
            for (int m = 0; m < 4; ++m) { const int p = p0 + 128 * ai + 16 * m; gw[ai][m] = p < ne ? EGATE[e * T_TOK + p] : 0.f; }
        bf16_t* base = Y + (size_t)(u.pm * 256 + 64 * wr + fr) * DM + (u.pn & 3) * 256 + 64 * wc + 8 * fq;
#pragma unroll
        for (int ai = 0; ai < 2; ++ai)
#pragma unroll
            for (int m = 0; m < 4; ++m)
#pragma unroll
                for (int bj = 0; bj < 2; ++bj) { const pg8::f32x4 a = acc[ai][bj][m][0] * gw[ai][m], b = acc[ai][bj][m][1] * gw[ai][m];
                    u32x4 w; w.x = pg8::cvt_pk_bf16(a[0], a[1]); w.y = pg8::cvt_pk_bf16(a[2], a[3]); w.z = pg8::cvt_pk_bf16(b[0], b[1]); w.w = pg8::cvt_pk_bf16(b[2], b[3]);
                    *(u32x4*)(base + (size_t)(128 * ai + 16 * m) * DM + 32 * bj) = w; }
    }
};
__device__ __forceinline__ void ph_moe_down(Frame& F) {
    moe_setup(F, false);
    pg8::Gemm g{(const bf16_t*)(F.ws + WS_HID), (const bf16_t*)(F.ws + WS_WD_T), 40960, 32 * 1024, 512};
    MoeOrder S{(LAS const int*)(F.lds + ML_UT), (LAS const unsigned*)(F.lds + ML_TOK)};
    EpiDown E{(bf16_t*)(F.ws + WS_YBUF), (const float*)(F.ws + WS_EGATE), (LAS const int*)(F.lds + ML_PTILE), (LAS const int*)(F.lds + ML_CNT)};
    pg8::gemm_phase<EpiDown, MoeOrder, true, true>(F.lds, g, S, E);
}
__device__ __forceinline__ void ph_combine(Frame& F) {
    LAS int* ptile = (LAS int*)(F.lds + ML_PTILE);
    const unsigned* TLOC = (const unsigned*)(F.ws + WS_TLOC); const bf16_t* Y = (const bf16_t*)(F.ws + WS_YBUF);
    const int gw = F.bid * 8 + F.wave, NGW = F.G * 8;
    for (int t = gw; t < T_TOK; t += NGW) {
        const unsigned l0 = TLOC[t * 2], l1 = TLOC[t * 2 + 1];
        const size_t r0 = (size_t)(256 * ptile[l0 >> 16] + (int)(l0 & 0xffffu)), r1 = (size_t)(256 * ptile[l1 >> 16] + (int)(l1 & 0xffffu));
#pragma unroll
        for (int j = 0; j < 4; ++j) { const int c4 = F.lane + 64 * j; f32x4 v = ((const f32x4*)(F.out + (size_t)t * DM))[c4];
            const u32x2 a = ((const u32x2*)(Y + r0 * DM))[c4], b = ((const u32x2*)(Y + r1 * DM))[c4];
            v.x += bf2f(a.x & 0xffffu); v.y += bf2f(a.x >> 16); v.z += bf2f(a.y & 0xffffu); v.w += bf2f(a.y >> 16);
            v.x += bf2f(b.x & 0xffffu); v.y += bf2f(b.x >> 16); v.z += bf2f(b.y & 0xffffu); v.w += bf2f(b.y >> 16);
            ((f32x4*)(F.out + (size_t)t * DM))[c4] = v; }
    }
}

__global__ void __launch_bounds__(512, 2) fwd(Args args) {
    extern __shared__ __attribute__((aligned(16))) unsigned char lds_raw[];
    Frame F;
    F.lds = (LAS unsigned char*)lds_raw; F.tid = threadIdx.x; F.lane = F.tid & 63; F.wave = __builtin_amdgcn_readfirstlane(F.tid >> 6);
    F.G = gridDim.x; F.bid = blockIdx.x; F.in = args.in; F.out = args.out; F.ws = args.ws; F.ctl = (unsigned*)(args.ws + WS_CTL);
    for (int u = F.tid; u < (LDS_BYTES - LDSCTL_OFF) / 4; u += 512) ((LAS unsigned*)(F.lds + LDSCTL_OFF))[u] = 0u;
    __syncthreads();
    XcdBarrier bar = xcd_barrier_post(F.ctl + CW_BAR, (volatile LAS unsigned*)(F.lds + LDSCTL_OFF + 32));
    const int lo = args.ph_lo, hi = args.ph_hi;
#define IN(k) (lo <= (k) && (k) < hi)
#define SEAM(k) do { if (IN(k) && IN((k) + 1)) xcd_barrier(bar); } while (0)
    if (IN(0)) { ph_norm_in(F); ph_prep_weights(F); }
    SEAM(0);
    if (IN(1)) ph_proj_gemm(F);
    SEAM(1);
    if (IN(2)) { ph_moba_route(F); ph_gla_a(F); }
    SEAM(2);
    if (IN(3)) { ph_gla_scan(F); ph_moba_gather(F, F.bid, F.G); }
    SEAM(3);
    if (IN(4)) { ph_moba_own(F, F.bid, F.G); ph_mem_attn(F, F.bid, F.G); ph_gla_c(F); }
    SEAM(4);
    if (IN(5)) ph_outproj_gemm(F);
    SEAM(5);
    if (IN(6)) ph_router(F);
    SEAM(6);
    if (IN(7)) ph_moe_gateup(F);
    SEAM(7);
    if (IN(8)) ph_moe_down(F);
    SEAM(8);
    if (IN(9)) { moe_setup(F, false); ph_combine(F); }
#undef IN
#undef SEAM
}

extern "C" void kernel_launch(void* const* d_in, const int* in_sizes, int n_in, void* d_out, int out_size, void* d_ws, size_t ws_size, hipStream_t stream) {
    static int grid = 0;
    if (grid == 0) {
        if (n_in != 22 || out_size != T_TOK * DM || ws_size < WS_END) { fprintf(stderr, "kernel_launch: unexpected shapes (n_in %d, out %d, ws %zu)\n", n_in, out_size, ws_size); grid = -1; return; }
        int dev = 0, cus = 0;
        if (hipGetDevice(&dev) != hipSuccess || hipDeviceGetAttribute(&cus, hipDeviceAttributeMultiprocessorCount, dev) != hipSuccess) { grid = -1; return; }
        if (hipFuncSetAttribute((const void*)fwd, hipFuncAttributeMaxDynamicSharedMemorySize, LDS_BYTES) != hipSuccess) { grid = -1; return; }
        int per_cu = 0;
        (void)hipOccupancyMaxActiveBlocksPerMultiprocessor(&per_cu, (const void*)fwd, 512, LDS_BYTES);
        (void)hipGetLastError();
        grid = cus;
    }
    if (grid < 0) return;
    (void)hipMemsetAsync((char*)d_ws + WS_CTL, 0, CTL_ZERO_BYTES, stream);
    Args a{};
    for (int i = 0; i < 22; ++i) a.in[i] = (const float*)d_in[i];
    a.out = (float*)d_out; a.ws = (unsigned char*)d_ws; a.ph_lo = 0; a.ph_hi = 10;
    hipLaunchKernelGGL(fwd, dim3(grid), dim3(512), LDS_BYTES, stream, a);
}
```

```cpp
#include <hip/hip_runtime.h>
#include <cstdio>
#include <cstdint>

#define LAS __attribute__((address_space(3)))
#define GAS __attribute__((address_space(1)))
typedef unsigned short bf16_t;
typedef float f32x4 __attribute__((ext_vector_type(4)));
typedef unsigned u32x4 __attribute__((ext_vector_type(4)));
typedef unsigned u32x2 __attribute__((ext_vector_type(2)));
typedef short bf16x8 __attribute__((ext_vector_type(8)));
typedef short s16x4 __attribute__((ext_vector_type(4)));
typedef float f32x16 __attribute__((ext_vector_type(16)));

constexpr int T_TOK = 16384, SEQ = 8192, DM = 1024, DIN = 2576, NMEM = 256;
constexpr int PROJ_LD = 2560;
constexpr int C_GQ = 0, C_GK = 256, C_GV = 512, C_GR = 1024, C_MBQ = 1536, C_MBK = 1792, C_MBV = 2048, C_MEMQ = 2304;
constexpr float EPS = 1e-6f;
constexpr float LOG2E = 1.4426950408889634f;
constexpr float C2 = 0.125f * LOG2E;

constexpr size_t MiB = 1u << 20;
constexpr size_t WS_CTL = 0, CTL_ZERO_BYTES = 1 * MiB;
constexpr size_t WS_LR = 1 * MiB;
constexpr size_t WS_MEMKV = 2 * MiB;
constexpr size_t WS_ETOK = 3 * MiB;
constexpr size_t WS_EGATE = 5 * MiB;
constexpr size_t WS_TLOC = 7 * MiB;
constexpr size_t WS_MLIST = 8 * MiB;
constexpr size_t WS_PML = 12 * MiB;
constexpr size_t WS_PO = 242 * MiB;
constexpr size_t WS_WOUT_T = 16 * MiB;
constexpr size_t WS_WGU_T = 18 * MiB;
constexpr size_t WS_WD_T = 82 * MiB;
constexpr size_t WS_WIN_T = 227 * MiB;
constexpr size_t WS_PROJ = 114 * MiB;
constexpr size_t WS_XN = 194 * MiB;
constexpr size_t WS_MIX = 194 * MiB;
constexpr size_t WS_H2 = 114 * MiB;
constexpr size_t WS_HID = 146 * MiB;
constexpr size_t WS_YBUF = 186 * MiB;
constexpr size_t WS_WLR_T = 15 * MiB;
constexpr size_t WS_DEC = 14 * MiB;
constexpr size_t WS_DS = 194 * MiB;
constexpr size_t WS_SP = 226 * MiB;
constexpr size_t WS_END = 266 * MiB;
constexpr int CW_BAR = 4096;
constexpr int CW_ECNT = 8192;
constexpr int CW_MCNT = 12288;
constexpr int CW_KMEAN = 16384;

constexpr int LDS_BYTES = 147456;
constexpr int LDSCTL_OFF = 131072;

__device__ __forceinline__ unsigned f2bf(float f) { unsigned u = __builtin_bit_cast(unsigned, f); return (u + 0x7fffu + ((u >> 16) & 1u)) >> 16; }
__device__ __forceinline__ float bf2f(unsigned h) { return __builtin_bit_cast(float, h << 16); }
__device__ __forceinline__ unsigned pk2(float lo, float hi) { return f2bf(lo) | (f2bf(hi) << 16); }
__device__ __forceinline__ float wave_sum(float v) {
#pragma unroll
    for (int o = 1; o < 64; o <<= 1) v += __shfl_xor(v, o);
    return v;
}
__device__ __forceinline__ float silu_f(float x) { return x / (1.f + __expf(-x)); }

#define XB_TMO      128
#define XB_XCNT(j)  (256  + 64 * (j))
#define XB_XSUB(j)  (1280 + 64 * (j))
#define XB_XGEN(j)  (2304 + 64 * (j))
#define XB_TOP      3328
#define XB_TOPGEN   3392
#define XCD_BAR_WORDS 3456
#define XB_SPIN_CAP (1u << 18)
__device__ __forceinline__ unsigned xb_ld(unsigned* p)              { return __hip_atomic_load(p, __ATOMIC_RELAXED, __HIP_MEMORY_SCOPE_AGENT); }
__device__ __forceinline__ unsigned xb_add(unsigned* p, unsigned v) { return __hip_atomic_fetch_add(p, v, __ATOMIC_RELAXED, __HIP_MEMORY_SCOPE_AGENT); }
__device__ __forceinline__ unsigned xb_xcc_id() { return (unsigned)__builtin_amdgcn_s_getreg((3 << 11) | 20) & 0xFu; }
#define XB_SPIN(cond, bar) do { unsigned _sp = 0; while (cond) { __builtin_amdgcn_s_sleep(1); \
    if ((++_sp & 255u) == 0u) { if (xb_ld(&(bar)[XB_TMO])) break; if (_sp > XB_SPIN_CAP) { atomicAdd(&(bar)[XB_TMO], 1u); break; } } } } while (0)
struct XcdBarrier { unsigned* bar; unsigned x; volatile LAS unsigned* st; };
__device__ __forceinline__ XcdBarrier xcd_barrier_post(unsigned* bar, volatile LAS unsigned* st) {
    XcdBarrier b; b.bar = bar; b.x = xb_xcc_id(); b.st = st;
    if (threadIdx.x == 0) (void)xb_add(&bar[XB_XCNT(b.x)], 1u);
    return b;
}
__device__ __forceinline__ void xcd_barrier_complete(unsigned* bar, unsigned x, unsigned& nloc, unsigned& nx) {
    const unsigned G = gridDim.x * gridDim.y * gridDim.z;
    unsigned sum, cnt, mine, sp = 0u;
    for (;;) {
        sum = 0u; cnt = 0u; mine = 0u;
#pragma unroll
        for (unsigned j = 0; j < 16; ++j) { const unsigned c = xb_ld(&bar[XB_XCNT(j)]); sum += c; cnt += (c > 0u) ? 1u : 0u; mine = (j == x) ? c : mine; }
        if (sum == G) break;
        __builtin_amdgcn_s_sleep(1);
        if ((++sp & 255u) == 0u) { if (xb_ld(&bar[XB_TMO])) break; if (sp > XB_SPIN_CAP) { atomicAdd(&bar[XB_TMO], 1u); break; } }
    }
    nloc = mine > 0u ? mine : 1u; nx = cnt > 0u ? cnt : 1u;
}
__device__ __forceinline__ void xcd_barrier(const XcdBarrier& b) {
    asm volatile("s_waitcnt vmcnt(0)" ::: "memory");
    __syncthreads();
    if (threadIdx.x == 0) {
        unsigned* bar = b.bar;
        __builtin_amdgcn_s_waitcnt(0);
        unsigned nloc = b.st[0], nx = b.st[1];
        if (nloc == 0u) { xcd_barrier_complete(bar, b.x, nloc, nx); b.st[0] = nloc; b.st[1] = nx; }
        const unsigned old = xb_add(&bar[XB_XSUB(b.x)], 1u);
        const unsigned gen = old / nloc;
        if (old + 1u == (gen + 1u) * nloc) {
            __builtin_amdgcn_fence(__ATOMIC_RELEASE, "agent");
            asm volatile("s_waitcnt vmcnt(0)" ::: "memory");
            const unsigned og = xb_add(&bar[XB_TOP], 1u);
            const unsigned tg = og / nx;
            if (og + 1u == (tg + 1u) * nx) xb_add(&bar[XB_TOPGEN], 1u);
            else XB_SPIN(xb_ld(&bar[XB_TOPGEN]) == tg, bar);
            __builtin_amdgcn_fence(__ATOMIC_ACQUIRE, "agent");
            xb_add(&bar[XB_XGEN(b.x)], 1u);
            asm volatile("s_waitcnt vmcnt(0)" ::: "memory");
        } else {
            XB_SPIN(xb_ld(&bar[XB_XGEN(b.x)]) == gen, bar);
            __builtin_amdgcn_fence(__ATOMIC_ACQUIRE, "agent");
            asm volatile("s_waitcnt vmcnt(0)" ::: "memory");
        }
    }
    __syncthreads();
}

namespace pg8 {
#define PG8_LAS __attribute__((address_space(3)))
typedef unsigned short bf16_t;
typedef short bf16x8 __attribute__((ext_vector_type(8)));
typedef float f32x4 __attribute__((ext_vector_type(4)));
typedef unsigned u32x4 __attribute__((ext_vector_type(4)));
constexpr int BM = 256, BK = 64, HALF = 128, HTB = HALF * BK * 2  , STAGE_BYTES = 8 * HTB, NXCD = 8, WGM = 8;

__host__ __device__ __forceinline__ int lds_byte(int r, int c) { const int st = (r >> 4) * 2 + (c >> 5), rr = r & 15, cc = c & 31, ob = rr * 64 + cc * 2; return st * 1024 + (ob ^ (((ob >> 9) & 1) << 5)); }
__host__ __device__ __forceinline__ void stage_rc(int b, int& R, int& C) { const int st = b / 1024, sb = b % 1024, swz = sb ^ (((sb >> 9) & 1) << 5); R = (st >> 1) * 16 + swz / 64; C = (st & 1) * 32 + (swz % 64) / 2; }
__host__ __device__ __forceinline__ int perm32(int rho) { const int n = rho >> 4, i = rho & 15; return 8 * (i >> 2) + 4 * n + (i & 3); }

struct Unit { int pm, pn, aux; };
struct Gemm { const bf16_t* A; const bf16_t* Bt; int M, N, K; };

struct StaticOrder {
    int nM, nN, nwg, G, c;
    __host__ __device__ void init(int M, int N, int G_, int c_) { nM = M / BM; nN = N / BM; nwg = nM * nN; G = G_; c = c_; }
    __host__ __device__ bool next(int i, Unit& u) const {
        const long L = (long)i * G + c; if (L >= nwg) return false;
        int wgid = (int)L; { const int q = nwg / NXCD, r = nwg % NXCD, xcd = wgid % NXCD, off = wgid / NXCD; wgid = (xcd < r ? xcd * (q + 1) : r * (q + 1) + (xcd - r) * q) + off; }
        const int nig = WGM * nN, gid = wgid / nig, fm = gid * WGM, gsz = (nM - fm) < WGM ? (nM - fm) : WGM;
        u.pm = fm + ((wgid % nig) % gsz); u.pn = (wgid % nig) / gsz; u.aux = 0; return true;
    }
    __device__ __forceinline__ void a_ready(const Unit&) const {}
    __device__ __forceinline__ void done(const Unit&) const {}
};

__device__ __forceinline__ unsigned cvt_pk_bf16(float lo, float hi) { unsigned r; asm volatile("v_cvt_pk_bf16_f32 %0, %1, %2" : "=v"(r) : "v"(lo), "v"(hi)); return r; }
typedef float f32x2 __attribute__((ext_vector_type(2)));

template <class Epi, class Sched, bool ALIGN_EPI = false, bool SP2 = false>
__device__ __forceinline__ void gemm_phase(PG8_LAS unsigned char* lds, const Gemm g, const Sched& S, const Epi& E) {
    const int tid = threadIdx.x, wid = __builtin_amdgcn_readfirstlane(tid >> 6), lane = tid & 63, wr = wid >> 2, wc = wid & 3, fr = lane & 15, fq = lane >> 4;
    const int K = g.K, nt = K / BK;
    unsigned voffA[2], voffB[2];
#pragma unroll
    for (int i = 0; i < 2; ++i) { int R, C; stage_rc(tid * 16 + i * 8192, R, C); const int Rb = Epi::PERM ? ((R & ~31) + perm32(R & 31)) : R;
        voffA[i] = (unsigned)(R * K + C) * 2u; voffB[i] = (unsigned)(Rb * K + C) * 2u; }
    const size_t kstep = (size_t)(BK * 2);
    const size_t hstep = (size_t)HALF * K * 2;
    const size_t tstep = 2 * hstep;
    const unsigned ldsw = (unsigned)wid * 1024u;
    const int aoff = lds_byte(wr * 64 + fr, fq * 8), boff = lds_byte(wc * 32 + fr, fq * 8);
#define PG8_SA(b, h) (((b) * 2 + (h)) * HTB)
#define PG8_SB(b, h) ((4 + (b) * 2 + (h)) * HTB)
#define PG8_STAGE(bufoff, gbase, voff) do { _Pragma("unroll") for (int _i = 0; _i < 2; ++_i) \
        __builtin_amdgcn_global_load_lds((const unsigned*)((const char*)(gbase) + (voff)[_i]), (PG8_LAS unsigned*)(lds + (bufoff) + ldsw + _i * 8192), 16, 0, 0); } while (0)
#define PG8_LDA(dst, b, h) do { _Pragma("unroll") for (int m = 0; m < 4; ++m) _Pragma("unroll") for (int k = 0; k < 2; ++k) dst[m][k] = *(const PG8_LAS bf16x8*)(lds + PG8_SA(b, h) + aoff + m * 2048 + k * 1024); } while (0)
#define PG8_LDB(dst, b, h) do { _Pragma("unroll") for (int n = 0; n < 2; ++n) _Pragma("unroll") for (int k = 0; k < 2; ++k) dst[n][k] = *(const PG8_LAS bf16x8*)(lds + PG8_SB(b, h) + boff + n * 2048 + k * 1024); } while (0)
#define PG8_MMA(ai, bj, At, Bt) do { __builtin_amdgcn_s_setprio(1); _Pragma("unroll") for (int m = 0; m < 4; ++m) _Pragma("unroll") for (int n = 0; n < 2; ++n) _Pragma("unroll") for (int k = 0; k < 2; ++k) \
        acc[ai][bj][m][n] = __builtin_amdgcn_mfma_f32_16x16x32_bf16(Bt[n][k], At[m][k], acc[ai][bj][m][n], 0, 0, 0); __builtin_amdgcn_s_setprio(0); } while (0)
#define PG8_WAIT_V(n) asm volatile("s_waitcnt vmcnt(" #n ")" ::: "memory")
#define PG8_WAIT_L(n) asm volatile("s_waitcnt lgkmcnt(" #n ")" ::: "memory")
#define PG8_BAR __builtin_amdgcn_s_barrier()
#define PG8_SCHED __builtin_amdgcn_sched_barrier(0)
    Unit cur, nxt; int ui = 0;
    if (!S.next(0, cur)) return;
    f32x4 acc[2][2][4][2];
#pragma unroll
    for (int a = 0; a < 2; ++a)
#pragma unroll
        for (int b = 0; b < 2; ++b)
#pragma unroll
            for (int m = 0; m < 4; ++m)
#pragma unroll
                for (int n = 0; n < 2; ++n) acc[a][b][m][n] = (f32x4){0.f, 0.f, 0.f, 0.f};
    bf16x8 At[4][2], B0[2][2], B1[2][2];
    const char* cA = (const char*)g.A + (size_t)cur.pm * tstep; const char* cB = (const char*)g.Bt + (size_t)cur.pn * tstep;
    S.a_ready(cur);
    if constexpr (SP2) {
        PG8_STAGE(PG8_SB(0, 0), cB, voffB); PG8_STAGE(PG8_SB(0, 1), cB + hstep, voffB); PG8_STAGE(PG8_SA(0, 0), cA, voffA); PG8_STAGE(PG8_SA(0, 1), cA + hstep, voffA);
        if (wr == 1) PG8_BAR;
        PG8_WAIT_V(2); PG8_BAR;
        PG8_STAGE(PG8_SB(1, 0), cB + kstep, voffB); PG8_STAGE(PG8_SA(1, 0), cA + kstep, voffA); PG8_STAGE(PG8_SB(1, 1), cB + hstep + kstep, voffB);
        PG8_WAIT_V(6); PG8_BAR;
    } else {
        PG8_STAGE(PG8_SB(0, 0), cB, voffB); PG8_STAGE(PG8_SA(0, 0), cA, voffA); PG8_STAGE(PG8_SB(0, 1), cB + hstep, voffB); PG8_STAGE(PG8_SA(0, 1), cA + hstep, voffA);
        if (wr == 1) PG8_BAR;
        PG8_WAIT_V(4); PG8_BAR;
        PG8_STAGE(PG8_SB(1, 0), cB + kstep, voffB); PG8_STAGE(PG8_SA(1, 0), cA + kstep, voffA); PG8_STAGE(PG8_SB(1, 1), cB + hstep + kstep, voffB);
        PG8_WAIT_V(6); PG8_BAR;
    }
    for (;;) {
        const bool has_next = S.next(ui + 1, nxt);
        const char* nA = has_next ? (const char*)g.A + (size_t)nxt.pm * tstep : cA; const char* nB = has_next ? (const char*)g.Bt + (size_t)nxt.pn * tstep : cB;
        for (int t = 0; t < nt; t += 2) {
            const bool last = (t == nt - 2);
            const char* a1 = cA + (size_t)(t + 1) * kstep;
            const char* a2 = last ? nA : cA + (size_t)(t + 2) * kstep; const char* b2 = last ? nB : cB + (size_t)(t + 2) * kstep;
            const char* a3 = a2 + kstep; const char* b3 = b2 + kstep;
            if (last && has_next) S.a_ready(nxt);
            if constexpr (SP2) {
            PG8_LDB(B0, 0, 0); PG8_LDB(B1, 0, 1); PG8_SCHED; PG8_LDA(At, 0, 0); PG8_STAGE(PG8_SA(1, 1), a1 + hstep, voffA);
            PG8_WAIT_V(8); PG8_WAIT_L(0); PG8_BAR; PG8_MMA(0, 0, At, B0); PG8_MMA(0, 1, At, B1); PG8_BAR; PG8_SCHED;
            PG8_LDA(At, 0, 1); PG8_STAGE(PG8_SB(0, 0), b2, voffB); PG8_STAGE(PG8_SB(0, 1), b2 + hstep, voffB); PG8_STAGE(PG8_SA(0, 0), a2, voffA);
            PG8_WAIT_V(8); PG8_WAIT_L(0); PG8_BAR; PG8_MMA(1, 0, At, B0); PG8_MMA(1, 1, At, B1); PG8_BAR; PG8_SCHED;
            PG8_LDB(B0, 1, 0); PG8_LDB(B1, 1, 1); PG8_SCHED; PG8_LDA(At, 1, 0); PG8_STAGE(PG8_SA(0, 1), a2 + hstep, voffA);
            PG8_WAIT_V(8); PG8_WAIT_L(0); PG8_BAR; PG8_MMA(0, 0, At, B0); PG8_MMA(0, 1, At, B1); PG8_BAR; PG8_SCHED;
            PG8_LDA(At, 1, 1); PG8_STAGE(PG8_SB(1, 0), b3, voffB); PG8_STAGE(PG8_SB(1, 1), b3 + hstep, voffB); PG8_STAGE(PG8_SA(1, 0), a3, voffA);
            PG8_WAIT_V(8); PG8_WAIT_L(0); PG8_BAR; PG8_MMA(1, 0, At, B0); PG8_MMA(1, 1, At, B1); PG8_BAR; PG8_SCHED;
            } else {
            PG8_LDB(B0, 0, 0); PG8_SCHED; PG8_LDA(At, 0, 0); PG8_STAGE(PG8_SA(1, 1), a1 + hstep, voffA);
            PG8_WAIT_L(8); PG8_BAR; PG8_WAIT_L(0); PG8_MMA(0, 0, At, B0); PG8_BAR; PG8_SCHED;
            PG8_LDB(B1, 0, 1); PG8_STAGE(PG8_SB(0, 0), b2, voffB);
            PG8_BAR; PG8_WAIT_L(0); PG8_MMA(0, 1, At, B1); PG8_BAR;
            PG8_LDA(At, 0, 1); PG8_STAGE(PG8_SA(0, 0), a2, voffA);
            PG8_BAR; PG8_WAIT_L(0); PG8_MMA(1, 0, At, B0); PG8_BAR; PG8_SCHED;
            PG8_STAGE(PG8_SB(0, 1), b2 + hstep, voffB);
            PG8_WAIT_V(6); PG8_BAR; PG8_MMA(1, 1, At, B1); PG8_BAR;
            PG8_LDB(B0, 1, 0); PG8_SCHED; PG8_LDA(At, 1, 0); PG8_STAGE(PG8_SA(0, 1), a2 + hstep, voffA);
            PG8_WAIT_L(8); PG8_BAR; PG8_WAIT_L(0); PG8_MMA(0, 0, At, B0); PG8_BAR; PG8_SCHED;
            PG8_LDB(B1, 1, 1); PG8_STAGE(PG8_SB(1, 0), b3, voffB);
            PG8_BAR; PG8_WAIT_L(0); PG8_MMA(0, 1, At, B1); PG8_BAR;
            PG8_LDA(At, 1, 1); PG8_STAGE(PG8_SA(1, 0), a3, voffA);
            PG8_BAR; PG8_WAIT_L(0); PG8_MMA(1, 0, At, B0); PG8_BAR; PG8_SCHED;
            PG8_STAGE(PG8_SB(1, 1), b3 + hstep, voffB);
            PG8_WAIT_V(6); PG8_BAR; PG8_MMA(1, 1, At, B1); PG8_BAR;
            }
        }
        if constexpr (ALIGN_EPI) { if (wr == 0) PG8_BAR; }
        if constexpr (!Epi::AFTER_DRAIN) { E(acc, cur, wr, wc, fr, fq); S.done(cur); }
        if (!has_next) break;
#pragma unroll
        for (int a = 0; a < 2; ++a)
#pragma unroll
            for (int b = 0; b < 2; ++b)
#pragma unroll
                for (int m = 0; m < 4; ++m)
#pragma unroll
                    for (int n = 0; n < 2; ++n) acc[a][b][m][n] = (f32x4){0.f, 0.f, 0.f, 0.f};
        cur = nxt; cA = nA; cB = nB; ++ui;
        if constexpr (ALIGN_EPI) { if (wr == 1) PG8_BAR; }
    }
    PG8_WAIT_V(0);
    if constexpr (!ALIGN_EPI) { if (wr == 0) PG8_BAR; }
    PG8_BAR;
    if constexpr (Epi::AFTER_DRAIN) { E.fused(acc, cur, wr, wc, fr, fq, lds, wid, lane); S.done(cur); }
#undef PG8_SA
#undef PG8_SB
#undef PG8_STAGE
#undef PG8_LDA
#undef PG8_LDB
#undef PG8_MMA
#undef PG8_WAIT_V
#undef PG8_WAIT_L
#undef PG8_BAR
#undef PG8_SCHED
}
template <class Epi, class Sched, bool ALIGN_EPI = false, bool SP2 = false>
__device__ __forceinline__ void gemm_phase_gather(PG8_LAS unsigned char* lds, const Gemm g, const Sched& S, const Epi& E) {
    const int tid = threadIdx.x, wid = __builtin_amdgcn_readfirstlane(tid >> 6), lane = tid & 63, wr = wid >> 2, wc = wid & 3, fr = lane & 15, fq = lane >> 4;
    const int K = g.K, nt = K / BK;
    unsigned voffA[2], voffB[2]; int RA[2];
#pragma unroll
    for (int i = 0; i < 2; ++i) { int R, C; stage_rc(tid * 16 + i * 8192, R, C); const int Rb = Epi::PERM ? ((R & ~31) + perm32(R & 31)) : R;
        RA[i] = R; voffA[i] = (unsigned)C * 2u; voffB[i] = (unsigned)(Rb * K + C) * 2u; }
    const size_t kstep = (size_t)(BK * 2);
    const size_t hstep = (size_t)HALF * K * 2;
    const size_t tstep = 2 * hstep;
    const unsigned ldsw = (unsigned)wid * 1024u;
    const int aoff = lds_byte(wr * 64 + fr, fq * 8), boff = lds_byte(wc * 32 + fr, fq * 8);
#define PG8_SA(b, h) (((b) * 2 + (h)) * HTB)
#define PG8_SB(b, h) ((4 + (b) * 2 + (h)) * HTB)
#define PG8_STAGE(bufoff, gbase, voff) do { _Pragma("unroll") for (int _i = 0; _i < 2; ++_i) \
        __builtin_amdgcn_global_load_lds((const unsigned*)((const char*)(gbase) + (voff)[_i]), (PG8_LAS unsigned*)(lds + (bufoff) + ldsw + _i * 8192), 16, 0, 0); } while (0)
#define PG8_LDA(dst, b, h) do { _Pragma("unroll") for (int m = 0; m < 4; ++m) _Pragma("unroll") for (int k = 0; k < 2; ++k) dst[m][k] = *(const PG8_LAS bf16x8*)(lds + PG8_SA(b, h) + aoff + m * 2048 + k * 1024); } while (0)
#define PG8_LDB(dst, b, h) do { _Pragma("unroll") for (int n = 0; n < 2; ++n) _Pragma("unroll") for (int k = 0; k < 2; ++k) dst[n][k] = *(const PG8_LAS bf16x8*)(lds + PG8_SB(b, h) + boff + n * 2048 + k * 1024); } while (0)
#define PG8_MMA(ai, bj, At, Bt) do { __builtin_amdgcn_s_setprio(1); _Pragma("unroll") for (int m = 0; m < 4; ++m) _Pragma("unroll") for (int n = 0; n < 2; ++n) _Pragma("unroll") for (int k = 0; k < 2; ++k) \
        acc[ai][bj][m][n] = __builtin_amdgcn_mfma_f32_16x16x32_bf16(Bt[n][k], At[m][k], acc[ai][bj][m][n], 0, 0, 0); __builtin_amdgcn_s_setprio(0); } while (0)
#define PG8_WAIT_V(n) asm volatile("s_waitcnt vmcnt(" #n ")" ::: "memory")
#define PG8_WAIT_L(n) asm volatile("s_waitcnt lgkmcnt(" #n ")" ::: "memory")
#define PG8_BAR __builtin_amdgcn_s_barrier()
#define PG8_SCHED __builtin_amdgcn_sched_barrier(0)
    Unit cur, nxt; int ui = 0;
    if (!S.next(0, cur)) return;
    f32x4 acc[2][2][4][2];
#pragma unroll
    for (int a = 0; a < 2; ++a)
#pragma unroll
        for (int b = 0; b < 2; ++b)
#pragma unroll
            for (int m = 0; m < 4; ++m)
#pragma unroll
                for (int n = 0; n < 2; ++n) acc[a][b][m][n] = (f32x4){0.f, 0.f, 0.f, 0.f};
    bf16x8 At[4][2], B0[2][2], B1[2][2];
    const char* cA = (const char*)g.A; unsigned cvo0[2], cvo1[2], nvo0[2], nvo1[2];
    _Pragma("unroll") for (int i = 0; i < 2; ++i) { cvo0[i] = S.arow(cur, RA[i]) * (unsigned)(K * 2) + voffA[i]; cvo1[i] = S.arow(cur, HALF + RA[i]) * (unsigned)(K * 2) + voffA[i]; }
    const char* cB = (const char*)g.Bt + (size_t)cur.pn * tstep;
    S.a_ready(cur);
    if constexpr (SP2) {
        PG8_STAGE(PG8_SB(0, 0), cB, voffB); PG8_STAGE(PG8_SB(0, 1), cB + hstep, voffB); PG8_STAGE(PG8_SA(0, 0), cA, cvo0); PG8_STAGE(PG8_SA(0, 1), cA, cvo1);
        if (wr == 1) PG8_BAR;
        PG8_WAIT_V(2); PG8_BAR;
        PG8_STAGE(PG8_SB(1, 0), cB + kstep, voffB); PG8_STAGE(PG8_SA(1, 0), cA + kstep, cvo0); PG8_STAGE(PG8_SB(1, 1), cB + hstep + kstep, voffB);
        PG8_WAIT_V(6); PG8_BAR;
    } else {
        PG8_STAGE(PG8_SB(0, 0), cB, voffB); PG8_STAGE(PG8_SA(0, 0), cA, cvo0); PG8_STAGE(PG8_SB(0, 1), cB + hstep, voffB); PG8_STAGE(PG8_SA(0, 1), cA, cvo1);
        if (wr == 1) PG8_BAR;
        PG8_WAIT_V(4); PG8_BAR;
        PG8_STAGE(PG8_SB(1, 0), cB + kstep, voffB); PG8_STAGE(PG8_SA(1, 0), cA + kstep, cvo0); PG8_STAGE(PG8_SB(1, 1), cB + hstep + kstep, voffB);
        PG8_WAIT_V(6); PG8_BAR;
    }
    for (;;) {
        const bool has_next = S.next(ui + 1, nxt);
        _Pragma("unroll") for (int i = 0; i < 2; ++i) { nvo0[i] = has_next ? S.arow(nxt, RA[i]) * (unsigned)(K * 2) + voffA[i] : cvo0[i]; nvo1[i] = has_next ? S.arow(nxt, HALF + RA[i]) * (unsigned)(K * 2) + voffA[i] : cvo1[i]; }
        const char* nB = has_next ? (const char*)g.Bt + (size_t)nxt.pn * tstep : cB;
        for (int t = 0; t < nt; t += 2) {
            const bool last = (t == nt - 2);
            const char* a1 = cA + (size_t)(t + 1) * kstep;
            const char* a2 = last ? cA : cA + (size_t)(t + 2) * kstep; unsigned xo0[2], xo1[2]; _Pragma("unroll") for (int i = 0; i < 2; ++i) { xo0[i] = last ? nvo0[i] : cvo0[i]; xo1[i] = last ? nvo1[i] : cvo1[i]; } const char* b2 = last ? nB : cB + (size_t)(t + 2) * kstep;
            const char* a3 = a2 + kstep; const char* b3 = b2 + kstep;
            if (last && has_next) S.a_ready(nxt);
            if constexpr (SP2) {
            PG8_LDB(B0, 0, 0); PG8_LDB(B1, 0, 1); PG8_SCHED; PG8_LDA(At, 0, 0); PG8_STAGE(PG8_SA(1, 1), a1, cvo1);
            PG8_WAIT_V(8); PG8_WAIT_L(0); PG8_BAR; PG8_MMA(0, 0, At, B0); PG8_MMA(0, 1, At, B1); PG8_BAR; PG8_SCHED;
            PG8_LDA(At, 0, 1); PG8_STAGE(PG8_SB(0, 0), b2, voffB); PG8_STAGE(PG8_SB(0, 1), b2 + hstep, voffB); PG8_STAGE(PG8_SA(0, 0), a2, xo0);
            PG8_WAIT_V(8); PG8_WAIT_L(0); PG8_BAR; PG8_MMA(1, 0, At, B0); PG8_MMA(1, 1, At, B1); PG8_BAR; PG8_SCHED;
            PG8_LDB(B0, 1, 0); PG8_LDB(B1, 1, 1); PG8_SCHED; PG8_LDA(At, 1, 0); PG8_STAGE(PG8_SA(0, 1), a2, xo1);
            PG8_WAIT_V(8); PG8_WAIT_L(0); PG8_BAR; PG8_MMA(0, 0, At, B0); PG8_MMA(0, 1, At, B1); PG8_BAR; PG8_SCHED;
            PG8_LDA(At, 1, 1); PG8_STAGE(PG8_SB(1, 0), b3, voffB); PG8_STAGE(PG8_SB(1, 1), b3 + hstep, voffB); PG8_STAGE(PG8_SA(1, 0), a3, xo0);
            PG8_WAIT_V(8); PG8_WAIT_L(0); PG8_BAR; PG8_MMA(1, 0, At, B0); PG8_MMA(1, 1, At, B1); PG8_BAR; PG8_SCHED;
            } else {
            PG8_LDB(B0, 0, 0); PG8_SCHED; PG8_LDA(At, 0, 0); PG8_STAGE(PG8_SA(1, 1), a1, cvo1);
            PG8_WAIT_L(8); PG8_BAR; PG8_WAIT_L(0); PG8_MMA(0, 0, At, B0); PG8_BAR; PG8_SCHED;
            PG8_LDB(B1, 0, 1); PG8_STAGE(PG8_SB(0, 0), b2, voffB);
            PG8_BAR; PG8_WAIT_L(0); PG8_MMA(0, 1, At, B1); PG8_BAR;
            PG8_LDA(At, 0, 1); PG8_STAGE(PG8_SA(0, 0), a2, xo0);
            PG8_BAR; PG8_WAIT_L(0); PG8_MMA(1, 0, At, B0); PG8_BAR; PG8_SCHED;
            PG8_STAGE(PG8_SB(0, 1), b2 + hstep, voffB);
            PG8_WAIT_V(6); PG8_BAR; PG8_MMA(1, 1, At, B1); PG8_BAR;
            PG8_LDB(B0, 1, 0); PG8_SCHED; PG8_LDA(At, 1, 0); PG8_STAGE(PG8_SA(0, 1), a2, xo1);
            PG8_WAIT_L(8); PG8_BAR; PG8_WAIT_L(0); PG8_MMA(0, 0, At, B0); PG8_BAR; PG8_SCHED;
            PG8_LDB(B1, 1, 1); PG8_STAGE(PG8_SB(1, 0), b3, voffB);
            PG8_BAR; PG8_WAIT_L(0); PG8_MMA(0, 1, At, B1); PG8_BAR;
            PG8_LDA(At, 1, 1); PG8_STAGE(PG8_SA(1, 0), a3, xo0);
            PG8_BAR; PG8_WAIT_L(0); PG8_MMA(1, 0, At, B0); PG8_BAR; PG8_SCHED;
            PG8_STAGE(PG8_SB(1, 1), b3 + hstep, voffB);
            PG8_WAIT_V(6); PG8_BAR; PG8_MMA(1, 1, At, B1); PG8_BAR;
            }
        }
        if constexpr (ALIGN_EPI) { if (wr == 0) PG8_BAR; }
        if constexpr (!Epi::AFTER_DRAIN) { E(acc, cur, wr, wc, fr, fq); S.done(cur); }
        if (!has_next) break;
#pragma unroll
        for (int a = 0; a < 2; ++a)
#pragma unroll
            for (int b = 0; b < 2; ++b)
#pragma unroll
                for (int m = 0; m < 4; ++m)
#pragma unroll
                    for (int n = 0; n < 2; ++n) acc[a][b][m][n] = (f32x4){0.f, 0.f, 0.f, 0.f};
        cur = nxt; cB = nB; ++ui; _Pragma("unroll") for (int i = 0; i < 2; ++i) { cvo0[i] = nvo0[i]; cvo1[i] = nvo1[i]; }
        if constexpr (ALIGN_EPI) { if (wr == 1) PG8_BAR; }
    }
    PG8_WAIT_V(0);
    if constexpr (!ALIGN_EPI) { if (wr == 0) PG8_BAR; }
    PG8_BAR;
    if constexpr (Epi::AFTER_DRAIN) { E.fused(acc, cur, wr, wc, fr, fq, lds, wid, lane); S.done(cur); }
#undef PG8_SA
#undef PG8_SB
#undef PG8_STAGE
#undef PG8_LDA
#undef PG8_LDB
#undef PG8_MMA
#undef PG8_WAIT_V
#undef PG8_WAIT_L
#undef PG8_BAR
#undef PG8_SCHED
}
}

struct Args {
    const float* in[22];
    float* out; unsigned char* ws;
    int ph_lo, ph_hi;
};
enum { I_X = 0, I_MEM, I_ATTN_G, I_MEM_G, I_WIN, I_WGK, I_BGK, I_GLA_OG, I_MBQ_G, I_MBK_G, I_WMEMKV, I_MEMQ_G, I_MEMK_G, I_WOUT, I_FFN_G,
       I_WRG, I_BRG, I_WRE, I_BRE, I_WGATE, I_WUP, I_WDOWN };

struct Frame {
    LAS unsigned char* lds; int tid, lane, wave, G, bid;
    const float* const* in; float* out; unsigned char* ws; unsigned* ctl;
};

__device__ __forceinline__ void ph_norm_in(Frame& F) {
    bf16_t* XN = (bf16_t*)(F.ws + WS_XN); float* LR = (float*)(F.ws + WS_LR);
    const int gw = F.bid * 8 + F.wave, NGW = F.G * 8;
    for (int r = gw; r < T_TOK + 512; r += NGW) {
        const float* src = r < T_TOK ? F.in[I_X] + (size_t)r * DM : F.in[I_MEM] + (size_t)(r - T_TOK) * DM;
        const float* g = r < T_TOK ? F.in[I_ATTN_G] : F.in[I_MEM_G];
        f32x4 v[4]; float ss = 0.f;
#pragma unroll
        for (int j = 0; j < 4; ++j) { v[j] = ((const f32x4*)src)[F.lane + 64 * j]; ss += v[j].x * v[j].x + v[j].y * v[j].y + v[j].z * v[j].z + v[j].w * v[j].w; }
        const float rstd = rsqrtf(wave_sum(ss) * (1.f / DM) + EPS);
#pragma unroll
        for (int j = 0; j < 4; ++j) { const f32x4 gg = ((const f32x4*)g)[F.lane + 64 * j]; v[j] = v[j] * rstd * gg;
            u32x2 o; o.x = pk2(v[j].x, v[j].y); o.y = pk2(v[j].z, v[j].w);
            ((u32x2*)(XN + (size_t)r * DM))[F.lane + 64 * j] = o; }
    }
}

__device__ __forceinline__ void tr_item(const float* W, int ldw, int scol0, bf16_t* WT, int K, int drow0, int k0, LAS float* scr, int lane) {
    f32x4 v[8];
#pragma unroll
    for (int i = 0; i < 8; ++i) v[i] = *(const f32x4*)(W + (size_t)(k0 + 8 * i + (lane >> 3)) * ldw + scol0 + 4 * (lane & 7));
#pragma unroll
    for (int i = 0; i < 8; ++i) { LAS float* s = scr + (8 * i + (lane >> 3)) * 33 + 4 * (lane & 7); s[0] = v[i].x; s[1] = v[i].y; s[2] = v[i].z; s[3] = v[i].w; }
    asm volatile("s_waitcnt lgkmcnt(0)" ::: "memory");
    const int c = lane & 7;
#pragma unroll
    for (int j = 0; j < 4; ++j) { const int n = (lane >> 3) + 8 * j; const LAS float* s = scr + (8 * c) * 33 + n;
        u32x4 o; o.x = pk2(s[0 * 33], s[1 * 33]); o.y = pk2(s[2 * 33], s[3 * 33]); o.z = pk2(s[4 * 33], s[5 * 33]); o.w = pk2(s[6 * 33], s[7 * 33]);
        *(u32x4*)(WT + (size_t)(drow0 + n) * K + k0 + 8 * c) = o; }
    asm volatile("s_waitcnt lgkmcnt(0)" ::: "memory");
}
__device__ __forceinline__ void ph_prep_weights(Frame& F) {
    LAS float* scr = (LAS float*)(F.lds + F.wave * 16384);
    bf16_t* WIN_T = (bf16_t*)(F.ws + WS_WIN_T); bf16_t* WOUT_T = (bf16_t*)(F.ws + WS_WOUT_T); bf16_t* WGU_T = (bf16_t*)(F.ws + WS_WGU_T); bf16_t* WD_T = (bf16_t*)(F.ws + WS_WD_T);
    const int gw = F.bid * 8 + F.wave, NGW = F.G * 8;
    { bf16_t* WLR_T = (bf16_t*)(F.ws + WS_WLR_T);
      for (int idx = F.bid * 512 + F.tid; idx < 16 * 1024; idx += F.G * 512) { const int i = idx >> 10, k = idx & 1023; WLR_T[idx] = (bf16_t)f2bf(F.in[I_WIN][(size_t)k * DIN + 1536 + i]); } }
    constexpr int N_IN = 12 * 8 * 16, N_OUT = 4 * 8 * 16, N_GU = 32 * 4 * 8 * 16, N_DN = 32 * 4 * 8 * 8;
    for (int it = gw; it < N_IN + N_OUT + N_GU + N_DN; it += NGW) {
        int r = it;
        if (r < N_IN) { const int kb = r & 15, g32 = (r >> 4) & 7, pn = r >> 7, bj = g32 >> 2, wc = g32 & 3; const int L0 = 256 * pn + 64 * wc + 32 * bj;
            if (pn < 10) tr_item(F.in[I_WIN], DIN, L0 < 1536 ? L0 : L0 + 16, WIN_T, 1024, 256 * pn + 32 * g32, 64 * kb, scr, F.lane);
            else tr_item(F.in[I_WMEMKV], 512, L0 - 2560, WIN_T, 1024, 256 * pn + 32 * g32, 64 * kb, scr, F.lane);
            continue; }
        r -= N_IN;
        if (r < N_OUT) { const int kb = r & 15, g32 = (r >> 4) & 7, pn = r >> 7, bj = g32 >> 2, wc = g32 & 3;
            tr_item(F.in[I_WOUT], 1024, 256 * pn + 64 * wc + 32 * bj, WOUT_T, 1024, 256 * pn + 32 * g32, 64 * kb, scr, F.lane); continue; }
        r -= N_OUT;
        if (r < N_GU) { const int kb = r & 15, g32 = (r >> 4) & 7, pn = (r >> 7) & 3, e = r >> 9, bj = g32 >> 2, wc = g32 & 3;
            tr_item((bj ? F.in[I_WUP] : F.in[I_WGATE]) + (size_t)e * 1024 * 512, 512, 128 * pn + 32 * wc, WGU_T, 1024, e * 1024 + 256 * pn + 32 * g32, 64 * kb, scr, F.lane); continue; }
        r -= N_GU;
        { const int kb = r & 7, g32 = (r >> 3) & 7, pn = (r >> 6) & 3, e = r >> 8, bj = g32 >> 2, wc = g32 & 3;
            tr_item(F.in[I_WDOWN] + (size_t)e * 512 * 1024, 1024, 256 * pn + 64 * wc + 32 * bj, WD_T, 512, e * 1024 + 256 * pn + 32 * g32, 64 * kb, scr, F.lane); }
    }
}

struct ProjOrder {
    pg8::StaticOrder s;
    __device__ __forceinline__ void init(int G, int c) { s.init(T_TOK, PROJ_LD, G, c); }
    __device__ __forceinline__ bool next(int i, pg8::Unit& u) const {
        if (s.next(i, u)) return true;
        const long L = (long)i * s.G + s.c - s.nwg;
        if (L >= 0 && L < 4) { u.pm = 64 + (int)(L >> 1); u.pn = 10 + (int)(L & 1); u.aux = 0; return true; }
        return false;
    }
    __device__ __forceinline__ void a_ready(const pg8::Unit&) const {}
    __device__ __forceinline__ void done(const pg8::Unit&) const {}
};
struct EpiProj {
    static constexpr bool PERM = true, AFTER_DRAIN = false;
    bf16_t* PROJ; bf16_t* MEMKV; float* KMEAN; bool do_kmean; const float* g_mbq; const float* g_mbk; const float* g_memq; const float* g_memk;
    __device__ __forceinline__ void operator()(const pg8::f32x4 (&acc)[2][2][4][2], const pg8::Unit& u, int wr, int wc, int fr, int fq) const {
        const int pn = u.pn;
        const float* gain = pn == 6 ? g_mbq : pn == 7 ? g_mbk : pn == 9 ? g_memq : pn == 10 ? g_memk : nullptr;
        const float post = (pn == 6 || pn == 9) ? C2 : (pn == 0 ? 0.125f : 1.f);
        float gv[2][8];
#pragma unroll
        for (int bj = 0; bj < 2; ++bj)
#pragma unroll
            for (int j = 0; j < 8; ++j) gv[bj][j] = (gain ? gain[32 * bj + 8 * fq + j] : 1.f) * post;
        bf16_t* base; int ld;
        if (pn < 10) { base = PROJ + (size_t)(u.pm * 256) * PROJ_LD + 256 * pn; ld = PROJ_LD; } else { base = MEMKV + (size_t)((u.pm - 64) * 256) * 512 + 256 * (pn - 10); ld = 512; }
        base += 64 * wc + 8 * fq;
        float ks[2][8];
#pragma unroll
        for (int bj = 0; bj < 2; ++bj)
#pragma unroll
            for (int j = 0; j < 8; ++j) ks[bj][j] = 0.f;
#pragma unroll
        for (int ai = 0; ai < 2; ++ai)
#pragma unroll
            for (int m = 0; m < 4; ++m) {
                const int row = 128 * ai + 64 * wr + 16 * m + fr; float rstd = 1.f;
                if (gain) { float ss = 0.f;
#pragma unroll
                    for (int bj = 0; bj < 2; ++bj)
#pragma unroll
                        for (int n = 0; n < 2; ++n) { const pg8::f32x4 x = acc[ai][bj][m][n]; ss += (x[0] * x[0] + x[1] * x[1]) + (x[2] * x[2] + x[3] * x[3]); }
                    ss += __shfl_xor(ss, 16); ss += __shfl_xor(ss, 32); rstd = rsqrtf(ss * (1.f / 64.f) + EPS); }
#pragma unroll
                for (int bj = 0; bj < 2; ++bj) { float o[8];
#pragma unroll
                    for (int j = 0; j < 8; ++j) o[j] = acc[ai][bj][m][j >> 2][j & 3] * rstd * gv[bj][j];
                    if (pn == 7) {
#pragma unroll
                        for (int j = 0; j < 8; ++j) ks[bj][j] += o[j]; }
                    u32x4 w; w.x = pg8::cvt_pk_bf16(o[0], o[1]); w.y = pg8::cvt_pk_bf16(o[2], o[3]); w.z = pg8::cvt_pk_bf16(o[4], o[5]); w.w = pg8::cvt_pk_bf16(o[6], o[7]);
                    *(u32x4*)(base + (size_t)row * ld + 32 * bj) = w; }
            }
        if (pn == 7 && do_kmean) {
            float* km = KMEAN + (((u.pm >> 5) * 4 + wc) * 32 + (u.pm & 31)) * 64 + 8 * fq;
#pragma unroll
            for (int bj = 0; bj < 2; ++bj)
#pragma unroll
                for (int j = 0; j < 8; ++j) { float v = ks[bj][j]; v += __shfl_xor(v, 1); v += __shfl_xor(v, 2); v += __shfl_xor(v, 4); v += __shfl_xor(v, 8);
                    if (fr == 0) atomicAdd(km + 32 * bj + j, v * (1.f / 256.f)); }
        }
    }
};
__device__ __forceinline__ void lr_task(Frame& F, int task) {
    const bf16_t* XN = (const bf16_t*)(F.ws + WS_XN); const bf16_t* WLR_T = (const bf16_t*)(F.ws + WS_WLR_T); float* LR = (float*)(F.ws + WS_LR);
    const int l15 = F.lane & 15, g4 = F.lane >> 4; const bf16_t* ap = XN + (size_t)(task * 16 + l15) * DM + 8 * g4; const bf16_t* bp = WLR_T + (size_t)l15 * DM + 8 * g4;
    f32x4 acc = {0.f, 0.f, 0.f, 0.f};
#pragma unroll 8
    for (int ks = 0; ks < 32; ++ks) acc = __builtin_amdgcn_mfma_f32_16x16x32_bf16(*(const bf16x8*)(ap + 32 * ks), *(const bf16x8*)(bp + 32 * ks), acc, 0, 0, 0);
#pragma unroll
    for (int e = 0; e < 4; ++e) LR[(size_t)(task * 16 + 4 * g4 + e) * 16 + l15] = acc[e];
}
__device__ __forceinline__ void ph_proj_gemm(Frame& F, bool do_kmean) {
    { const int half = F.G >> 1; if (F.bid >= half) for (int task = (F.bid - half) * 8 + F.wave; task < T_TOK / 16; task += (F.G - half) * 8) lr_task(F, task); }
    pg8::Gemm g{(const bf16_t*)(F.ws + WS_XN), (const bf16_t*)(F.ws + WS_WIN_T), T_TOK + 512, 3072, 1024};
    ProjOrder S; S.init(F.G, F.bid);
    EpiProj E{(bf16_t*)(F.ws + WS_PROJ), (bf16_t*)(F.ws + WS_MEMKV), (float*)(F.ctl + CW_KMEAN), do_kmean, F.in[I_MBQ_G], F.in[I_MBK_G], F.in[I_MEMQ_G], F.in[I_MEMK_G]};
    pg8::gemm_phase<EpiProj, ProjOrder, true, true>(F.lds, g, S, E);
}

__device__ __forceinline__ void attend_naive(const float (&q)[64], float (&o)[64], float& m, float& l, const bf16_t* kp, const bf16_t* vp, int ld, int s0, int s1, int t, float slope2) {
    for (int s = s0; s < s1; ++s) {
        const u32x4* kr = (const u32x4*)(kp + (size_t)s * ld); float sc = 0.f;
#pragma unroll
        for (int c = 0; c < 8; ++c) { const u32x4 w = kr[c];
            sc += q[8 * c + 0] * bf2f(w.x & 0xffffu) + q[8 * c + 1] * bf2f(w.x >> 16) + q[8 * c + 2] * bf2f(w.y & 0xffffu) + q[8 * c + 3] * bf2f(w.y >> 16)
                + q[8 * c + 4] * bf2f(w.z & 0xffffu) + q[8 * c + 5] * bf2f(w.z >> 16) + q[8 * c + 6] * bf2f(w.w & 0xffffu) + q[8 * c + 7] * bf2f(w.w >> 16); }
        sc -= slope2 * (float)(t - s);
        float p;
        if (sc > m) { const float f = exp2f(m - sc); l *= f;
#pragma unroll
            for (int d = 0; d < 64; ++d) o[d] *= f;
            m = sc; p = 1.f; } else p = exp2f(sc - m);
        l += p;
        const u32x4* vr = (const u32x4*)(vp + (size_t)s * ld);
#pragma unroll
        for (int c = 0; c < 8; ++c) { const u32x4 w = vr[c];
            o[8 * c + 0] += p * bf2f(w.x & 0xffffu); o[8 * c + 1] += p * bf2f(w.x >> 16); o[8 * c + 2] += p * bf2f(w.y & 0xffffu); o[8 * c + 3] += p * bf2f(w.y >> 16);
            o[8 * c + 4] += p * bf2f(w.z & 0xffffu); o[8 * c + 5] += p * bf2f(w.z >> 16); o[8 * c + 6] += p * bf2f(w.w & 0xffffu); o[8 * c + 7] += p * bf2f(w.w >> 16); }
    }
}
__device__ __forceinline__ void load_q64(float (&q)[64], const bf16_t* p) {
#pragma unroll
    for (int c = 0; c < 8; ++c) { const u32x4 w = ((const u32x4*)p)[c];
        q[8 * c + 0] = bf2f(w.x & 0xffffu); q[8 * c + 1] = bf2f(w.x >> 16); q[8 * c + 2] = bf2f(w.y & 0xffffu); q[8 * c + 3] = bf2f(w.y >> 16);
        q[8 * c + 4] = bf2f(w.z & 0xffffu); q[8 * c + 5] = bf2f(w.z >> 16); q[8 * c + 6] = bf2f(w.w & 0xffffu); q[8 * c + 7] = bf2f(w.w >> 16); }
}
__device__ __forceinline__ void store_o64(const float (&o)[64], float inv, bf16_t* p) {
#pragma unroll
    for (int c = 0; c < 8; ++c) { u32x4 w; w.x = pk2(o[8 * c] * inv, o[8 * c + 1] * inv); w.y = pk2(o[8 * c + 2] * inv, o[8 * c + 3] * inv); w.z = pk2(o[8 * c + 4] * inv, o[8 * c + 5] * inv); w.w = pk2(o[8 * c + 6] * inv, o[8 * c + 7] * inv);
        ((u32x4*)p)[c] = w; }
}


typedef float f32x2_t __attribute__((ext_vector_type(2)));
typedef __bf16 bf16x2_t __attribute__((ext_vector_type(2)));
__device__ __forceinline__ unsigned cvtpk(float lo, float hi) { f32x2_t v = {lo, hi}; bf16x2_t b = __builtin_convertvector(v, bf16x2_t); return __builtin_bit_cast(unsigned, b); }
__device__ __forceinline__ int crow(int r, int hi) { return (r & 3) + 8 * (r >> 2) + 4 * hi; }
constexpr int MLIST_CAP = 126976;
__device__ __forceinline__ int mlist_off(int j) { return 256 * (31 * j - (j * (j - 1)) / 2); }
constexpr int AL_K = 0, AL_V = 32768, AL_ENT = 65536, AL_WSF = 66560, AL_PRE = 70656;
__device__ __forceinline__ void attn_fill_kv(Frame& F, const bf16_t* kb, const bf16_t* vb, int ld) {
    for (int i = F.tid; i < 2048; i += 512) { const int key = i >> 3, c = i & 7;
        const u32x4 kk = *(const u32x4*)(kb + (size_t)key * ld + c * 8), vv = *(const u32x4*)(vb + (size_t)key * ld + c * 8);
        *(LAS u32x4*)(F.lds + AL_K + key * 128 + ((c ^ ((key >> 1) & 7)) << 4)) = kk;
        *(LAS u32x4*)(F.lds + AL_V + key * 128 + ((c ^ (((key >> 1) & 1) << 2)) << 4)) = vv; }
}
template <int MODE>
__device__ __forceinline__ void attn_unit(Frame& F, const bf16_t* qbase  , int brow  , int h, int t0, int kpos0, float slope2, int nvalid, int nsel,
                                          bf16_t* outp  ) {
    const int lane = F.lane, r32 = lane & 31, hi = lane >> 5, w = F.wave;
    LAS const unsigned* ent = (LAS const unsigned*)(F.lds + AL_ENT);
    LAS float* wsf = (LAS float*)(F.lds + AL_WSF) + w * 128;
    float* PML = (float*)(F.ws + WS_PML); bf16_t* PO = (bf16_t*)(F.ws + WS_PO);
    int tq, myslot = 0;
    if (MODE == 0) { int ei = 32 * w + r32; if (ei >= nvalid) ei = 0; const unsigned e = ent[ei]; tq = (int)(e & 0x1fffu); myslot = (int)(e >> 13); }
    else tq = t0 + 32 * w + r32;
    bf16x8 qf[4];
    { const bf16_t* qp = qbase + (size_t)tq * PROJ_LD + 8 * hi;
#pragma unroll
      for (int d0 = 0; d0 < 4; ++d0) qf[d0] = *(const bf16x8*)(qp + 16 * d0); }
    const float lanec = (MODE == 2) ? 0.f : slope2 * (float)(kpos0 + 4 * hi - tq);
    float mref = 0.f, lsum = 0.f; bool first = true;
    f32x16 o0, o1;
#pragma unroll
    for (int r = 0; r < 16; ++r) { o0[r] = 0.f; o1[r] = 0.f; }
    if (MODE == 1 && nsel > 0) {
        first = false;
        const float* pm = PML + ((size_t)(brow + tq) * 4 + h) * 6;
        float ms[3], ls[3]; float M0 = -INFINITY;
#pragma unroll
        for (int s = 0; s < 3; ++s) { if (s < nsel) { ms[s] = pm[2 * s]; ls[s] = pm[2 * s + 1]; } else { ms[s] = -INFINITY; ls[s] = 0.f; } M0 = fmaxf(M0, ms[s]); }
        float l0 = 0.f;
#pragma unroll
        for (int s = 0; s < 3; ++s) { const float ws_ = ls[s] * exp2f(ms[s] - M0); l0 += ws_; if (hi == 0) wsf[32 * s + r32] = ws_; }
        mref = M0; lsum = hi == 0 ? l0 : 0.f;
#pragma unroll
        for (int r = 0; r < 16; ++r) { const int qr = 32 * w + crow(r, hi); const bf16_t* pp = PO + ((size_t)(brow + t0 + qr) * 4 + h) * 192 + r32;
#pragma unroll
            for (int s = 0; s < 3; ++s) if (s < nsel) { const float ws_ = wsf[32 * s + crow(r, hi)]; o0[r] += ws_ * bf2f(pp[64 * s]); o1[r] += ws_ * bf2f(pp[64 * s + 32]); } }
    }
    const int kswz = (r32 >> 1) & 7;
    const unsigned kaddr0 = AL_K + r32 * 128 + ((hi ^ kswz) << 4);
    (void)kaddr0;
    const int q4 = (lane & 15) >> 2, p4 = lane & 3, blk = (lane >> 4) & 1, vsw = ((q4 >> 1) & 1) << 2, vx = 2 * blk + (p4 >> 1);
    const unsigned vb = AL_V + (4 * hi + q4) * 128 + 8 * (p4 & 1);
    const unsigned voff0 = vb + ((vsw + vx) << 4), voff1 = vb + (((4 ^ vsw) + vx) << 4);
    const int jmax = (MODE == 1) ? ((32 * w + 31) >> 6) : 3;
    for (int j = 0; j <= jmax; ++j) {
        const float c0 = lanec + slope2 * (float)(64 * j) - mref;
        f32x16 p0, p1;
#pragma unroll
        for (int r = 0; r < 16; ++r) { p0[r] = c0; p1[r] = c0 + 32.f * slope2; }
#pragma unroll
        for (int d0 = 0; d0 < 4; ++d0) {
            const unsigned ka = AL_K + (64 * j + r32) * 128 + (((2 * d0 + hi) ^ kswz) << 4);
            const bf16x8 k0 = *(LAS const bf16x8*)(F.lds + ka), k1 = *(LAS const bf16x8*)(F.lds + ka + 32 * 128);
            p0 = __builtin_amdgcn_mfma_f32_32x32x16_bf16(k0, qf[d0], p0, 0, 0, 0);
            p1 = __builtin_amdgcn_mfma_f32_32x32x16_bf16(k1, qf[d0], p1, 0, 0, 0);
        }
        if (MODE != 2) {
#pragma unroll
            for (int r = 0; r < 16; ++r) { const float a = slope2 * (float)((r & 3) + 8 * (r >> 2)); p0[r] += a; p1[r] += a; }
        }
        if (MODE == 1) { const int qpos = 32 * w + r32;
#pragma unroll
            for (int r = 0; r < 16; ++r) { const int kp = 64 * j + crow(r, hi); if (kp > qpos) p0[r] = -INFINITY; if (kp + 32 > qpos) p1[r] = -INFINITY; } }
        float mx = fmaxf(p0[0], p1[0]);
#pragma unroll
        for (int r = 1; r < 16; ++r) mx = fmaxf(mx, fmaxf(p0[r], p1[r]));
        mx = fmaxf(mx, __shfl_xor(mx, 32));
        if (first) {
            mref = mx;
#pragma unroll
            for (int r = 0; r < 16; ++r) { p0[r] -= mx; p1[r] -= mx; }
            first = false;
        } else if (__any(mx > 0.f)) {
            const float dl = fmaxf(mx, 0.f), f = __builtin_amdgcn_exp2f(-dl); mref += dl; lsum *= f;
#pragma unroll
            for (int r = 0; r < 16; ++r) { p0[r] -= dl; p1[r] -= dl; }
            if (hi == 0) wsf[r32] = f;
#pragma unroll
            for (int r = 0; r < 16; ++r) { const float fr = wsf[crow(r, hi)]; o0[r] *= fr; o1[r] *= fr; }
        }
        float ps = 0.f;
#pragma unroll
        for (int r = 0; r < 16; ++r) { p0[r] = __builtin_amdgcn_exp2f(p0[r]); p1[r] = __builtin_amdgcn_exp2f(p1[r]); ps += p0[r] + p1[r]; }
        lsum += ps;
        u32x4 a00, a01, a10, a11;
        a00.x = cvtpk(p0[0], p0[1]); a00.y = cvtpk(p0[2], p0[3]); a00.z = cvtpk(p0[4], p0[5]); a00.w = cvtpk(p0[6], p0[7]);
        a01.x = cvtpk(p0[8], p0[9]); a01.y = cvtpk(p0[10], p0[11]); a01.z = cvtpk(p0[12], p0[13]); a01.w = cvtpk(p0[14], p0[15]);
        a10.x = cvtpk(p1[0], p1[1]); a10.y = cvtpk(p1[2], p1[3]); a10.z = cvtpk(p1[4], p1[5]); a10.w = cvtpk(p1[6], p1[7]);
        a11.x = cvtpk(p1[8], p1[9]); a11.y = cvtpk(p1[10], p1[11]); a11.z = cvtpk(p1[12], p1[13]); a11.w = cvtpk(p1[14], p1[15]);
#define VFRAG(dst, voff, rowoff) do { const s16x4 lo_ = __builtin_bit_cast(s16x4, __builtin_amdgcn_ds_read_tr16_b64_v4i16((LAS s16x4*)(F.lds + (voff) + (rowoff) * 128))); \
        const s16x4 hi_ = __builtin_bit_cast(s16x4, __builtin_amdgcn_ds_read_tr16_b64_v4i16((LAS s16x4*)(F.lds + (voff) + ((rowoff) + 8) * 128))); \
        dst = (bf16x8){lo_[0], lo_[1], lo_[2], lo_[3], hi_[0], hi_[1], hi_[2], hi_[3]}; } while (0)
#pragma unroll
        for (int ks = 0; ks < 4; ++ks) {
            const int ro = 64 * j + 16 * ks; bf16x8 v0, v1; VFRAG(v0, voff0, ro); VFRAG(v1, voff1, ro);
            const bf16x8 pa = __builtin_bit_cast(bf16x8, ks == 0 ? a00 : ks == 1 ? a01 : ks == 2 ? a10 : a11);
            o0 = __builtin_amdgcn_mfma_f32_32x32x16_bf16(pa, v0, o0, 0, 0, 0);
            o1 = __builtin_amdgcn_mfma_f32_32x32x16_bf16(pa, v1, o1, 0, 0, 0);
        }
#undef VFRAG
    }
    const float ltot = lsum + __shfl_xor(lsum, 32);
    if (hi == 0) wsf[r32] = 1.f / ltot;
    if (MODE == 0) {
        if (hi == 0 && 32 * w + r32 < nvalid) { float* pm = PML + ((size_t)(brow + tq) * 4 + h) * 6 + 2 * myslot; pm[0] = mref; pm[1] = ltot; }
#pragma unroll
        for (int r = 0; r < 16; ++r) { const int qi = 32 * w + crow(r, hi); const float ri = wsf[crow(r, hi)];
            if (qi < nvalid) { const unsigned e = ent[qi]; bf16_t* pp = PO + (((size_t)(brow + (int)(e & 0x1fffu)) * 4 + h) * 3 + (e >> 13)) * 64 + r32;
                pp[0] = (bf16_t)f2bf(o0[r] * ri); pp[32] = (bf16_t)f2bf(o1[r] * ri); } }
    } else {
#pragma unroll
        for (int r = 0; r < 16; ++r) { const float ri = wsf[crow(r, hi)]; bf16_t* pp = outp + (size_t)(brow + t0 + 32 * w + crow(r, hi)) * DM + r32;
            pp[0] = (bf16_t)f2bf(o0[r] * ri); pp[32] = (bf16_t)f2bf(o1[r] * ri); }
    }
}

__device__ __forceinline__ void ph_moba_route(Frame& F, unsigned* MCNT, unsigned* MLIST) {
    const bf16_t* PROJ = (const bf16_t*)(F.ws + WS_PROJ); const float* KMEAN = (const float*)(F.ctl + CW_KMEAN);
    LAS float* km = (LAS float*)F.lds;
    LAS unsigned* lcnt = (LAS unsigned*)(F.lds + 8192); LAS unsigned* lbase = lcnt + 32;
    for (int item = F.bid; item < 256; item += F.G) {
        const int bh = item >> 5, qb = item & 31, b = bh >> 2, h = bh & 3; if (qb == 0) continue;
        const int qi = F.tid >> 1, par = F.tid & 1, t = qb * 256 + qi;
        __syncthreads();
        for (int i = F.tid; i < qb * 64; i += 512) km[i] = KMEAN[bh * 2048 + i];
        if (F.tid < 32) lcnt[F.tid] = 0u;
        float q[64]; load_q64(q, PROJ + (size_t)(b * SEQ + t) * PROJ_LD + C_MBQ + h * 64);
        __syncthreads();
        float b0 = -INFINITY, b1 = -INFINITY, b2 = -INFINITY; int i0 = 0, i1 = 0, i2 = 0;
        for (int j = par; j < qb; j += 2) { float gsc = 0.f;
#pragma unroll
            for (int d = 0; d < 64; d += 4) { const f32x4 kk = *(LAS f32x4*)(km + j * 64 + d); gsc += q[d] * kk.x + q[d + 1] * kk.y + q[d + 2] * kk.z + q[d + 3] * kk.w; }
            if (gsc > b0) { b2 = b1; i2 = i1; b1 = b0; i1 = i0; b0 = gsc; i0 = j; } else if (gsc > b1) { b2 = b1; i2 = i1; b1 = gsc; i1 = j; } else if (gsc > b2) { b2 = gsc; i2 = j; } }
        {
            float c[3] = {__shfl_xor(b0, 1), __shfl_xor(b1, 1), __shfl_xor(b2, 1)}; int ci[3] = {__shfl_xor(i0, 1), __shfl_xor(i1, 1), __shfl_xor(i2, 1)};
#pragma unroll
            for (int s = 0; s < 3; ++s) { const float g_ = c[s]; const int j_ = ci[s];
                if (g_ > b0 || (g_ == b0 && j_ < i0)) { b2 = b1; i2 = i1; b1 = b0; i1 = i0; b0 = g_; i0 = j_; }
                else if (g_ > b1 || (g_ == b1 && j_ < i1)) { b2 = b1; i2 = i1; b1 = g_; i1 = j_; }
                else if (g_ > b2 || (g_ == b2 && j_ < i2)) { b2 = g_; i2 = j_; } }
        }
        const int nsel = qb < 3 ? qb : 3; unsigned lp[3] = {0u, 0u, 0u};
        if (par == 0) {
#pragma unroll
            for (int s = 0; s < 3; ++s) if (s < nsel) lp[s] = atomicAdd((unsigned*)(lcnt + (s == 0 ? i0 : s == 1 ? i1 : i2)), 1u); }
        __syncthreads();
        if (F.tid < 32) { const unsigned n = lcnt[F.tid]; lbase[F.tid] = n ? atomicAdd(&MCNT[bh * 32 + F.tid], n) : 0u; }
        __syncthreads();
        if (par == 0) {
#pragma unroll
            for (int s = 0; s < 3; ++s) if (s < nsel) { const int jb = s == 0 ? i0 : s == 1 ? i1 : i2;
                MLIST[(size_t)bh * MLIST_CAP + mlist_off(jb) + lbase[jb] + lp[s]] = (unsigned)t | ((unsigned)s << 13); } }
    }
}
__device__ __forceinline__ void ph_mem_attn(Frame& F, int bid, int nb) {
    const bf16_t* PROJ = (const bf16_t*)(F.ws + WS_PROJ); const bf16_t* MEMKV = (const bf16_t*)(F.ws + WS_MEMKV); bf16_t* MIX = (bf16_t*)(F.ws + WS_MIX);
    for (int u = bid; u < 256; u += nb) {
        const int bh = u >> 5, b = bh >> 2, h = bh & 3, qb = u & 31;
        __syncthreads();
        attn_fill_kv(F, MEMKV + (size_t)(b * NMEM) * 512 + h * 64, MEMKV + (size_t)(b * NMEM) * 512 + 256 + h * 64, 512);
        __syncthreads();
        attn_unit<2>(F, PROJ + (size_t)(b * SEQ) * PROJ_LD + C_MEMQ + h * 64, b * SEQ, h, qb * 256, 0, 0.f, 256, 0, MIX + 768 + h * 64);
    }
}
__device__ __forceinline__ void ph_moba_gather(Frame& F, int bid, int nb) {
    const bf16_t* PROJ = (const bf16_t*)(F.ws + WS_PROJ); const unsigned* MLIST = (const unsigned*)(F.ws + WS_MLIST);
    LAS int* pre = (LAS int*)(F.lds + AL_PRE); LAS unsigned* ent = (LAS unsigned*)(F.lds + AL_ENT);
    __syncthreads();
    if (F.tid < 256) pre[F.tid + 1] = ((int)xb_ld(F.ctl + CW_MCNT + F.tid) + 255) >> 8;
    __syncthreads();
    if (F.tid == 0) { pre[0] = 0; for (int k = 0; k < 256; ++k) pre[k + 1] += pre[k]; }
    __syncthreads();
    const int total = pre[256];
    for (int u = bid; u < total; u += nb) {
        int lo = 0, hi_ = 256; while (hi_ - lo > 1) { const int mid = (lo + hi_) >> 1; if (pre[mid] <= u) lo = mid; else hi_ = mid; }
        const int k = lo, sl = u - pre[k], bh = k >> 5, j = k & 31, b = bh >> 2, h = bh & 3;
        const int cnt = (int)xb_ld(F.ctl + CW_MCNT + k); const int nvalid = (cnt - 256 * sl) < 256 ? (cnt - 256 * sl) : 256;
        __syncthreads();
        if (F.tid < 256) ent[F.tid] = F.tid < nvalid ? MLIST[(size_t)bh * MLIST_CAP + mlist_off(j) + 256 * sl + F.tid] : 0u;
        attn_fill_kv(F, PROJ + (size_t)(b * SEQ + 256 * j) * PROJ_LD + C_MBK + h * 64, PROJ + (size_t)(b * SEQ + 256 * j) * PROJ_LD + C_MBV + h * 64, PROJ_LD);
        __syncthreads();
        attn_unit<0>(F, PROJ + (size_t)(b * SEQ) * PROJ_LD + C_MBQ + h * 64, b * SEQ, h, 0, 256 * j, exp2f(-2.f * (float)(h + 1)) * LOG2E, nvalid, 0, nullptr);
    }
}
__device__ __forceinline__ void ph_moba_own(Frame& F, int bid, int nb) {
    const bf16_t* PROJ = (const bf16_t*)(F.ws + WS_PROJ); bf16_t* MIX = (bf16_t*)(F.ws + WS_MIX);
    for (int u = bid; u < 256; u += nb) {
        const int bh = u >> 5, b = bh >> 2, h = bh & 3, j = u & 31;
        __syncthreads();
        attn_fill_kv(F, PROJ + (size_t)(b * SEQ + 256 * j) * PROJ_LD + C_MBK + h * 64, PROJ + (size_t)(b * SEQ + 256 * j) * PROJ_LD + C_MBV + h * 64, PROJ_LD);
        __syncthreads();
        attn_unit<1>(F, PROJ + (size_t)(b * SEQ) * PROJ_LD + C_MBQ + h * 64, b * SEQ, h, 256 * j, 256 * j, exp2f(-2.f * (float)(h + 1)) * LOG2E, 256, j < 3 ? j : 3, MIX + 512 + h * 64);
    }
}


constexpr int GL_LR = 0, GL_TOT = 4096, GL_QD = 8192, GL_KI = 16384, GL_AM = 24576, GL_V = 32768, GL_SP = 49152, GL_SSQ = 65536;
typedef float f32x4a __attribute__((ext_vector_type(4)));
__device__ __forceinline__ unsigned offK(int row, int ch) { return (unsigned)(row * 128 + ((ch ^ ((row >> 1) & 7)) << 4)); }
__device__ __forceinline__ unsigned offB(int row, int ch) { return (unsigned)(256 * row + 16 * (ch ^ (((row & 3) << 2) | ((row >> 2) & 3)))); }
__device__ __forceinline__ bf16x8 rowfrag(LAS unsigned char* img, int lane, int rb, int s) { return *(LAS const bf16x8*)(img + offK(16 * rb + (lane & 15), 4 * s + (lane >> 4))); }
__device__ __forceinline__ bf16x8 trfrag(LAS unsigned char* img, int lane, int c, int ks) {
    const int g = lane >> 4, q = (lane & 15) >> 2, p = lane & 3;
    const unsigned a0 = offB(32 * ks + 8 * g + q, 2 * c + (p >> 1)) + 8 * (p & 1), a1 = offB(32 * ks + 8 * g + 4 + q, 2 * c + (p >> 1)) + 8 * (p & 1);
    const s16x4 lo = __builtin_bit_cast(s16x4, __builtin_amdgcn_ds_read_tr16_b64_v4i16((LAS s16x4*)(img + a0)));
    const s16x4 hi = __builtin_bit_cast(s16x4, __builtin_amdgcn_ds_read_tr16_b64_v4i16((LAS s16x4*)(img + a1)));
    return (bf16x8){lo[0], lo[1], lo[2], lo[3], hi[0], hi[1], hi[2], hi[3]};
}
constexpr int GL_CUM = 67584, GL_CL = 67584 + 64 * 68 * 4, GL_R = 86016, GL_O = 102400;
struct GlaRegs { float lr0, lr1, wg[16], bias; u32x4 q, k, v0, v1, s0, s1, r0, r1; unsigned short k8[8]; };
template <bool PHASE_C>
__device__ __forceinline__ void gla_load(Frame& F, int u, GlaRegs& R) {
    const bf16_t* PROJ = (const bf16_t*)(F.ws + WS_PROJ); const float* LR = (const float*)(F.ws + WS_LR); const bf16_t* SP = (const bf16_t*)(F.ws + WS_SP);
    const int b = u >> 9, h = (u >> 7) & 3, n = u & 127, t0 = b * SEQ + 64 * n, seg = F.tid >> 6, d = F.tid & 63;
    R.lr0 = LR[(size_t)t0 * 16 + F.tid]; R.lr1 = LR[(size_t)t0 * 16 + 512 + F.tid];
#pragma unroll
    for (int i = 0; i < 16; ++i) R.wg[i] = F.in[I_WGK][i * 256 + h * 64 + d];
    R.bias = F.in[I_BGK][h * 64 + d];
    const int row0 = F.tid >> 4, ch0 = F.tid & 15;
    R.v0 = *(const u32x4*)(PROJ + (size_t)(t0 + row0) * PROJ_LD + C_GV + h * 128 + ch0 * 8); R.v1 = *(const u32x4*)(PROJ + (size_t)(t0 + row0 + 32) * PROJ_LD + C_GV + h * 128 + ch0 * 8);
    if (PHASE_C) {
        const int row = F.tid >> 3, ch = F.tid & 7;
        R.q = *(const u32x4*)(PROJ + (size_t)(t0 + row) * PROJ_LD + C_GQ + h * 64 + ch * 8); R.k = *(const u32x4*)(PROJ + (size_t)(t0 + row) * PROJ_LD + C_GK + h * 64 + ch * 8);
        const bf16_t* sp = SP + (size_t)((n * 8 + b * 4 + h) * 64) * 128;
        R.s0 = *(const u32x4*)(sp + (size_t)row0 * 128 + ch0 * 8); R.s1 = *(const u32x4*)(sp + (size_t)(row0 + 32) * 128 + ch0 * 8);
        R.r0 = *(const u32x4*)(PROJ + (size_t)(t0 + row0) * PROJ_LD + C_GR + h * 128 + ch0 * 8); R.r1 = *(const u32x4*)(PROJ + (size_t)(t0 + row0 + 32) * PROJ_LD + C_GR + h * 128 + ch0 * 8);
    } else {
#pragma unroll
        for (int i = 0; i < 8; ++i) R.k8[i] = PROJ[(size_t)(t0 + 8 * seg + i) * PROJ_LD + C_GK + h * 64 + d];
    }
}
__device__ __forceinline__ void gla_prep(Frame& F, const GlaRegs& R, float (&cum)[8], float& cum_last) {
    LAS float* lrs = (LAS float*)(F.lds + GL_LR); LAS float* tot = (LAS float*)(F.lds + GL_TOT); LAS float* CUM = (LAS float*)(F.lds + GL_CUM); LAS float* CL = (LAS float*)(F.lds + GL_CL);
    const int seg = F.tid >> 6, d = F.tid & 63;
    __syncthreads();
    lrs[F.tid] = R.lr0; lrs[512 + F.tid] = R.lr1;
    __syncthreads();
    float run = 0.f;
#pragma unroll
    for (int i = 0; i < 8; ++i) { const int c = 8 * seg + i; float z = R.bias;
#pragma unroll
        for (int k = 0; k < 16; k += 4) { const f32x4 l4 = *(LAS f32x4*)(lrs + c * 16 + k); z += l4.x * R.wg[k] + l4.y * R.wg[k + 1] + l4.z * R.wg[k + 2] + l4.w * R.wg[k + 3]; }
        const float ls = fminf(z, 0.f) - __logf(1.f + __expf(-fabsf(z)));
        run += ls * (1.f / 16.f); cum[i] = run; }
    tot[seg * 64 + d] = run;
    __syncthreads();
    float off = 0.f, all = 0.f;
#pragma unroll
    for (int s = 0; s < 8; ++s) { const float v = tot[s * 64 + d]; all += v; off += s < seg ? v : 0.f; }
#pragma unroll
    for (int i = 0; i < 8; ++i) { cum[i] += off; CUM[(8 * seg + i) * 68 + d] = cum[i]; }
    cum_last = all; if (seg == 0) CL[d] = all;
}
__device__ __forceinline__ void gla_put_b(Frame& F, int goff, const u32x4& a, const u32x4& b) {
    const int row0 = F.tid >> 4, ch0 = F.tid & 15; *(LAS u32x4*)(F.lds + goff + offB(row0, ch0)) = a; *(LAS u32x4*)(F.lds + goff + offB(row0 + 32, ch0)) = b;
}
__device__ __forceinline__ void gla_a_unit(Frame& F, int u, const GlaRegs& R) {
    float* DS = (float*)(F.ws + WS_DS); float* DEC = (float*)(F.ws + WS_DEC);
    const int b = u >> 9, h = (u >> 7) & 3, n = u & 127, seg = F.tid >> 6, d = F.tid & 63, lane = F.lane, w = F.wave;
    float cum[8], cl; gla_prep(F, R, cum, cl);
    { float ke[8];
#pragma unroll
      for (int i = 0; i < 8; ++i) ke[i] = bf2f(R.k8[i]) * __expf(cl - cum[i]);
      u32x4 pk; pk.x = cvtpk(ke[0], ke[1]); pk.y = cvtpk(ke[2], ke[3]); pk.z = cvtpk(ke[4], ke[5]); pk.w = cvtpk(ke[6], ke[7]);
      *(LAS u32x4*)(F.lds + GL_QD + offK(d, seg)) = pk; }
    gla_put_b(F, GL_V, R.v0, R.v1);
    if (seg == 0) DEC[(size_t)((n * 8 + b * 4 + h) * 64) + d] = __expf(cl);
    __syncthreads();
    f32x4 acc[4];
#pragma unroll
    for (int mt = 0; mt < 4; ++mt) acc[mt] = (f32x4){0.f, 0.f, 0.f, 0.f};
#pragma unroll
    for (int ks = 0; ks < 2; ++ks) { const bf16x8 bfr = trfrag(F.lds + GL_V, lane, w, ks);
#pragma unroll
        for (int mt = 0; mt < 4; ++mt) acc[mt] = __builtin_amdgcn_mfma_f32_16x16x32_bf16(rowfrag(F.lds + GL_QD, lane, mt, ks), bfr, acc[mt], 0, 0, 0); }
    float* ds = DS + (size_t)((n * 8 + b * 4 + h) * 64) * 128 + 16 * w + (lane & 15);
#pragma unroll
    for (int mt = 0; mt < 4; ++mt)
#pragma unroll
        for (int e = 0; e < 4; ++e) ds[(16 * mt + 4 * (lane >> 4) + e) * 128] = acc[mt][e];
}
__device__ __forceinline__ void ph_gla_scan(Frame& F) {
    const float* DS = (const float*)(F.ws + WS_DS); const float* DEC = (const float*)(F.ws + WS_DEC); bf16_t* SP = (bf16_t*)(F.ws + WS_SP);
    if (F.tid < 256)
        for (int e = F.bid * 256 + F.tid; e < 65536; e += F.G * 256) {
            float S = 0.f; const int bhdk = e >> 7;
#pragma unroll 8
            for (int n = 0; n < 128; ++n) { const float dsv = DS[(size_t)n * 65536 + e], dc = DEC[n * 512 + bhdk]; SP[(size_t)n * 65536 + e] = (bf16_t)f2bf(S); S = S * dc + dsv; }
        }
}
__device__ __forceinline__ void gla_c_unit(Frame& F, int u, const GlaRegs& R) {
    bf16_t* MIX = (bf16_t*)(F.ws + WS_MIX);
    const int b = u >> 9, h = (u >> 7) & 3, n = u & 127, t0 = b * SEQ + 64 * n, lane = F.lane, w = F.wave, g4 = lane >> 4, l15 = lane & 15;
    float cum[8], cl; gla_prep(F, R, cum, cl);
    gla_put_b(F, GL_V, R.v0, R.v1); gla_put_b(F, GL_SP, R.s0, R.s1);
    { const int row0 = F.tid >> 4, ch0 = F.tid & 15; *(LAS u32x4*)(F.lds + GL_R + row0 * 256 + ch0 * 16) = R.r0; *(LAS u32x4*)(F.lds + GL_R + (row0 + 32) * 256 + ch0 * 16) = R.r1; }
    __syncthreads();
    {
        const int row = F.tid >> 3, ch = F.tid & 7; LAS const float* cp = (LAS const float*)(F.lds + GL_CUM) + row * 68 + 8 * ch;
        const f32x4 c0 = *(LAS const f32x4*)cp, c1 = *(LAS const f32x4*)(cp + 4);
        const float cu[8] = {c0.x, c0.y, c0.z, c0.w, c1.x, c1.y, c1.z, c1.w};
        const unsigned qw[4] = {R.q.x, R.q.y, R.q.z, R.q.w}, kw[4] = {R.k.x, R.k.y, R.k.z, R.k.w}; u32x4 qo, ko; unsigned qq[4], kk[4];
#pragma unroll
        for (int p = 0; p < 4; ++p) { const float e0 = __expf(cu[2 * p]), e1 = __expf(cu[2 * p + 1]);
            qq[p] = cvtpk(bf2f(qw[p] & 0xffffu) * e0, bf2f(qw[p] >> 16) * e1); kk[p] = cvtpk(bf2f(kw[p] & 0xffffu) * __builtin_amdgcn_rcpf(e0), bf2f(kw[p] >> 16) * __builtin_amdgcn_rcpf(e1)); }
        qo.x = qq[0]; qo.y = qq[1]; qo.z = qq[2]; qo.w = qq[3]; ko.x = kk[0]; ko.y = kk[1]; ko.z = kk[2]; ko.w = kk[3];
        *(LAS u32x4*)(F.lds + GL_QD + offK(row, ch)) = qo; *(LAS u32x4*)(F.lds + GL_KI + offK(row, ch)) = ko;
    }
    __syncthreads();
    {
        const int it = w & 3;
#pragma unroll
        for (int jj = 0; jj < 2; ++jj) { const int jt = 2 * (w >> 2) + jj; u32x2 pk; pk.x = 0u; pk.y = 0u;
            if (jt <= it) { f32x4 a = {0.f, 0.f, 0.f, 0.f};
#pragma unroll
                for (int ks = 0; ks < 2; ++ks) a = __builtin_amdgcn_mfma_f32_16x16x32_bf16(rowfrag(F.lds + GL_KI, lane, jt, ks), rowfrag(F.lds + GL_QD, lane, it, ks), a, 0, 0, 0);
                const int i = 16 * it + l15, j0 = 16 * jt + 4 * g4;
                pk.x = cvtpk(j0 <= i ? a[0] : 0.f, j0 + 1 <= i ? a[1] : 0.f); pk.y = cvtpk(j0 + 2 <= i ? a[2] : 0.f, j0 + 3 <= i ? a[3] : 0.f); }
            *(LAS u32x2*)(F.lds + GL_AM + offK(16 * it + l15, 2 * jt + (g4 >> 1)) + (g4 & 1) * 8) = pk; }
    }
    __syncthreads();
    f32x4 acc[4];
    {
        const bf16x8 bv0 = trfrag(F.lds + GL_V, lane, w, 0), bv1 = trfrag(F.lds + GL_V, lane, w, 1), bs0 = trfrag(F.lds + GL_SP, lane, w, 0), bs1 = trfrag(F.lds + GL_SP, lane, w, 1);
#pragma unroll
        for (int mt = 0; mt < 4; ++mt) { f32x4 a = {0.f, 0.f, 0.f, 0.f};
            a = __builtin_amdgcn_mfma_f32_16x16x32_bf16(rowfrag(F.lds + GL_AM, lane, mt, 0), bv0, a, 0, 0, 0);
            a = __builtin_amdgcn_mfma_f32_16x16x32_bf16(rowfrag(F.lds + GL_AM, lane, mt, 1), bv1, a, 0, 0, 0);
            a = __builtin_amdgcn_mfma_f32_16x16x32_bf16(rowfrag(F.lds + GL_QD, lane, mt, 0), bs0, a, 0, 0, 0);
            a = __builtin_amdgcn_mfma_f32_16x16x32_bf16(rowfrag(F.lds + GL_QD, lane, mt, 1), bs1, a, 0, 0, 0);
            acc[mt] = a; }
    }
    LAS float* ssq = (LAS float*)(F.lds + GL_SSQ);
#pragma unroll
    for (int mt = 0; mt < 4; ++mt)
#pragma unroll
        for (int e = 0; e < 4; ++e) { float ss = acc[mt][e] * acc[mt][e]; ss += __shfl_xor(ss, 1); ss += __shfl_xor(ss, 2); ss += __shfl_xor(ss, 4); ss += __shfl_xor(ss, 8);
            if (l15 == 0) ssq[w * 64 + 16 * mt + 4 * g4 + e] = ss; }
    __syncthreads();
    const int v = 16 * w + l15; const float gain = F.in[I_GLA_OG][v];
#pragma unroll
    for (int mt = 0; mt < 4; ++mt)
#pragma unroll
        for (int e = 0; e < 4; ++e) { const int row = 16 * mt + 4 * g4 + e; float tot = 0.f;
#pragma unroll
            for (int ww = 0; ww < 8; ++ww) tot += ssq[ww * 64 + row];
            const float rstd = rsqrtf(tot * (1.f / 128.f) + EPS), r = bf2f(*(LAS const bf16_t*)(F.lds + GL_R + row * 256 + v * 2));
            *(LAS bf16_t*)(F.lds + GL_O + row * 256 + v * 2) = (bf16_t)f2bf(acc[mt][e] * rstd * gain * r * __builtin_amdgcn_rcpf(1.f + __expf(-r))); }
    __syncthreads();
    { const int row0 = F.tid >> 4, ch0 = F.tid & 15;
      *(u32x4*)(MIX + (size_t)(t0 + row0) * DM + h * 128 + ch0 * 8) = *(LAS const u32x4*)(F.lds + GL_O + row0 * 256 + ch0 * 16);
      *(u32x4*)(MIX + (size_t)(t0 + row0 + 32) * DM + h * 128 + ch0 * 8) = *(LAS const u32x4*)(F.lds + GL_O + (row0 + 32) * 256 + ch0 * 16); }
}
__device__ __forceinline__ void ph_gla_a(Frame& F) {
    if (F.bid >= 1024) return; GlaRegs R, Rn; gla_load<false>(F, F.bid, R);
    for (int u = F.bid; u < 1024; u += F.G) { const bool more = u + F.G < 1024; if (more) gla_load<false>(F, u + F.G, Rn); gla_a_unit(F, u, R); if (more) R = Rn; }
}
__device__ __forceinline__ void ph_gla_c(Frame& F) {
    if (F.bid >= 1024) return; GlaRegs R, Rn; gla_load<true>(F, F.bid, R);
    for (int u = F.bid; u < 1024; u += F.G) { const bool more = u + F.G < 1024; if (more) gla_load<true>(F, u + F.G, Rn); gla_c_unit(F, u, R); if (more) R = Rn; }
}

__device__ __forceinline__ void ph_router(Frame& F, bool commit) {
    bf16_t* H2 = (bf16_t*)(F.ws + WS_H2); unsigned* ETOK = (unsigned*)(F.ws + WS_ETOK); float* EGATE = (float*)(F.ws + WS_EGATE); unsigned* TLOC = (unsigned*)(F.ws + WS_TLOC);
    unsigned* ECNT = F.ctl + CW_ECNT;
    const int gw = F.bid * 8 + F.wave, NGW = F.G * 8;
    for (int t = gw; t < T_TOK; t += NGW) {
        f32x4 v[4]; float ss = 0.f;
#pragma unroll
        for (int j = 0; j < 4; ++j) { v[j] = ((const f32x4*)(F.out + (size_t)t * DM))[F.lane + 64 * j]; ss += v[j].x * v[j].x + v[j].y * v[j].y + v[j].z * v[j].z + v[j].w * v[j].w; }
        const float rstd = rsqrtf(wave_sum(ss) * (1.f / DM) + EPS);
        float lg[4] = {0.f, 0.f, 0.f, 0.f};
#pragma unroll
        for (int j = 0; j < 4; ++j) { const f32x4 gg = ((const f32x4*)F.in[I_FFN_G])[F.lane + 64 * j]; v[j] = v[j] * rstd * gg;
            u32x2 o; o.x = pk2(v[j].x, v[j].y); o.y = pk2(v[j].z, v[j].w); ((u32x2*)(H2 + (size_t)t * DM))[F.lane + 64 * j] = o;
#pragma unroll
            for (int e = 0; e < 4; ++e) { const f32x4 w = ((const f32x4*)F.in[I_WRG])[4 * (F.lane + 64 * j) + e];
                lg[0] += v[j][e] * w.x; lg[1] += v[j][e] * w.y; lg[2] += v[j][e] * w.z; lg[3] += v[j][e] * w.w; } }
#pragma unroll
        for (int i = 0; i < 4; ++i) lg[i] = wave_sum(lg[i]) + F.in[I_BRG][i];
        int gs = 0; float gm = lg[0];
#pragma unroll
        for (int i = 1; i < 4; ++i) if (lg[i] > gm) { gm = lg[i]; gs = i; }
        float den = 0.f;
#pragma unroll
        for (int i = 0; i < 4; ++i) den += __expf(lg[i] - gm);
        const float pg = 1.f / den;
        float le[8];
#pragma unroll
        for (int i = 0; i < 8; ++i) le[i] = 0.f;
        const float* wre = F.in[I_WRE] + (size_t)gs * DM * 8;
#pragma unroll
        for (int j = 0; j < 4; ++j)
#pragma unroll
            for (int e = 0; e < 4; ++e) { const int d = 4 * (F.lane + 64 * j) + e; const f32x4 w0 = ((const f32x4*)wre)[2 * d], w1 = ((const f32x4*)wre)[2 * d + 1];
                le[0] += v[j][e] * w0.x; le[1] += v[j][e] * w0.y; le[2] += v[j][e] * w0.z; le[3] += v[j][e] * w0.w; le[4] += v[j][e] * w1.x; le[5] += v[j][e] * w1.y; le[6] += v[j][e] * w1.z; le[7] += v[j][e] * w1.w; }
#pragma unroll
        for (int i = 0; i < 8; ++i) le[i] = wave_sum(le[i]) + F.in[I_BRE][gs * 8 + i];
        int i0 = 0; float m0 = le[0];
#pragma unroll
        for (int i = 1; i < 8; ++i) if (le[i] > m0) { m0 = le[i]; i0 = i; }
        int i1 = i0 == 0 ? 1 : 0; float m1 = -INFINITY;
#pragma unroll
        for (int i = 0; i < 8; ++i) if (i != i0 && le[i] > m1) { m1 = le[i]; i1 = i; }
        const float w0 = 1.f / (1.f + __expf(m1 - m0)), w1 = 1.f - w0;
        if (F.lane == 0 && commit) {
            const int e0 = gs * 8 + i0, e1 = gs * 8 + i1;
            const unsigned p0 = atomicAdd(&ECNT[e0], 1u), p1 = atomicAdd(&ECNT[e1], 1u);
            ETOK[e0 * T_TOK + p0] = (unsigned)t; EGATE[e0 * T_TOK + p0] = pg * w0; ETOK[e1 * T_TOK + p1] = (unsigned)t; EGATE[e1 * T_TOK + p1] = pg * w1;
            TLOC[t * 2] = ((unsigned)e0 << 16) | p0; TLOC[t * 2 + 1] = ((unsigned)e1 << 16) | p1;
        }
    }
}


struct EpiOut {
    static constexpr bool PERM = true, AFTER_DRAIN = false;
    const float* x; float* out;
    __device__ __forceinline__ void operator()(const pg8::f32x4 (&acc)[2][2][4][2], const pg8::Unit& u, int wr, int wc, int fr, int fq) const {
#pragma unroll
        for (int ai = 0; ai < 2; ++ai)
#pragma unroll
            for (int m = 0; m < 4; ++m) { const size_t off = (size_t)(u.pm * 256 + 128 * ai + 64 * wr + 16 * m + fr) * DM + u.pn * 256 + 64 * wc + 8 * fq;
#pragma unroll
                for (int bj = 0; bj < 2; ++bj) { const f32x4 x0 = *(const f32x4*)(x + off + 32 * bj), x1 = *(const f32x4*)(x + off + 32 * bj + 4);
                    *(f32x4*)(out + off + 32 * bj) = x0 + acc[ai][bj][m][0]; *(f32x4*)(out + off + 32 * bj + 4) = x1 + acc[ai][bj][m][1]; } }
    }
};
__device__ __forceinline__ void ph_outproj_gemm(Frame& F) {
    pg8::Gemm g{(const bf16_t*)(F.ws + WS_MIX), (const bf16_t*)(F.ws + WS_WOUT_T), T_TOK, DM, DM};
    pg8::StaticOrder S; S.init(T_TOK, DM, F.G, F.bid);
    EpiOut E{F.in[I_X], F.out};
    pg8::gemm_phase<EpiOut, pg8::StaticOrder, true, true>(F.lds, g, S, E);
}

constexpr int ML_PTILE = LDSCTL_OFF + 256, ML_CNT = LDSCTL_OFF + 512, ML_UT = LDSCTL_OFF + 768, ML_TOK = LDSCTL_OFF + 1024;
struct MoeOrder {
    LAS const int* ut; LAS const unsigned* tokl;
    __device__ __forceinline__ bool next(int i, pg8::Unit& u) const { if (i >= 4 || ut[4 * i + 2] == 0) return false; u.pm = ut[4 * i]; u.pn = ut[4 * i + 1]; u.aux = i; return true; }
    __device__ __forceinline__ unsigned arow(const pg8::Unit& u, int r) const { return tokl[u.aux * 256 + r]; }
    __device__ __forceinline__ void a_ready(const pg8::Unit&) const {}
    __device__ __forceinline__ void done(const pg8::Unit&) const {}
};
__device__ __forceinline__ void moe_setup(Frame& F, bool want_tok) {
    LAS int* ptile = (LAS int*)(F.lds + ML_PTILE); LAS int* cnt = (LAS int*)(F.lds + ML_CNT); LAS int* ut = (LAS int*)(F.lds + ML_UT); LAS unsigned* tokl = (LAS unsigned*)(F.lds + ML_TOK);
    const unsigned* ETOK = (const unsigned*)(F.ws + WS_ETOK);
    __syncthreads();
    if (F.tid < 32) cnt[F.tid] = (int)xb_ld(F.ctl + CW_ECNT + F.tid);
    __syncthreads();
    if (F.tid == 0) {
        int a = 0; for (int e = 0; e < 32; ++e) { ptile[e] = a; a += (cnt[e] + 255) >> 8; } ptile[32] = a;
        for (int i = 0; i < 4; ++i) { const int L = i * F.G + F.bid;
            if (L < 4 * a) { const int tl = L >> 2; int e = 0; while (ptile[e + 1] <= tl) ++e; ut[4 * i] = tl; ut[4 * i + 1] = e * 4 + (L & 3); ut[4 * i + 2] = 1; ut[4 * i + 3] = tl - ptile[e]; }
            else { ut[4 * i] = 0; ut[4 * i + 1] = 0; ut[4 * i + 2] = 0; ut[4 * i + 3] = 0; } }
    }
    __syncthreads();
    if (want_tok)
        for (int idx = F.tid; idx < 1024; idx += 512) { const int i = idx >> 8, r = idx & 255;
            if (ut[4 * i + 2]) { const int e = ut[4 * i + 1] >> 2; int p = 256 * ut[4 * i + 3] + r; if (p >= cnt[e]) p = 0; tokl[idx] = ETOK[e * T_TOK + p]; } else tokl[idx] = 0u; }
    __syncthreads();
}
struct EpiSwiGLU {
    static constexpr bool PERM = true, AFTER_DRAIN = false;
    bf16_t* HID;
    __device__ __forceinline__ void operator()(const pg8::f32x4 (&acc)[2][2][4][2], const pg8::Unit& u, int wr, int wc, int fr, int fq) const {
        bf16_t* base = HID + (size_t)(u.pm * 256 + 64 * wr + fr) * 512 + (u.pn & 3) * 128 + 32 * wc + 8 * fq;
#pragma unroll
        for (int ai = 0; ai < 2; ++ai)
#pragma unroll
            for (int m = 0; m < 4; ++m) { float o[8];
#pragma unroll
                for (int j = 0; j < 8; ++j) { const float gt = acc[ai][0][m][j >> 2][j & 3], up = acc[ai][1][m][j >> 2][j & 3]; o[j] = gt * __builtin_amdgcn_rcpf(1.f + __expf(-gt)) * up; }
                u32x4 w; w.x = pg8::cvt_pk_bf16(o[0], o[1]); w.y = pg8::cvt_pk_bf16(o[2], o[3]); w.z = pg8::cvt_pk_bf16(o[4], o[5]); w.w = pg8::cvt_pk_bf16(o[6], o[7]);
                *(u32x4*)(base + (size_t)(128 * ai + 16 * m) * 512) = w; }
    }
};
__device__ __forceinline__ void ph_moe_gateup(Frame& F) {
    moe_setup(F, true);
    pg8::Gemm g{(const bf16_t*)(F.ws + WS_H2), (const bf16_t*)(F.ws + WS_WGU_T), T_TOK, 32 * 1024, DM};
    MoeOrder S{(LAS const int*)(F.lds + ML_UT), (LAS const unsigned*)(F.lds + ML_TOK)};
    EpiSwiGLU E{(bf16_t*)(F.ws + WS_HID)};
    pg8::gemm_phase_gather<EpiSwiGLU, MoeOrder, true, true>(F.lds, g, S, E);
}
struct EpiDown {
    static constexpr bool PERM = true, AFTER_DRAIN = false;
    bf16_t* Y; const float* EGATE; LAS const int* ptile; LAS const int* cnt;
    __device__ __forceinline__ void operator()(const pg8::f32x4 (&acc)[2][2][4][2], const pg8::Unit& u, int wr, int wc, int fr, int fq) const {
        const int e = u.pn >> 2, p0 = 256 * (u.pm - ptile[e]) + 64 * wr + fr, ne = cnt[e];
        float gw[2][4];
#pragma unroll
        for (int ai = 0; ai < 2; ++ai)
#pragma unroll
            for (int m = 0; m < 4; ++m) { const int p = p0 + 128 * ai + 16 * m; gw[ai][m] = p < ne ? EGATE[e * T_TOK + p] : 0.f; }
        bf16_t* base = Y + (size_t)(u.pm * 256 + 64 * wr + fr) * DM + (u.pn & 3) * 256 + 64 * wc + 8 * fq;
#pragma unroll
        for (int ai = 0; ai < 2; ++ai)
#pragma unroll
            for (int m = 0; m < 4; ++m)
#pragma unroll
                for (int bj = 0; bj < 2; ++bj) { const pg8::f32x4 a = acc[ai][bj][m][0] * gw[ai][m], b = acc[ai][bj][m][1] * gw[ai][m];
                    u32x4 w; w.x = pg8::cvt_pk_bf16(a[0], a[1]); w.y = pg8::cvt_pk_bf16(a[2], a[3]); w.z = pg8::cvt_pk_bf16(b[0], b[1]); w.w = pg8::cvt_pk_bf16(b[2], b[3]);
                    *(u32x4*)(base + (size_t)(128 * ai + 16 * m) * DM + 32 * bj) = w; }
    }
};
__device__ __forceinline__ void ph_moe_down(Frame& F) {
    moe_setup(F, false);
    pg8::Gemm g{(const bf16_t*)(F.ws + WS_HID), (const bf16_t*)(F.ws + WS_WD_T), 40960, 32 * 1024, 512};
    MoeOrder S{(LAS const int*)(F.lds + ML_UT), (LAS const unsigned*)(F.lds + ML_TOK)};
    EpiDown E{(bf16_t*)(F.ws + WS_YBUF), (const float*)(F.ws + WS_EGATE), (LAS const int*)(F.lds + ML_PTILE), (LAS const int*)(F.lds + ML_CNT)};
    pg8::gemm_phase<EpiDown, MoeOrder, true, true>(F.lds, g, S, E);
}
__device__ __forceinline__ void ph_combine(Frame& F, float* dst) {
    LAS int* ptile = (LAS int*)(F.lds + ML_PTILE);
    const unsigned* TLOC = (const unsigned*)(F.ws + WS_TLOC); const bf16_t* Y = (const bf16_t*)(F.ws + WS_YBUF);
    const int gw = F.bid * 8 + F.wave, NGW = F.G * 8;
    for (int t = gw; t < T_TOK; t += NGW) {
        const unsigned l0 = TLOC[t * 2], l1 = TLOC[t * 2 + 1];
        const size_t r0 = (size_t)(256 * ptile[l0 >> 16] + (int)(l0 & 0xffffu)), r1 = (size_t)(256 * ptile[l1 >> 16] + (int)(l1 & 0xffffu));
#pragma unroll
        for (int j = 0; j < 4; ++j) { const int c4 = F.lane + 64 * j; f32x4 v = ((const f32x4*)(F.out + (size_t)t * DM))[c4];
            const u32x2 a = ((const u32x2*)(Y + r0 * DM))[c4], b = ((const u32x2*)(Y + r1 * DM))[c4];
            v.x += bf2f(a.x & 0xffffu); v.y += bf2f(a.x >> 16); v.z += bf2f(a.y & 0xffffu); v.w += bf2f(a.y >> 16);
            v.x += bf2f(b.x & 0xffffu); v.y += bf2f(b.x >> 16); v.z += bf2f(b.y & 0xffffu); v.w += bf2f(b.y >> 16);
            ((f32x4*)(dst + (size_t)t * DM))[c4] = v; }
    }
}

__global__ void __launch_bounds__(512, 2) fwd(Args args) {
    extern __shared__ __attribute__((aligned(16))) unsigned char lds_raw[];
    Frame F;
    F.lds = (LAS unsigned char*)lds_raw; F.tid = threadIdx.x; F.lane = F.tid & 63; F.wave = __builtin_amdgcn_readfirstlane(F.tid >> 6);
    F.G = gridDim.x; F.bid = blockIdx.x; F.in = args.in; F.out = args.out; F.ws = args.ws; F.ctl = (unsigned*)(args.ws + WS_CTL);
    for (int u = F.tid; u < (LDS_BYTES - LDSCTL_OFF) / 4; u += 512) ((LAS unsigned*)(F.lds + LDSCTL_OFF))[u] = 0u;
    __syncthreads();
    XcdBarrier bar = xcd_barrier_post(F.ctl + CW_BAR, (volatile LAS unsigned*)(F.lds + LDSCTL_OFF + 32));
    const int lo = args.ph_lo, hi = args.ph_hi;
#define IN(k) (lo <= (k) && (k) < hi)
#define SEAM(k) do { if (IN(k) && IN((k) + 1)) xcd_barrier(bar); } while (0)
#ifndef PROBE_REP
#define PROBE_REP -1
#endif
#define REPB(k, body) do { if (IN(k)) { body; if (PROBE_REP == (k)) { xcd_barrier(bar); body; } } } while (0)
    REPB(0, { ph_norm_in(F); ph_prep_weights(F); });
    SEAM(0);
    if (IN(1)) { ph_proj_gemm(F, true); if (PROBE_REP == 1) { xcd_barrier(bar); ph_proj_gemm(F, false); } }
    SEAM(1);
    if (IN(2)) { ph_moba_route(F, F.ctl + CW_MCNT, (unsigned*)(F.ws + WS_MLIST)); ph_gla_a(F); if (PROBE_REP == 2) { xcd_barrier(bar); ph_gla_a(F); }
        if (PROBE_REP == 12) { xcd_barrier(bar); ph_moba_route(F, F.ctl + 32768, (unsigned*)(F.ws + WS_PO)); } }
    SEAM(2);
    if (IN(3)) { ph_gla_scan(F); ph_moba_gather(F, F.bid, F.G); if (PROBE_REP == 3) { xcd_barrier(bar); ph_gla_scan(F); ph_moba_gather(F, F.bid, F.G); } if (PROBE_REP == 13) { xcd_barrier(bar); ph_gla_scan(F); } }
    SEAM(3);
    if (IN(4)) { ph_moba_own(F, F.bid, F.G); ph_mem_attn(F, F.bid, F.G); ph_gla_c(F);
        if (PROBE_REP == 4) { xcd_barrier(bar); ph_moba_own(F, F.bid, F.G); ph_mem_attn(F, F.bid, F.G); ph_gla_c(F); }
        if (PROBE_REP == 14) { xcd_barrier(bar); ph_gla_c(F); } }
    SEAM(4);
    REPB(5, ph_outproj_gemm(F));
    SEAM(5);
    if (IN(6)) { ph_router(F, true); if (PROBE_REP == 6) { xcd_barrier(bar); ph_router(F, false); } }
    SEAM(6);
    REPB(7, ph_moe_gateup(F));
    SEAM(7);
    REPB(8, ph_moe_down(F));
    SEAM(8);
    if (IN(9)) { moe_setup(F, false); if (PROBE_REP == 9) { ph_combine(F, (float*)(F.ws + WS_H2)); xcd_barrier(bar); } if (PROBE_REP == 20) { xcd_barrier(bar); xcd_barrier(bar); xcd_barrier(bar); xcd_barrier(bar); } ph_combine(F, F.out); }
#undef IN
#undef SEAM
}

extern "C" void kernel_launch(void* const* d_in, const int* in_sizes, int n_in, void* d_out, int out_size, void* d_ws, size_t ws_size, hipStream_t stream) {
    static int grid = 0;
    if (grid == 0) {
        if (n_in != 22 || out_size != T_TOK * DM || ws_size < WS_END) { fprintf(stderr, "kernel_launch: unexpected shapes (n_in %d, out %d, ws %zu)\n", n_in, out_size, ws_size); grid = -1; return; }
        int dev = 0, cus = 0;
        if (hipGetDevice(&dev) != hipSuccess || hipDeviceGetAttribute(&cus, hipDeviceAttributeMultiprocessorCount, dev) != hipSuccess) { grid = -1; return; }
        if (hipFuncSetAttribute((const void*)fwd, hipFuncAttributeMaxDynamicSharedMemorySize, LDS_BYTES) != hipSuccess) { grid = -1; return; }
        int per_cu = 0;
        (void)hipOccupancyMaxActiveBlocksPerMultiprocessor(&per_cu, (const void*)fwd, 512, LDS_BYTES);
        (void)hipGetLastError();
        grid = cus;
    }
    if (grid < 0) return;
    (void)hipMemsetAsync((char*)d_ws + WS_CTL, 0, CTL_ZERO_BYTES, stream);
    Args a{};
    for (int i = 0; i < 22; ++i) a.in[i] = (const float*)d_in[i];
    a.out = (float*)d_out; a.ws = (unsigned char*)d_ws; a.ph_lo = 0; a.ph_hi = 10;
    hipLaunchKernelGGL(fwd, dim3(grid), dim3(512), LDS_BYTES, stream, a);
}
```

```cpp
#include <hip/hip_runtime.h>
#include <cstdio>
#include <cstdint>

#define LAS __attribute__((address_space(3)))
#define GAS __attribute__((address_space(1)))
typedef unsigned short bf16_t;
typedef float f32x4 __attribute__((ext_vector_type(4)));
typedef unsigned u32x4 __attribute__((ext_vector_type(4)));
typedef unsigned u32x2 __attribute__((ext_vector_type(2)));
typedef short bf16x8 __attribute__((ext_vector_type(8)));
typedef short s16x4 __attribute__((ext_vector_type(4)));
typedef float f32x16 __attribute__((ext_vector_type(16)));

constexpr int T_TOK = 16384, SEQ = 8192, DM = 1024, DIN = 2576, NMEM = 256;
constexpr int PROJ_LD = 2560;
constexpr int C_GQ = 0, C_GK = 256, C_GV = 512, C_GR = 1024, C_MBQ = 1536, C_MBK = 1792, C_MBV = 2048, C_MEMQ = 2304;
constexpr float EPS = 1e-6f;
constexpr float LOG2E = 1.4426950408889634f;
constexpr float C2 = 0.125f * LOG2E;

constexpr size_t MiB = 1u << 20;
constexpr size_t WS_CTL = 0, CTL_ZERO_BYTES = 1 * MiB;
constexpr size_t WS_LR = 1 * MiB;
constexpr size_t WS_MEMKV = 2 * MiB;
constexpr size_t WS_ETOK = 3 * MiB;
constexpr size_t WS_EGATE = 5 * MiB;
constexpr size_t WS_TLOC = 7 * MiB;
constexpr size_t WS_MLIST = 8 * MiB;
constexpr size_t WS_PML = 12 * MiB;
constexpr size_t WS_PO = 242 * MiB;
constexpr size_t WS_WOUT_T = 16 * MiB;
constexpr size_t WS_WGU_T = 18 * MiB;
constexpr size_t WS_WD_T = 82 * MiB;
constexpr size_t WS_WIN_T = 227 * MiB;
constexpr size_t WS_PROJ = 114 * MiB;
constexpr size_t WS_XN = 194 * MiB;
constexpr size_t WS_MIX = 194 * MiB;
constexpr size_t WS_X1B = 114 * MiB;
constexpr size_t WS_ERSTD = 9 * MiB;
constexpr size_t WS_HID = 146 * MiB;
constexpr size_t WS_YBUF = 186 * MiB;
constexpr size_t WS_WLR_T = 15 * MiB;
constexpr size_t WS_DEC = 14 * MiB;
constexpr size_t WS_DS = 194 * MiB;
constexpr size_t WS_SP = 226 * MiB;
constexpr size_t WS_END = 266 * MiB;
constexpr int CW_BAR = 4096;
constexpr int CW_ECNT = 8192;
constexpr int CW_MCNT = 12288;
constexpr int CW_KMEAN = 16384;

constexpr int LDS_BYTES = 147456;
constexpr int LDSCTL_OFF = 131072;

__device__ __forceinline__ unsigned f2bf(float f) { unsigned u = __builtin_bit_cast(unsigned, f); return (u + 0x7fffu + ((u >> 16) & 1u)) >> 16; }
__device__ __forceinline__ float bf2f(unsigned h) { return __builtin_bit_cast(float, h << 16); }
__device__ __forceinline__ unsigned pk2(float lo, float hi) { return f2bf(lo) | (f2bf(hi) << 16); }
__device__ __forceinline__ float wave_sum(float v) {
#pragma unroll
    for (int o = 1; o < 64; o <<= 1) v += __shfl_xor(v, o);
    return v;
}
__device__ __forceinline__ float silu_f(float x) { return x / (1.f + __expf(-x)); }

#define XB_TMO      128
#define XB_XCNT(j)  (256  + 64 * (j))
#define XB_XSUB(j)  (1280 + 64 * (j))
#define XB_XGEN(j)  (2304 + 64 * (j))
#define XB_TOP      3328
#define XB_TOPGEN   3392
#define XCD_BAR_WORDS 3456
#define XB_SPIN_CAP (1u << 18)
__device__ __forceinline__ unsigned xb_ld(unsigned* p)              { return __hip_atomic_load(p, __ATOMIC_RELAXED, __HIP_MEMORY_SCOPE_AGENT); }
__device__ __forceinline__ unsigned xb_add(unsigned* p, unsigned v) { return __hip_atomic_fetch_add(p, v, __ATOMIC_RELAXED, __HIP_MEMORY_SCOPE_AGENT); }
__device__ __forceinline__ unsigned xb_xcc_id() { return (unsigned)__builtin_amdgcn_s_getreg((3 << 11) | 20) & 0xFu; }
#define XB_SPIN(cond, bar) do { unsigned _sp = 0; while (cond) { __builtin_amdgcn_s_sleep(1); \
    if ((++_sp & 255u) == 0u) { if (xb_ld(&(bar)[XB_TMO])) break; if (_sp > XB_SPIN_CAP) { atomicAdd(&(bar)[XB_TMO], 1u); break; } } } } while (0)
struct XcdBarrier { unsigned* bar; unsigned x; volatile LAS unsigned* st; };
__device__ __forceinline__ XcdBarrier xcd_barrier_post(unsigned* bar, volatile LAS unsigned* st) {
    XcdBarrier b; b.bar = bar; b.x = xb_xcc_id(); b.st = st;
    if (threadIdx.x == 0) (void)xb_add(&bar[XB_XCNT(b.x)], 1u);
    return b;
}
__device__ __forceinline__ void xcd_barrier_complete(unsigned* bar, unsigned x, unsigned& nloc, unsigned& nx) {
    const unsigned G = gridDim.x * gridDim.y * gridDim.z;
    unsigned sum, cnt, mine, sp = 0u;
    for (;;) {
        sum = 0u; cnt = 0u; mine = 0u;
#pragma unroll
        for (unsigned j = 0; j < 16; ++j) { const unsigned c = xb_ld(&bar[XB_XCNT(j)]); sum += c; cnt += (c > 0u) ? 1u : 0u; mine = (j == x) ? c : mine; }
        if (sum == G) break;
        __builtin_amdgcn_s_sleep(1);
        if ((++sp & 255u) == 0u) { if (xb_ld(&bar[XB_TMO])) break; if (sp > XB_SPIN_CAP) { atomicAdd(&bar[XB_TMO], 1u); break; } }
    }
    nloc = mine > 0u ? mine : 1u; nx = cnt > 0u ? cnt : 1u;
}
__device__ __forceinline__ void xcd_barrier(const XcdBarrier& b) {
    asm volatile("s_waitcnt vmcnt(0)" ::: "memory");
    __syncthreads();
    if (threadIdx.x == 0) {
        unsigned* bar = b.bar;
        __builtin_amdgcn_s_waitcnt(0);
        unsigned nloc = b.st[0], nx = b.st[1];
        if (nloc == 0u) { xcd_barrier_complete(bar, b.x, nloc, nx); b.st[0] = nloc; b.st[1] = nx; }
        const unsigned old = xb_add(&bar[XB_XSUB(b.x)], 1u);
        const unsigned gen = old / nloc;
        if (old + 1u == (gen + 1u) * nloc) {
            __builtin_amdgcn_fence(__ATOMIC_RELEASE, "agent");
            asm volatile("s_waitcnt vmcnt(0)" ::: "memory");
            const unsigned og = xb_add(&bar[XB_TOP], 1u);
            const unsigned tg = og / nx;
            if (og + 1u == (tg + 1u) * nx) xb_add(&bar[XB_TOPGEN], 1u);
            else XB_SPIN(xb_ld(&bar[XB_TOPGEN]) == tg, bar);
            __builtin_amdgcn_fence(__ATOMIC_ACQUIRE, "agent");
            xb_add(&bar[XB_XGEN(b.x)], 1u);
            asm volatile("s_waitcnt vmcnt(0)" ::: "memory");
        } else {
            XB_SPIN(xb_ld(&bar[XB_XGEN(b.x)]) == gen, bar);
            __builtin_amdgcn_fence(__ATOMIC_ACQUIRE, "agent");
            asm volatile("s_waitcnt vmcnt(0)" ::: "memory");
        }
    }
    __syncthreads();
}

namespace pg8 {
#define PG8_LAS __attribute__((address_space(3)))
typedef unsigned short bf16_t;
typedef short bf16x8 __attribute__((ext_vector_type(8)));
typedef float f32x4 __attribute__((ext_vector_type(4)));
typedef unsigned u32x4 __attribute__((ext_vector_type(4)));
constexpr int BM = 256, BK = 64, HALF = 128, HTB = HALF * BK * 2  , STAGE_BYTES = 8 * HTB, NXCD = 8, WGM = 8;

__host__ __device__ __forceinline__ int lds_byte(int r, int c) { const int st = (r >> 4) * 2 + (c >> 5), rr = r & 15, cc = c & 31, ob = rr * 64 + cc * 2; return st * 1024 + (ob ^ (((ob >> 9) & 1) << 5)); }
__host__ __device__ __forceinline__ void stage_rc(int b, int& R, int& C) { const int st = b / 1024, sb = b % 1024, swz = sb ^ (((sb >> 9) & 1) << 5); R = (st >> 1) * 16 + swz / 64; C = (st & 1) * 32 + (swz % 64) / 2; }
__host__ __device__ __forceinline__ int perm32(int rho) { const int n = rho >> 4, i = rho & 15; return 8 * (i >> 2) + 4 * n + (i & 3); }

struct Unit { int pm, pn, aux; };
struct Gemm { const bf16_t* A; const bf16_t* Bt; int M, N, K; };

struct StaticOrder {
    int nM, nN, nwg, G, c;
    __host__ __device__ void init(int M, int N, int G_, int c_) { nM = M / BM; nN = N / BM; nwg = nM * nN; G = G_; c = c_; }
    __host__ __device__ bool next(int i, Unit& u) const {
        const long L = (long)i * G + c; if (L >= nwg) return false;
        int wgid = (int)L; { const int q = nwg / NXCD, r = nwg % NXCD, xcd = wgid % NXCD, off = wgid / NXCD; wgid = (xcd < r ? xcd * (q + 1) : r * (q + 1) + (xcd - r) * q) + off; }
        const int nig = WGM * nN, gid = wgid / nig, fm = gid * WGM, gsz = (nM - fm) < WGM ? (nM - fm) : WGM;
        u.pm = fm + ((wgid % nig) % gsz); u.pn = (wgid % nig) / gsz; u.aux = 0; return true;
    }
    __device__ __forceinline__ void a_ready(const Unit&) const {}
    __device__ __forceinline__ void done(const Unit&) const {}
};

__device__ __forceinline__ unsigned cvt_pk_bf16(float lo, float hi) { unsigned r; asm volatile("v_cvt_pk_bf16_f32 %0, %1, %2" : "=v"(r) : "v"(lo), "v"(hi)); return r; }
typedef float f32x2 __attribute__((ext_vector_type(2)));

template <class Epi, class Sched, bool ALIGN_EPI = false, bool SP2 = false>
__device__ __forceinline__ void gemm_phase(PG8_LAS unsigned char* lds, const Gemm g, const Sched& S, const Epi& E) {
    const int tid = threadIdx.x, wid = __builtin_amdgcn_readfirstlane(tid >> 6), lane = tid & 63, wr = wid >> 2, wc = wid & 3, fr = lane & 15, fq = lane >> 4;
    const int K = g.K, nt = K / BK;
    unsigned voffA[2], voffB[2];
#pragma unroll
    for (int i = 0; i < 2; ++i) { int R, C; stage_rc(tid * 16 + i * 8192, R, C); const int Rb = Epi::PERM ? ((R & ~31) + perm32(R & 31)) : R;
        voffA[i] = (unsigned)(R * K + C) * 2u; voffB[i] = (unsigned)(Rb * K + C) * 2u; }
    const size_t kstep = (size_t)(BK * 2);
    const size_t hstep = (size_t)HALF * K * 2;
    const size_t tstep = 2 * hstep;
    const unsigned ldsw = (unsigned)wid * 1024u;
    const int aoff = lds_byte(wr * 64 + fr, fq * 8), boff = lds_byte(wc * 32 + fr, fq * 8);
#define PG8_SA(b, h) (((b) * 2 + (h)) * HTB)
#define PG8_SB(b, h) ((4 + (b) * 2 + (h)) * HTB)
#define PG8_STAGE(bufoff, gbase, voff) do { _Pragma("unroll") for (int _i = 0; _i < 2; ++_i) \
        __builtin_amdgcn_global_load_lds((const unsigned*)((const char*)(gbase) + (voff)[_i]), (PG8_LAS unsigned*)(lds + (bufoff) + ldsw + _i * 8192), 16, 0, 0); } while (0)
#define PG8_LDA(dst, b, h) do { _Pragma("unroll") for (int m = 0; m < 4; ++m) _Pragma("unroll") for (int k = 0; k < 2; ++k) dst[m][k] = *(const PG8_LAS bf16x8*)(lds + PG8_SA(b, h) + aoff + m * 2048 + k * 1024); } while (0)
#define PG8_LDB(dst, b, h) do { _Pragma("unroll") for (int n = 0; n < 2; ++n) _Pragma("unroll") for (int k = 0; k < 2; ++k) dst[n][k] = *(const PG8_LAS bf16x8*)(lds + PG8_SB(b, h) + boff + n * 2048 + k * 1024); } while (0)
#define PG8_MMA(ai, bj, At, Bt) do { __builtin_amdgcn_s_setprio(1); _Pragma("unroll") for (int m = 0; m < 4; ++m) _Pragma("unroll") for (int n = 0; n < 2; ++n) _Pragma("unroll") for (int k = 0; k < 2; ++k) \
        acc[ai][bj][m][n] = __builtin_amdgcn_mfma_f32_16x16x32_bf16(Bt[n][k], At[m][k], acc[ai][bj][m][n], 0, 0, 0); __builtin_amdgcn_s_setprio(0); } while (0)
#define PG8_WAIT_V(n) asm volatile("s_waitcnt vmcnt(" #n ")" ::: "memory")
#define PG8_WAIT_L(n) asm volatile("s_waitcnt lgkmcnt(" #n ")" ::: "memory")
#define PG8_BAR __builtin_amdgcn_s_barrier()
#define PG8_SCHED __builtin_amdgcn_sched_barrier(0)
    Unit cur, nxt; int ui = 0;
    if (!S.next(0, cur)) return;
    f32x4 acc[2][2][4][2];
#pragma unroll
    for (int a = 0; a < 2; ++a)
#pragma unroll
        for (int b = 0; b < 2; ++b)
#pragma unroll
            for (int m = 0; m < 4; ++m)
#pragma unroll
                for (int n = 0; n < 2; ++n) acc[a][b][m][n] = (f32x4){0.f, 0.f, 0.f, 0.f};
    bf16x8 At[4][2], B0[2][2], B1[2][2];
    const char* cA = (const char*)g.A + (size_t)cur.pm * tstep; const char* cB = (const char*)g.Bt + (size_t)cur.pn * tstep;
    S.a_ready(cur);
    if constexpr (SP2) {
        PG8_STAGE(PG8_SB(0, 0), cB, voffB); PG8_STAGE(PG8_SB(0, 1), cB + hstep, voffB); PG8_STAGE(PG8_SA(0, 0), cA, voffA); PG8_STAGE(PG8_SA(0, 1), cA + hstep, voffA);
        if (wr == 1) PG8_BAR;
        PG8_WAIT_V(2); PG8_BAR;
        PG8_STAGE(PG8_SB(1, 0), cB + kstep, voffB); PG8_STAGE(PG8_SA(1, 0), cA + kstep, voffA); PG8_STAGE(PG8_SB(1, 1), cB + hstep + kstep, voffB);
        PG8_WAIT_V(6); PG8_BAR;
    } else {
        PG8_STAGE(PG8_SB(0, 0), cB, voffB); PG8_STAGE(PG8_SA(0, 0), cA, voffA); PG8_STAGE(PG8_SB(0, 1), cB + hstep, voffB); PG8_STAGE(PG8_SA(0, 1), cA + hstep, voffA);
        if (wr == 1) PG8_BAR;
        PG8_WAIT_V(4); PG8_BAR;
        PG8_STAGE(PG8_SB(1, 0), cB + kstep, voffB); PG8_STAGE(PG8_SA(1, 0), cA + kstep, voffA); PG8_STAGE(PG8_SB(1, 1), cB + hstep + kstep, voffB);
        PG8_WAIT_V(6); PG8_BAR;
    }
    for (;;) {
        const bool has_next = S.next(ui + 1, nxt);
        const char* nA = has_next ? (const char*)g.A + (size_t)nxt.pm * tstep : cA; const char* nB = has_next ? (const char*)g.Bt + (size_t)nxt.pn * tstep : cB;
        for (int t = 0; t < nt; t += 2) {
            const bool last = (t == nt - 2);
            const char* a1 = cA + (size_t)(t + 1) * kstep;
            const char* a2 = last ? nA : cA + (size_t)(t + 2) * kstep; const char* b2 = last ? nB : cB + (size_t)(t + 2) * kstep;
            const char* a3 = a2 + kstep; const char* b3 = b2 + kstep;
            if (last && has_next) S.a_ready(nxt);
            if constexpr (SP2) {
            PG8_LDB(B0, 0, 0); PG8_LDB(B1, 0, 1); PG8_SCHED; PG8_LDA(At, 0, 0); PG8_STAGE(PG8_SA(1, 1), a1 + hstep, voffA);
            PG8_WAIT_V(8); PG8_WAIT_L(0); PG8_BAR; PG8_MMA(0, 0, At, B0); PG8_MMA(0, 1, At, B1); PG8_BAR; PG8_SCHED;
            PG8_LDA(At, 0, 1); PG8_STAGE(PG8_SB(0, 0), b2, voffB); PG8_STAGE(PG8_SB(0, 1), b2 + hstep, voffB); PG8_STAGE(PG8_SA(0, 0), a2, voffA);
            PG8_WAIT_V(8); PG8_WAIT_L(0); PG8_BAR; PG8_MMA(1, 0, At, B0); PG8_MMA(1, 1, At, B1); PG8_BAR; PG8_SCHED;
            PG8_LDB(B0, 1, 0); PG8_LDB(B1, 1, 1); PG8_SCHED; PG8_LDA(At, 1, 0); PG8_STAGE(PG8_SA(0, 1), a2 + hstep, voffA);
            PG8_WAIT_V(8); PG8_WAIT_L(0); PG8_BAR; PG8_MMA(0, 0, At, B0); PG8_MMA(0, 1, At, B1); PG8_BAR; PG8_SCHED;
            PG8_LDA(At, 1, 1); PG8_STAGE(PG8_SB(1, 0), b3, voffB); PG8_STAGE(PG8_SB(1, 1), b3 + hstep, voffB); PG8_STAGE(PG8_SA(1, 0), a3, voffA);
            PG8_WAIT_V(8); PG8_WAIT_L(0); PG8_BAR; PG8_MMA(1, 0, At, B0); PG8_MMA(1, 1, At, B1); PG8_BAR; PG8_SCHED;
            } else {
            PG8_LDB(B0, 0, 0); PG8_SCHED; PG8_LDA(At, 0, 0); PG8_STAGE(PG8_SA(1, 1), a1 + hstep, voffA);
            PG8_WAIT_L(8); PG8_BAR; PG8_WAIT_L(0); PG8_MMA(0, 0, At, B0); PG8_BAR; PG8_SCHED;
            PG8_LDB(B1, 0, 1); PG8_STAGE(PG8_SB(0, 0), b2, voffB);
            PG8_BAR; PG8_WAIT_L(0); PG8_MMA(0, 1, At, B1); PG8_BAR;
            PG8_LDA(At, 0, 1); PG8_STAGE(PG8_SA(0, 0), a2, voffA);
            PG8_BAR; PG8_WAIT_L(0); PG8_MMA(1, 0, At, B0); PG8_BAR; PG8_SCHED;
            PG8_STAGE(PG8_SB(0, 1), b2 + hstep, voffB);
            PG8_WAIT_V(6); PG8_BAR; PG8_MMA(1, 1, At, B1); PG8_BAR;
            PG8_LDB(B0, 1, 0); PG8_SCHED; PG8_LDA(At, 1, 0); PG8_STAGE(PG8_SA(0, 1), a2 + hstep, voffA);
            PG8_WAIT_L(8); PG8_BAR; PG8_WAIT_L(0); PG8_MMA(0, 0, At, B0); PG8_BAR; PG8_SCHED;
            PG8_LDB(B1, 1, 1); PG8_STAGE(PG8_SB(1, 0), b3, voffB);
            PG8_BAR; PG8_WAIT_L(0); PG8_MMA(0, 1, At, B1); PG8_BAR;
            PG8_LDA(At, 1, 1); PG8_STAGE(PG8_SA(1, 0), a3, voffA);
            PG8_BAR; PG8_WAIT_L(0); PG8_MMA(1, 0, At, B0); PG8_BAR; PG8_SCHED;
            PG8_STAGE(PG8_SB(1, 1), b3 + hstep, voffB);
            PG8_WAIT_V(6); PG8_BAR; PG8_MMA(1, 1, At, B1); PG8_BAR;
            }
        }
        if constexpr (ALIGN_EPI) { if (wr == 0) PG8_BAR; }
        if constexpr (!Epi::AFTER_DRAIN) { E(acc, cur, wr, wc, fr, fq); S.done(cur); }
        if (!has_next) break;
#pragma unroll
        for (int a = 0; a < 2; ++a)
#pragma unroll
            for (int b = 0; b < 2; ++b)
#pragma unroll
                for (int m = 0; m < 4; ++m)
#pragma unroll
                    for (int n = 0; n < 2; ++n) acc[a][b][m][n] = (f32x4){0.f, 0.f, 0.f, 0.f};
        cur = nxt; cA = nA; cB = nB; ++ui;
        if constexpr (ALIGN_EPI) { if (wr == 1) PG8_BAR; }
    }
    PG8_WAIT_V(0);
    if constexpr (!ALIGN_EPI) { if (wr == 0) PG8_BAR; }
    PG8_BAR;
    if constexpr (Epi::AFTER_DRAIN) { E.fused(acc, cur, wr, wc, fr, fq, lds, wid, lane); S.done(cur); }
#undef PG8_SA
#undef PG8_SB
#undef PG8_STAGE
#undef PG8_LDA
#undef PG8_LDB
#undef PG8_MMA
#undef PG8_WAIT_V
#undef PG8_WAIT_L
#undef PG8_BAR
#undef PG8_SCHED
}
template <class Epi, class Sched, bool ALIGN_EPI = false, bool SP2 = false>
__device__ __forceinline__ void gemm_phase_gather(PG8_LAS unsigned char* lds, const Gemm g, const Sched& S, const Epi& E) {
    const int tid = threadIdx.x, wid = __builtin_amdgcn_readfirstlane(tid >> 6), lane = tid & 63, wr = wid >> 2, wc = wid & 3, fr = lane & 15, fq = lane >> 4;
    const int K = g.K, nt = K / BK;
    unsigned voffA[2], voffB[2]; int RA[2];
#pragma unroll
    for (int i = 0; i < 2; ++i) { int R, C; stage_rc(tid * 16 + i * 8192, R, C); const int Rb = Epi::PERM ? ((R & ~31) + perm32(R & 31)) : R;
        RA[i] = R; voffA[i] = (unsigned)C * 2u; voffB[i] = (unsigned)(Rb * K + C) * 2u; }
    const size_t kstep = (size_t)(BK * 2);
    const size_t hstep = (size_t)HALF * K * 2;
    const size_t tstep = 2 * hstep;
    const unsigned ldsw = (unsigned)wid * 1024u;
    const int aoff = lds_byte(wr * 64 + fr, fq * 8), boff = lds_byte(wc * 32 + fr, fq * 8);
#define PG8_SA(b, h) (((b) * 2 + (h)) * HTB)
#define PG8_SB(b, h) ((4 + (b) * 2 + (h)) * HTB)
#define PG8_STAGE(bufoff, gbase, voff) do { _Pragma("unroll") for (int _i = 0; _i < 2; ++_i) \
        __builtin_amdgcn_global_load_lds((const unsigned*)((const char*)(gbase) + (voff)[_i]), (PG8_LAS unsigned*)(lds + (bufoff) + ldsw + _i * 8192), 16, 0, 0); } while (0)
#define PG8_LDA(dst, b, h) do { _Pragma("unroll") for (int m = 0; m < 4; ++m) _Pragma("unroll") for (int k = 0; k < 2; ++k) dst[m][k] = *(const PG8_LAS bf16x8*)(lds + PG8_SA(b, h) + aoff + m * 2048 + k * 1024); } while (0)
#define PG8_LDB(dst, b, h) do { _Pragma("unroll") for (int n = 0; n < 2; ++n) _Pragma("unroll") for (int k = 0; k < 2; ++k) dst[n][k] = *(const PG8_LAS bf16x8*)(lds + PG8_SB(b, h) + boff + n * 2048 + k * 1024); } while (0)
#define PG8_MMA(ai, bj, At, Bt) do { __builtin_amdgcn_s_setprio(1); _Pragma("unroll") for (int m = 0; m < 4; ++m) _Pragma("unroll") for (int n = 0; n < 2; ++n) _Pragma("unroll") for (int k = 0; k < 2; ++k) \
        acc[ai][bj][m][n] = __builtin_amdgcn_mfma_f32_16x16x32_bf16(Bt[n][k], At[m][k], acc[ai][bj][m][n], 0, 0, 0); __builtin_amdgcn_s_setprio(0); } while (0)
#define PG8_WAIT_V(n) asm volatile("s_waitcnt vmcnt(" #n ")" ::: "memory")
#define PG8_WAIT_L(n) asm volatile("s_waitcnt lgkmcnt(" #n ")" ::: "memory")
#define PG8_BAR __builtin_amdgcn_s_barrier()
#define PG8_SCHED __builtin_amdgcn_sched_barrier(0)
    Unit cur, nxt; int ui = 0;
    if (!S.next(0, cur)) return;
    f32x4 acc[2][2][4][2];
#pragma unroll
    for (int a = 0; a < 2; ++a)
#pragma unroll
        for (int b = 0; b < 2; ++b)
#pragma unroll
            for (int m = 0; m < 4; ++m)
#pragma unroll
                for (int n = 0; n < 2; ++n) acc[a][b][m][n] = (f32x4){0.f, 0.f, 0.f, 0.f};
    bf16x8 At[4][2], B0[2][2], B1[2][2];
    const char* cA = (const char*)g.A; unsigned cvo0[2], cvo1[2], nvo0[2], nvo1[2];
    _Pragma("unroll") for (int i = 0; i < 2; ++i) { cvo0[i] = S.arow(cur, RA[i]) * (unsigned)(K * 2) + voffA[i]; cvo1[i] = S.arow(cur, HALF + RA[i]) * (unsigned)(K * 2) + voffA[i]; }
    const char* cB = (const char*)g.Bt + (size_t)cur.pn * tstep;
    S.a_ready(cur);
    if constexpr (SP2) {
        PG8_STAGE(PG8_SB(0, 0), cB, voffB); PG8_STAGE(PG8_SB(0, 1), cB + hstep, voffB); PG8_STAGE(PG8_SA(0, 0), cA, cvo0); PG8_STAGE(PG8_SA(0, 1), cA, cvo1);
        if (wr == 1) PG8_BAR;
        PG8_WAIT_V(2); PG8_BAR;
        PG8_STAGE(PG8_SB(1, 0), cB + kstep, voffB); PG8_STAGE(PG8_SA(1, 0), cA + kstep, cvo0); PG8_STAGE(PG8_SB(1, 1), cB + hstep + kstep, voffB);
        PG8_WAIT_V(6); PG8_BAR;
    } else {
        PG8_STAGE(PG8_SB(0, 0), cB, voffB); PG8_STAGE(PG8_SA(0, 0), cA, cvo0); PG8_STAGE(PG8_SB(0, 1), cB + hstep, voffB); PG8_STAGE(PG8_SA(0, 1), cA, cvo1);
        if (wr == 1) PG8_BAR;
        PG8_WAIT_V(4); PG8_BAR;
        PG8_STAGE(PG8_SB(1, 0), cB + kstep, voffB); PG8_STAGE(PG8_SA(1, 0), cA + kstep, cvo0); PG8_STAGE(PG8_SB(1, 1), cB + hstep + kstep, voffB);
        PG8_WAIT_V(6); PG8_BAR;
    }
    for (;;) {
        const bool has_next = S.next(ui + 1, nxt);
        _Pragma("unroll") for (int i = 0; i < 2; ++i) { nvo0[i] = has_next ? S.arow(nxt, RA[i]) * (unsigned)(K * 2) + voffA[i] : cvo0[i]; nvo1[i] = has_next ? S.arow(nxt, HALF + RA[i]) * (unsigned)(K * 2) + voffA[i] : cvo1[i]; }
        const char* nB = has_next ? (const char*)g.Bt + (size_t)nxt.pn * tstep : cB;
        for (int t = 0; t < nt; t += 2) {
            const bool last = (t == nt - 2);
            const char* a1 = cA + (size_t)(t + 1) * kstep;
            const char* a2 = last ? cA : cA + (size_t)(t + 2) * kstep; unsigned xo0[2], xo1[2]; _Pragma("unroll") for (int i = 0; i < 2; ++i) { xo0[i] = last ? nvo0[i] : cvo0[i]; xo1[i] = last ? nvo1[i] : cvo1[i]; } const char* b2 = last ? nB : cB + (size_t)(t + 2) * kstep;
            const char* a3 = a2 + kstep; const char* b3 = b2 + kstep;
            if (last && has_next) S.a_ready(nxt);
            if constexpr (SP2) {
            PG8_LDB(B0, 0, 0); PG8_LDB(B1, 0, 1); PG8_SCHED; PG8_LDA(At, 0, 0); PG8_STAGE(PG8_SA(1, 1), a1, cvo1);
            PG8_WAIT_V(8); PG8_WAIT_L(0); PG8_BAR; PG8_MMA(0, 0, At, B0); PG8_MMA(0, 1, At, B1); PG8_BAR; PG8_SCHED;
            PG8_LDA(At, 0, 1); PG8_STAGE(PG8_SB(0, 0), b2, voffB); PG8_STAGE(PG8_SB(0, 1), b2 + hstep, voffB); PG8_STAGE(PG8_SA(0, 0), a2, xo0);
            PG8_WAIT_V(8); PG8_WAIT_L(0); PG8_BAR; PG8_MMA(1, 0, At, B0); PG8_MMA(1, 1, At, B1); PG8_BAR; PG8_SCHED;
            PG8_LDB(B0, 1, 0); PG8_LDB(B1, 1, 1); PG8_SCHED; PG8_LDA(At, 1, 0); PG8_STAGE(PG8_SA(0, 1), a2, xo1);
            PG8_WAIT_V(8); PG8_WAIT_L(0); PG8_BAR; PG8_MMA(0, 0, At, B0); PG8_MMA(0, 1, At, B1); PG8_BAR; PG8_SCHED;
            PG8_LDA(At, 1, 1); PG8_STAGE(PG8_SB(1, 0), b3, voffB); PG8_STAGE(PG8_SB(1, 1), b3 + hstep, voffB); PG8_STAGE(PG8_SA(1, 0), a3, xo0);
            PG8_WAIT_V(8); PG8_WAIT_L(0); PG8_BAR; PG8_MMA(1, 0, At, B0); PG8_MMA(1, 1, At, B1); PG8_BAR; PG8_SCHED;
            } else {
            PG8_LDB(B0, 0, 0); PG8_SCHED; PG8_LDA(At, 0, 0); PG8_STAGE(PG8_SA(1, 1), a1, cvo1);
            PG8_WAIT_L(8); PG8_BAR; PG8_WAIT_L(0); PG8_MMA(0, 0, At, B0); PG8_BAR; PG8_SCHED;
            PG8_LDB(B1, 0, 1); PG8_STAGE(PG8_SB(0, 0), b2, voffB);
            PG8_BAR; PG8_WAIT_L(0); PG8_MMA(0, 1, At, B1); PG8_BAR;
            PG8_LDA(At, 0, 1); PG8_STAGE(PG8_SA(0, 0), a2, xo0);
            PG8_BAR; PG8_WAIT_L(0); PG8_MMA(1, 0, At, B0); PG8_BAR; PG8_SCHED;
            PG8_STAGE(PG8_SB(0, 1), b2 + hstep, voffB);
            PG8_WAIT_V(6); PG8_BAR; PG8_MMA(1, 1, At, B1); PG8_BAR;
            PG8_LDB(B0, 1, 0); PG8_SCHED; PG8_LDA(At, 1, 0); PG8_STAGE(PG8_SA(0, 1), a2, xo1);
            PG8_WAIT_L(8); PG8_BAR; PG8_WAIT_L(0); PG8_MMA(0, 0, At, B0); PG8_BAR; PG8_SCHED;
            PG8_LDB(B1, 1, 1); PG8_STAGE(PG8_SB(1, 0), b3, voffB);
            PG8_BAR; PG8_WAIT_L(0); PG8_MMA(0, 1, At, B1); PG8_BAR;
            PG8_LDA(At, 1, 1); PG8_STAGE(PG8_SA(1, 0), a3, xo0);
            PG8_BAR; PG8_WAIT_L(0); PG8_MMA(1, 0, At, B0); PG8_BAR; PG8_SCHED;
            PG8_STAGE(PG8_SB(1, 1), b3 + hstep, voffB);
            PG8_WAIT_V(6); PG8_BAR; PG8_MMA(1, 1, At, B1); PG8_BAR;
            }
        }
        if constexpr (ALIGN_EPI) { if (wr == 0) PG8_BAR; }
        if constexpr (!Epi::AFTER_DRAIN) { E(acc, cur, wr, wc, fr, fq); S.done(cur); }
        if (!has_next) break;
#pragma unroll
        for (int a = 0; a < 2; ++a)
#pragma unroll
            for (int b = 0; b < 2; ++b)
#pragma unroll
                for (int m = 0; m < 4; ++m)
#pragma unroll
                    for (int n = 0; n < 2; ++n) acc[a][b][m][n] = (f32x4){0.f, 0.f, 0.f, 0.f};
        cur = nxt; cB = nB; ++ui; _Pragma("unroll") for (int i = 0; i < 2; ++i) { cvo0[i] = nvo0[i]; cvo1[i] = nvo1[i]; }
        if constexpr (ALIGN_EPI) { if (wr == 1) PG8_BAR; }
    }
    PG8_WAIT_V(0);
    if constexpr (!ALIGN_EPI) { if (wr == 0) PG8_BAR; }
    PG8_BAR;
    if constexpr (Epi::AFTER_DRAIN) { E.fused(acc, cur, wr, wc, fr, fq, lds, wid, lane); S.done(cur); }
#undef PG8_SA
#undef PG8_SB
#undef PG8_STAGE
#undef PG8_LDA
#undef PG8_LDB
#undef PG8_MMA
#undef PG8_WAIT_V
#undef PG8_WAIT_L
#undef PG8_BAR
#undef PG8_SCHED
}
}

struct Args {
    const float* in[22];
    float* out; unsigned char* ws;
    int ph_lo, ph_hi;
};
enum { I_X = 0, I_MEM, I_ATTN_G, I_MEM_G, I_WIN, I_WGK, I_BGK, I_GLA_OG, I_MBQ_G, I_MBK_G, I_WMEMKV, I_MEMQ_G, I_MEMK_G, I_WOUT, I_FFN_G,
       I_WRG, I_BRG, I_WRE, I_BRE, I_WGATE, I_WUP, I_WDOWN };

struct Frame {
    LAS unsigned char* lds; int tid, lane, wave, G, bid;
    const float* const* in; float* out; unsigned char* ws; unsigned* ctl;
};

__device__ __forceinline__ void ph_norm_in(Frame& F) {
    bf16_t* XN = (bf16_t*)(F.ws + WS_XN); float* LR = (float*)(F.ws + WS_LR);
    const int gw = F.bid * 8 + F.wave, NGW = F.G * 8;
    for (int r = gw; r < T_TOK + 512; r += NGW) {
        const float* src = r < T_TOK ? F.in[I_X] + (size_t)r * DM : F.in[I_MEM] + (size_t)(r - T_TOK) * DM;
        const float* g = r < T_TOK ? F.in[I_ATTN_G] : F.in[I_MEM_G];
        f32x4 v[4]; float ss = 0.f;
#pragma unroll
        for (int j = 0; j < 4; ++j) { v[j] = __builtin_nontemporal_load(((const f32x4*)src) + F.lane + 64 * j); ss += v[j].x * v[j].x + v[j].y * v[j].y + v[j].z * v[j].z + v[j].w * v[j].w; }
        const float rstd = rsqrtf(wave_sum(ss) * (1.f / DM) + EPS);
#pragma unroll
        for (int j = 0; j < 4; ++j) { const f32x4 gg = ((const f32x4*)g)[F.lane + 64 * j]; v[j] = v[j] * rstd * gg;
            u32x2 o; o.x = pk2(v[j].x, v[j].y); o.y = pk2(v[j].z, v[j].w);
            ((u32x2*)(XN + (size_t)r * DM))[F.lane + 64 * j] = o; }
    }
}

__device__ __forceinline__ void tr_item(const float* W, int ldw, int scol0, bf16_t* WT, int K, int drow0, int k0, LAS float* scr, int lane, const float* kgain = nullptr) {
    f32x4 v[8];
#pragma unroll
    for (int i = 0; i < 8; ++i) v[i] = __builtin_nontemporal_load((const f32x4*)(W + (size_t)(k0 + 8 * i + (lane >> 3)) * ldw + scol0 + 4 * (lane & 7)));
    if (kgain) {
#pragma unroll
        for (int i = 0; i < 8; ++i) v[i] = v[i] * kgain[k0 + 8 * i + (lane >> 3)]; }
#pragma unroll
    for (int i = 0; i < 8; ++i) { LAS float* s = scr + (8 * i + (lane >> 3)) * 33 + 4 * (lane & 7); s[0] = v[i].x; s[1] = v[i].y; s[2] = v[i].z; s[3] = v[i].w; }
    asm volatile("s_waitcnt lgkmcnt(0)" ::: "memory");
    const int c = lane & 7;
#pragma unroll
    for (int j = 0; j < 4; ++j) { const int n = (lane >> 3) + 8 * j; const LAS float* s = scr + (8 * c) * 33 + n;
        u32x4 o; o.x = pk2(s[0 * 33], s[1 * 33]); o.y = pk2(s[2 * 33], s[3 * 33]); o.z = pk2(s[4 * 33], s[5 * 33]); o.w = pk2(s[6 * 33], s[7 * 33]);
        *(u32x4*)(WT + (size_t)(drow0 + n) * K + k0 + 8 * c) = o; }
    asm volatile("s_waitcnt lgkmcnt(0)" ::: "memory");
}
__device__ __forceinline__ void ph_prep_weights(Frame& F) {
    LAS float* scr = (LAS float*)(F.lds + F.wave * 16384);
    bf16_t* WIN_T = (bf16_t*)(F.ws + WS_WIN_T); bf16_t* WOUT_T = (bf16_t*)(F.ws + WS_WOUT_T); bf16_t* WGU_T = (bf16_t*)(F.ws + WS_WGU_T); bf16_t* WD_T = (bf16_t*)(F.ws + WS_WD_T);
    const int gw = F.bid * 8 + F.wave, NGW = F.G * 8;
    { bf16_t* WLR_T = (bf16_t*)(F.ws + WS_WLR_T);
      for (int idx = F.bid * 512 + F.tid; idx < 16 * 1024; idx += F.G * 512) { const int i = idx >> 10, k = idx & 1023; WLR_T[idx] = (bf16_t)f2bf(F.in[I_WIN][(size_t)k * DIN + 1536 + i]); } }
    constexpr int N_IN = 12 * 8 * 16, N_OUT = 4 * 8 * 16, N_GU = 32 * 4 * 8 * 16, N_DN = 32 * 4 * 8 * 8;
    for (int it = gw; it < N_IN + N_OUT + N_GU + N_DN; it += NGW) {
        int r = it;
        if (r < N_IN) { const int kb = r & 15, g32 = (r >> 4) & 7, pn = r >> 7, bj = g32 >> 2, wc = g32 & 3; const int L0 = 256 * pn + 64 * wc + 32 * bj;
            if (pn < 10) tr_item(F.in[I_WIN], DIN, L0 < 1536 ? L0 : L0 + 16, WIN_T, 1024, 256 * pn + 32 * g32, 64 * kb, scr, F.lane);
            else tr_item(F.in[I_WMEMKV], 512, L0 - 2560, WIN_T, 1024, 256 * pn + 32 * g32, 64 * kb, scr, F.lane);
            continue; }
        r -= N_IN;
        if (r < N_OUT) { const int kb = r & 15, g32 = (r >> 4) & 7, pn = r >> 7, bj = g32 >> 2, wc = g32 & 3;
            tr_item(F.in[I_WOUT], 1024, 256 * pn + 64 * wc + 32 * bj, WOUT_T, 1024, 256 * pn + 32 * g32, 64 * kb, scr, F.lane); continue; }
        r -= N_OUT;
        if (r < N_GU) { const int kb = r & 15, g32 = (r >> 4) & 7, pn = (r >> 7) & 3, e = r >> 9, bj = g32 >> 2, wc = g32 & 3;
            tr_item((bj ? F.in[I_WUP] : F.in[I_WGATE]) + (size_t)e * 1024 * 512, 512, 128 * pn + 32 * wc, WGU_T, 1024, e * 1024 + 256 * pn + 32 * g32, 64 * kb, scr, F.lane, F.in[I_FFN_G]); continue; }
        r -= N_GU;
        { const int kb = r & 7, g32 = (r >> 3) & 7, pn = (r >> 6) & 3, e = r >> 8, bj = g32 >> 2, wc = g32 & 3;
            tr_item(F.in[I_WDOWN] + (size_t)e * 512 * 1024, 1024, 256 * pn + 64 * wc + 32 * bj, WD_T, 512, e * 1024 + 256 * pn + 32 * g32, 64 * kb, scr, F.lane); }
    }
}

struct ProjOrder {
    pg8::StaticOrder s;
    __device__ __forceinline__ void init(int G, int c) { s.init(T_TOK, PROJ_LD, G, c); }
    __device__ __forceinline__ bool next(int i, pg8::Unit& u) const {
        if (s.next(i, u)) return true;
        const long L = (long)i * s.G + s.c - s.nwg;
        if (L >= 0 && L < 4) { u.pm = 64 + (int)(L >> 1); u.pn = 10 + (int)(L & 1); u.aux = 0; return true; }
        return false;
    }
    __device__ __forceinline__ void a_ready(const pg8::Unit&) const {}
    __device__ __forceinline__ void done(const pg8::Unit&) const {}
};
struct EpiProj {
    static constexpr bool PERM = true, AFTER_DRAIN = false;
    bf16_t* PROJ; bf16_t* MEMKV; float* KMEAN; bool do_kmean; const float* g_mbq; const float* g_mbk; const float* g_memq; const float* g_memk;
    __device__ __forceinline__ void operator()(const pg8::f32x4 (&acc)[2][2][4][2], const pg8::Unit& u, int wr, int wc, int fr, int fq) const {
        const int pn = u.pn;
        const float* gain = pn == 6 ? g_mbq : pn == 7 ? g_mbk : pn == 9 ? g_memq : pn == 10 ? g_memk : nullptr;
        const float post = (pn == 6 || pn == 9) ? C2 : (pn == 0 ? 0.125f : 1.f);
        float gv[2][8];
#pragma unroll
        for (int bj = 0; bj < 2; ++bj)
#pragma unroll
            for (int j = 0; j < 8; ++j) gv[bj][j] = (gain ? gain[32 * bj + 8 * fq + j] : 1.f) * post;
        bf16_t* base; int ld;
        if (pn < 10) { base = PROJ + (size_t)(u.pm * 256) * PROJ_LD + 256 * pn; ld = PROJ_LD; } else { base = MEMKV + (size_t)((u.pm - 64) * 256) * 512 + 256 * (pn - 10); ld = 512; }
        base += 64 * wc + 8 * fq;
        float ks[2][8];
#pragma unroll
        for (int bj = 0; bj < 2; ++bj)
#pragma unroll
            for (int j = 0; j < 8; ++j) ks[bj][j] = 0.f;
#pragma unroll
        for (int ai = 0; ai < 2; ++ai)
#pragma unroll
            for (int m = 0; m < 4; ++m) {
                const int row = 128 * ai + 64 * wr + 16 * m + fr; float rstd = 1.f;
                if (gain) { float ss = 0.f;
#pragma unroll
                    for (int bj = 0; bj < 2; ++bj)
#pragma unroll
                        for (int n = 0; n < 2; ++n) { const pg8::f32x4 x = acc[ai][bj][m][n]; ss += (x[0] * x[0] + x[1] * x[1]) + (x[2] * x[2] + x[3] * x[3]); }
                    ss += __shfl_xor(ss, 16); ss += __shfl_xor(ss, 32); rstd = rsqrtf(ss * (1.f / 64.f) + EPS); }
#pragma unroll
                for (int bj = 0; bj < 2; ++bj) { float o[8];
#pragma unroll
                    for (int j = 0; j < 8; ++j) o[j] = acc[ai][bj][m][j >> 2][j & 3] * rstd * gv[bj][j];
                    if (pn == 7) {
#pragma unroll
                        for (int j = 0; j < 8; ++j) ks[bj][j] += o[j]; }
                    u32x4 w; w.x = pg8::cvt_pk_bf16(o[0], o[1]); w.y = pg8::cvt_pk_bf16(o[2], o[3]); w.z = pg8::cvt_pk_bf16(o[4], o[5]); w.w = pg8::cvt_pk_bf16(o[6], o[7]);
                    *(u32x4*)(base + (size_t)row * ld + 32 * bj) = w; }
            }
        if (pn == 7 && do_kmean) {
            float* km = KMEAN + (((u.pm >> 5) * 4 + wc) * 32 + (u.pm & 31)) * 64 + 8 * fq;
#pragma unroll
            for (int bj = 0; bj < 2; ++bj)
#pragma unroll
                for (int j = 0; j < 8; ++j) { float v = ks[bj][j]; v += __shfl_xor(v, 1); v += __shfl_xor(v, 2); v += __shfl_xor(v, 4); v += __shfl_xor(v, 8);
                    if (fr == 0) atomicAdd(km + 32 * bj + j, v * (1.f / 256.f)); }
        }
    }
};
__device__ __forceinline__ void lr_task(Frame& F, int task) {
    const bf16_t* XN = (const bf16_t*)(F.ws + WS_XN); const bf16_t* WLR_T = (const bf16_t*)(F.ws + WS_WLR_T); float* LR = (float*)(F.ws + WS_LR);
    const int l15 = F.lane & 15, g4 = F.lane >> 4; const bf16_t* ap = XN + (size_t)(task * 16 + l15) * DM + 8 * g4; const bf16_t* bp = WLR_T + (size_t)l15 * DM + 8 * g4;
    f32x4 acc = {0.f, 0.f, 0.f, 0.f};
#pragma unroll 8
    for (int ks = 0; ks < 32; ++ks) acc = __builtin_amdgcn_mfma_f32_16x16x32_bf16(*(const bf16x8*)(ap + 32 * ks), *(const bf16x8*)(bp + 32 * ks), acc, 0, 0, 0);
#pragma unroll
    for (int e = 0; e < 4; ++e) LR[(size_t)(task * 16 + 4 * g4 + e) * 16 + l15] = acc[e];
}
__device__ __forceinline__ void ph_proj_gemm(Frame& F, bool do_kmean) {
    { const int half = F.G >> 1; if (F.bid >= half) for (int task = (F.bid - half) * 8 + F.wave; task < T_TOK / 16; task += (F.G - half) * 8) lr_task(F, task); }
    pg8::Gemm g{(const bf16_t*)(F.ws + WS_XN), (const bf16_t*)(F.ws + WS_WIN_T), T_TOK + 512, 3072, 1024};
    ProjOrder S; S.init(F.G, F.bid);
    EpiProj E{(bf16_t*)(F.ws + WS_PROJ), (bf16_t*)(F.ws + WS_MEMKV), (float*)(F.ctl + CW_KMEAN), do_kmean, F.in[I_MBQ_G], F.in[I_MBK_G], F.in[I_MEMQ_G], F.in[I_MEMK_G]};
    pg8::gemm_phase<EpiProj, ProjOrder, true, true>(F.lds, g, S, E);
}

__device__ __forceinline__ void attend_naive(const float (&q)[64], float (&o)[64], float& m, float& l, const bf16_t* kp, const bf16_t* vp, int ld, int s0, int s1, int t, float slope2) {
    for (int s = s0; s < s1; ++s) {
        const u32x4* kr = (const u32x4*)(kp + (size_t)s * ld); float sc = 0.f;
#pragma unroll
        for (int c = 0; c < 8; ++c) { const u32x4 w = kr[c];
            sc += q[8 * c + 0] * bf2f(w.x & 0xffffu) + q[8 * c + 1] * bf2f(w.x >> 16) + q[8 * c + 2] * bf2f(w.y & 0xffffu) + q[8 * c + 3] * bf2f(w.y >> 16)
                + q[8 * c + 4] * bf2f(w.z & 0xffffu) + q[8 * c + 5] * bf2f(w.z >> 16) + q[8 * c + 6] * bf2f(w.w & 0xffffu) + q[8 * c + 7] * bf2f(w.w >> 16); }
        sc -= slope2 * (float)(t - s);
        float p;
        if (sc > m) { const float f = exp2f(m - sc); l *= f;
#pragma unroll
            for (int d = 0; d < 64; ++d) o[d] *= f;
            m = sc; p = 1.f; } else p = exp2f(sc - m);
        l += p;
        const u32x4* vr = (const u32x4*)(vp + (size_t)s * ld);
#pragma unroll
        for (int c = 0; c < 8; ++c) { const u32x4 w = vr[c];
            o[8 * c + 0] += p * bf2f(w.x & 0xffffu); o[8 * c + 1] += p * bf2f(w.x >> 16); o[8 * c + 2] += p * bf2f(w.y & 0xffffu); o[8 * c + 3] += p * bf2f(w.y >> 16);
            o[8 * c + 4] += p * bf2f(w.z & 0xffffu); o[8 * c + 5] += p * bf2f(w.z >> 16); o[8 * c + 6] += p * bf2f(w.w & 0xffffu); o[8 * c + 7] += p * bf2f(w.w >> 16); }
    }
}
__device__ __forceinline__ void load_q64(float (&q)[64], const bf16_t* p) {
#pragma unroll
    for (int c = 0; c < 8; ++c) { const u32x4 w = ((const u32x4*)p)[c];
        q[8 * c + 0] = bf2f(w.x & 0xffffu); q[8 * c + 1] = bf2f(w.x >> 16); q[8 * c + 2] = bf2f(w.y & 0xffffu); q[8 * c + 3] = bf2f(w.y >> 16);
        q[8 * c + 4] = bf2f(w.z & 0xffffu); q[8 * c + 5] = bf2f(w.z >> 16); q[8 * c + 6] = bf2f(w.w & 0xffffu); q[8 * c + 7] = bf2f(w.w >> 16); }
}
__device__ __forceinline__ void store_o64(const float (&o)[64], float inv, bf16_t* p) {
#pragma unroll
    for (int c = 0; c < 8; ++c) { u32x4 w; w.x = pk2(o[8 * c] * inv, o[8 * c + 1] * inv); w.y = pk2(o[8 * c + 2] * inv, o[8 * c + 3] * inv); w.z = pk2(o[8 * c + 4] * inv, o[8 * c + 5] * inv); w.w = pk2(o[8 * c + 6] * inv, o[8 * c + 7] * inv);
        ((u32x4*)p)[c] = w; }
}


typedef float f32x2_t __attribute__((ext_vector_type(2)));
typedef __bf16 bf16x2_t __attribute__((ext_vector_type(2)));
__device__ __forceinline__ unsigned cvtpk(float lo, float hi) { f32x2_t v = {lo, hi}; bf16x2_t b = __builtin_convertvector(v, bf16x2_t); return __builtin_bit_cast(unsigned, b); }
__device__ __forceinline__ int crow(int r, int hi) { return (r & 3) + 8 * (r >> 2) + 4 * hi; }
constexpr int MLIST_CAP = 126976;
__device__ __forceinline__ int mlist_off(int j) { return 256 * (31 * j - (j * (j - 1)) / 2); }
constexpr int AL_K = 0, AL_V = 32768, AL_ENT = 65536, AL_WSF = 66560, AL_PRE = 70656;
__device__ __forceinline__ void attn_fill_kv(Frame& F, const bf16_t* kb, const bf16_t* vb, int ld) {
    for (int i = F.tid; i < 2048; i += 512) { const int key = i >> 3, c = i & 7;
        const u32x4 kk = *(const u32x4*)(kb + (size_t)key * ld + c * 8), vv = *(const u32x4*)(vb + (size_t)key * ld + c * 8);
        *(LAS u32x4*)(F.lds + AL_K + key * 128 + ((c ^ ((key >> 1) & 7)) << 4)) = kk;
        *(LAS u32x4*)(F.lds + AL_V + key * 128 + ((c ^ (((key >> 1) & 1) << 2)) << 4)) = vv; }
}
template <int MODE>
__device__ __forceinline__ void attn_unit(Frame& F, const bf16_t* qbase  , int brow  , int h, int t0, int kpos0, float slope2, int nvalid, int nsel,
                                          bf16_t* outp  ) {
    const int lane = F.lane, r32 = lane & 31, hi = lane >> 5, w = F.wave;
    LAS const unsigned* ent = (LAS const unsigned*)(F.lds + AL_ENT);
    LAS float* wsf = (LAS float*)(F.lds + AL_WSF) + w * 128;
    float* PML = (float*)(F.ws + WS_PML); bf16_t* PO = (bf16_t*)(F.ws + WS_PO);
    int tq, myslot = 0;
    if (MODE == 0) { int ei = 32 * w + r32; if (ei >= nvalid) ei = 0; const unsigned e = ent[ei]; tq = (int)(e & 0x1fffu); myslot = (int)(e >> 13); }
    else tq = t0 + 32 * w + r32;
    bf16x8 qf[4];
    { const bf16_t* qp = qbase + (size_t)tq * PROJ_LD + 8 * hi;
#pragma unroll
      for (int d0 = 0; d0 < 4; ++d0) qf[d0] = *(const bf16x8*)(qp + 16 * d0); }
    const float lanec = (MODE == 2) ? 0.f : slope2 * (float)(kpos0 + 4 * hi - tq);
    float mref = 0.f, lsum = 0.f; bool first = true;
    f32x16 o0, o1;
#pragma unroll
    for (int r = 0; r < 16; ++r) { o0[r] = 0.f; o1[r] = 0.f; }
    if (MODE == 1 && nsel > 0) {
        first = false;
        const float* pm = PML + ((size_t)(brow + tq) * 4 + h) * 6;
        float ms[3], ls[3]; float M0 = -INFINITY;
#pragma unroll
        for (int s = 0; s < 3; ++s) { if (s < nsel) { ms[s] = pm[2 * s]; ls[s] = pm[2 * s + 1]; } else { ms[s] = -INFINITY; ls[s] = 0.f; } M0 = fmaxf(M0, ms[s]); }
        float l0 = 0.f;
#pragma unroll
        for (int s = 0; s < 3; ++s) { const float ws_ = ls[s] * exp2f(ms[s] - M0); l0 += ws_; if (hi == 0) wsf[32 * s + r32] = ws_; }
        mref = M0; lsum = hi == 0 ? l0 : 0.f;
#pragma unroll
        for (int r = 0; r < 16; ++r) { const int qr = 32 * w + crow(r, hi); const bf16_t* pp = PO + ((size_t)(brow + t0 + qr) * 4 + h) * 192 + r32;
#pragma unroll
            for (int s = 0; s < 3; ++s) if (s < nsel) { const float ws_ = wsf[32 * s + crow(r, hi)]; o0[r] += ws_ * bf2f(pp[64 * s]); o1[r] += ws_ * bf2f(pp[64 * s + 32]); } }
    }
    const int kswz = (r32 >> 1) & 7;
    const unsigned kaddr0 = AL_K + r32 * 128 + ((hi ^ kswz) << 4);
    (void)kaddr0;
    const int q4 = (lane & 15) >> 2, p4 = lane & 3, blk = (lane >> 4) & 1, vsw = ((q4 >> 1) & 1) << 2, vx = 2 * blk + (p4 >> 1);
    const unsigned vb = AL_V + (4 * hi + q4) * 128 + 8 * (p4 & 1);
    const unsigned voff0 = vb + ((vsw + vx) << 4), voff1 = vb + (((4 ^ vsw) + vx) << 4);
    const int jmax = (MODE == 1) ? ((32 * w + 31) >> 6) : 3;
    for (int j = 0; j <= jmax; ++j) {
        const float c0 = lanec + slope2 * (float)(64 * j) - mref;
        f32x16 p0, p1;
#pragma unroll
        for (int r = 0; r < 16; ++r) { p0[r] = c0; p1[r] = c0 + 32.f * slope2; }
#pragma unroll
        for (int d0 = 0; d0 < 4; ++d0) {
            const unsigned ka = AL_K + (64 * j + r32) * 128 + (((2 * d0 + hi) ^ kswz) << 4);
            const bf16x8 k0 = *(LAS const bf16x8*)(F.lds + ka), k1 = *(LAS const bf16x8*)(F.lds + ka + 32 * 128);
            p0 = __builtin_amdgcn_mfma_f32_32x32x16_bf16(k0, qf[d0], p0, 0, 0, 0);
            p1 = __builtin_amdgcn_mfma_f32_32x32x16_bf16(k1, qf[d0], p1, 0, 0, 0);
        }
        if (MODE != 2) {
#pragma unroll
            for (int r = 0; r < 16; ++r) { const float a = slope2 * (float)((r & 3) + 8 * (r >> 2)); p0[r] += a; p1[r] += a; }
        }
        if (MODE == 1) { const int qpos = 32 * w + r32;
#pragma unroll
            for (int r = 0; r < 16; ++r) { const int kp = 64 * j + crow(r, hi); if (kp > qpos) p0[r] = -INFINITY; if (kp + 32 > qpos) p1[r] = -INFINITY; } }
        float mx = fmaxf(p0[0], p1[0]);
#pragma unroll
        for (int r = 1; r < 16; ++r) mx = fmaxf(mx, fmaxf(p0[r], p1[r]));
        mx = fmaxf(mx, __shfl_xor(mx, 32));
        if (first) {
            mref = mx;
#pragma unroll
            for (int r = 0; r < 16; ++r) { p0[r] -= mx; p1[r] -= mx; }
            first = false;
        } else if (__any(mx > 0.f)) {
            const float dl = fmaxf(mx, 0.f), f = __builtin_amdgcn_exp2f(-dl); mref += dl; lsum *= f;
#pragma unroll
            for (int r = 0; r < 16; ++r) { p0[r] -= dl; p1[r] -= dl; }
            if (hi == 0) wsf[r32] = f;
#pragma unroll
            for (int r = 0; r < 16; ++r) { const float fr = wsf[crow(r, hi)]; o0[r] *= fr; o1[r] *= fr; }
        }
        float ps = 0.f;
#pragma unroll
        for (int r = 0; r < 16; ++r) { p0[r] = __builtin_amdgcn_exp2f(p0[r]); p1[r] = __builtin_amdgcn_exp2f(p1[r]); ps += p0[r] + p1[r]; }
        lsum += ps;
        u32x4 a00, a01, a10, a11;
        a00.x = cvtpk(p0[0], p0[1]); a00.y = cvtpk(p0[2], p0[3]); a00.z = cvtpk(p0[4], p0[5]); a00.w = cvtpk(p0[6], p0[7]);
        a01.x = cvtpk(p0[8], p0[9]); a01.y = cvtpk(p0[10], p0[11]); a01.z = cvtpk(p0[12], p0[13]); a01.w = cvtpk(p0[14], p0[15]);
        a10.x = cvtpk(p1[0], p1[1]); a10.y = cvtpk(p1[2], p1[3]); a10.z = cvtpk(p1[4], p1[5]); a10.w = cvtpk(p1[6], p1[7]);
        a11.x = cvtpk(p1[8], p1[9]); a11.y = cvtpk(p1[10], p1[11]); a11.z = cvtpk(p1[12], p1[13]); a11.w = cvtpk(p1[14], p1[15]);
#define VFRAG(dst, voff, rowoff) do { const s16x4 lo_ = __builtin_bit_cast(s16x4, __builtin_amdgcn_ds_read_tr16_b64_v4i16((LAS s16x4*)(F.lds + (voff) + (rowoff) * 128))); \
        const s16x4 hi_ = __builtin_bit_cast(s16x4, __builtin_amdgcn_ds_read_tr16_b64_v4i16((LAS s16x4*)(F.lds + (voff) + ((rowoff) + 8) * 128))); \
        dst = (bf16x8){lo_[0], lo_[1], lo_[2], lo_[3], hi_[0], hi_[1], hi_[2], hi_[3]}; } while (0)
#pragma unroll
        for (int ks = 0; ks < 4; ++ks) {
            const int ro = 64 * j + 16 * ks; bf16x8 v0, v1; VFRAG(v0, voff0, ro); VFRAG(v1, voff1, ro);
            const bf16x8 pa = __builtin_bit_cast(bf16x8, ks == 0 ? a00 : ks == 1 ? a01 : ks == 2 ? a10 : a11);
            o0 = __builtin_amdgcn_mfma_f32_32x32x16_bf16(pa, v0, o0, 0, 0, 0);
            o1 = __builtin_amdgcn_mfma_f32_32x32x16_bf16(pa, v1, o1, 0, 0, 0);
        }
#undef VFRAG
    }
    const float ltot = lsum + __shfl_xor(lsum, 32);
    if (hi == 0) wsf[r32] = 1.f / ltot;
    if (MODE == 0) {
        if (hi == 0 && 32 * w + r32 < nvalid) { float* pm = PML + ((size_t)(brow + tq) * 4 + h) * 6 + 2 * myslot; pm[0] = mref; pm[1] = ltot; }
#pragma unroll
        for (int r = 0; r < 16; ++r) { const int qi = 32 * w + crow(r, hi); const float ri = wsf[crow(r, hi)];
            if (qi < nvalid) { const unsigned e = ent[qi]; bf16_t* pp = PO + (((size_t)(brow + (int)(e & 0x1fffu)) * 4 + h) * 3 + (e >> 13)) * 64 + r32;
                pp[0] = (bf16_t)f2bf(o0[r] * ri); pp[32] = (bf16_t)f2bf(o1[r] * ri); } }
    } else {
#pragma unroll
        for (int r = 0; r < 16; ++r) { const float ri = wsf[crow(r, hi)]; bf16_t* pp = outp + (size_t)(brow + t0 + 32 * w + crow(r, hi)) * DM + r32;
            pp[0] = (bf16_t)f2bf(o0[r] * ri); pp[32] = (bf16_t)f2bf(o1[r] * ri); }
    }
}

__device__ __forceinline__ void ph_moba_route(Frame& F, unsigned* MCNT, unsigned* MLIST) {
    const bf16_t* PROJ = (const bf16_t*)(F.ws + WS_PROJ); const float* KMEAN = (const float*)(F.ctl + CW_KMEAN);
    LAS float* km = (LAS float*)F.lds;
    LAS unsigned* lcnt = (LAS unsigned*)(F.lds + 8192); LAS unsigned* lbase = lcnt + 32;
    for (int item = F.bid; item < 256; item += F.G) {
        const int bh = item >> 5, qb = item & 31, b = bh >> 2, h = bh & 3; if (qb == 0) continue;
        const int qi = F.tid >> 1, par = F.tid & 1, t = qb * 256 + qi;
        __syncthreads();
        for (int i = F.tid; i < qb * 64; i += 512) km[i] = KMEAN[bh * 2048 + i];
        if (F.tid < 32) lcnt[F.tid] = 0u;
        float q[64]; load_q64(q, PROJ + (size_t)(b * SEQ + t) * PROJ_LD + C_MBQ + h * 64);
        __syncthreads();
        float b0 = -INFINITY, b1 = -INFINITY, b2 = -INFINITY; int i0 = 0, i1 = 0, i2 = 0;
        for (int j = par; j < qb; j += 2) { float gsc = 0.f;
#pragma unroll
            for (int d = 0; d < 64; d += 4) { const f32x4 kk = *(LAS f32x4*)(km + j * 64 + d); gsc += q[d] * kk.x + q[d + 1] * kk.y + q[d + 2] * kk.z + q[d + 3] * kk.w; }
            if (gsc > b0) { b2 = b1; i2 = i1; b1 = b0; i1 = i0; b0 = gsc; i0 = j; } else if (gsc > b1) { b2 = b1; i2 = i1; b1 = gsc; i1 = j; } else if (gsc > b2) { b2 = gsc; i2 = j; } }
        {
            float c[3] = {__shfl_xor(b0, 1), __shfl_xor(b1, 1), __shfl_xor(b2, 1)}; int ci[3] = {__shfl_xor(i0, 1), __shfl_xor(i1, 1), __shfl_xor(i2, 1)};
#pragma unroll
            for (int s = 0; s < 3; ++s) { const float g_ = c[s]; const int j_ = ci[s];
                if (g_ > b0 || (g_ == b0 && j_ < i0)) { b2 = b1; i2 = i1; b1 = b0; i1 = i0; b0 = g_; i0 = j_; }
                else if (g_ > b1 || (g_ == b1 && j_ < i1)) { b2 = b1; i2 = i1; b1 = g_; i1 = j_; }
                else if (g_ > b2 || (g_ == b2 && j_ < i2)) { b2 = g_; i2 = j_; } }
        }
        const int nsel = qb < 3 ? qb : 3; unsigned lp[3] = {0u, 0u, 0u};
        if (par == 0) {
#pragma unroll
            for (int s = 0; s < 3; ++s) if (s < nsel) lp[s] = atomicAdd((unsigned*)(lcnt + (s == 0 ? i0 : s == 1 ? i1 : i2)), 1u); }
        __syncthreads();
        if (F.tid < 32) { const unsigned n = lcnt[F.tid]; lbase[F.tid] = n ? atomicAdd(&MCNT[bh * 32 + F.tid], n) : 0u; }
        __syncthreads();
        if (par == 0) {
#pragma unroll
            for (int s = 0; s < 3; ++s) if (s < nsel) { const int jb = s == 0 ? i0 : s == 1 ? i1 : i2;
                MLIST[(size_t)bh * MLIST_CAP + mlist_off(jb) + lbase[jb] + lp[s]] = (unsigned)t | ((unsigned)s << 13); } }
    }
}
__device__ __forceinline__ void ph_mem_attn(Frame& F, int bid, int nb) {
    const bf16_t* PROJ = (const bf16_t*)(F.ws + WS_PROJ); const bf16_t* MEMKV = (const bf16_t*)(F.ws + WS_MEMKV); bf16_t* MIX = (bf16_t*)(F.ws + WS_MIX);
    for (int u = bid; u < 256; u += nb) {
        const int bh = u >> 5, b = bh >> 2, h = bh & 3, qb = u & 31;
        __syncthreads();
        attn_fill_kv(F, MEMKV + (size_t)(b * NMEM) * 512 + h * 64, MEMKV + (size_t)(b * NMEM) * 512 + 256 + h * 64, 512);
        __syncthreads();
        attn_unit<2>(F, PROJ + (size_t)(b * SEQ) * PROJ_LD + C_MEMQ + h * 64, b * SEQ, h, qb * 256, 0, 0.f, 256, 0, MIX + 768 + h * 64);
    }
}
__device__ __forceinline__ void ph_moba_gather(Frame& F, int bid, int nb) {
    const bf16_t* PROJ = (const bf16_t*)(F.ws + WS_PROJ); const unsigned* MLIST = (const unsigned*)(F.ws + WS_MLIST);
    LAS int* pre = (LAS int*)(F.lds + AL_PRE); LAS unsigned* ent = (LAS unsigned*)(F.lds + AL_ENT);
    __syncthreads();
    if (F.tid < 256) pre[F.tid + 1] = ((int)xb_ld(F.ctl + CW_MCNT + F.tid) + 255) >> 8;
    __syncthreads();
    if (F.tid == 0) { pre[0] = 0; for (int k = 0; k < 256; ++k) pre[k + 1] += pre[k]; }
    __syncthreads();
    const int total = pre[256];
    for (int u = bid; u < total; u += nb) {
        int lo = 0, hi_ = 256; while (hi_ - lo > 1) { const int mid = (lo + hi_) >> 1; if (pre[mid] <= u) lo = mid; else hi_ = mid; }
        const int k = lo, sl = u - pre[k], bh = k >> 5, j = k & 31, b = bh >> 2, h = bh & 3;
        const int cnt = (int)xb_ld(F.ctl + CW_MCNT + k); const int nvalid = (cnt - 256 * sl) < 256 ? (cnt - 256 * sl) : 256;
        __syncthreads();
        if (F.tid < 256) ent[F.tid] = F.tid < nvalid ? MLIST[(size_t)bh * MLIST_CAP + mlist_off(j) + 256 * sl + F.tid] : 0u;
        attn_fill_kv(F, PROJ + (size_t)(b * SEQ + 256 * j) * PROJ_LD + C_MBK + h * 64, PROJ + (size_t)(b * SEQ + 256 * j) * PROJ_LD + C_MBV + h * 64, PROJ_LD);
        __syncthreads();
        attn_unit<0>(F, PROJ + (size_t)(b * SEQ) * PROJ_LD + C_MBQ + h * 64, b * SEQ, h, 0, 256 * j, exp2f(-2.f * (float)(h + 1)) * LOG2E, nvalid, 0, nullptr);
    }
}
__device__ __forceinline__ void ph_moba_own(Frame& F, int bid, int nb) {
    const bf16_t* PROJ = (const bf16_t*)(F.ws + WS_PROJ); bf16_t* MIX = (bf16_t*)(F.ws + WS_MIX);
    for (int u = bid; u < 256; u += nb) {
        const int bh = u >> 5, b = bh >> 2, h = bh & 3, j = u & 31;
        __syncthreads();
        attn_fill_kv(F, PROJ + (size_t)(b * SEQ + 256 * j) * PROJ_LD + C_MBK + h * 64, PROJ + (size_t)(b * SEQ + 256 * j) * PROJ_LD + C_MBV + h * 64, PROJ_LD);
        __syncthreads();
        attn_unit<1>(F, PROJ + (size_t)(b * SEQ) * PROJ_LD + C_MBQ + h * 64, b * SEQ, h, 256 * j, 256 * j, exp2f(-2.f * (float)(h + 1)) * LOG2E, 256, j < 3 ? j : 3, MIX + 512 + h * 64);
    }
}


constexpr int GL_LR = 0, GL_TOT = 4096, GL_QD = 8192, GL_KI = 16384, GL_AM = 24576, GL_V = 32768, GL_SP = 49152, GL_SSQ = 65536;
typedef float f32x4a __attribute__((ext_vector_type(4)));
__device__ __forceinline__ unsigned offK(int row, int ch) { return (unsigned)(row * 128 + ((ch ^ ((row >> 1) & 7)) << 4)); }
__device__ __forceinline__ unsigned offB(int row, int ch) { return (unsigned)(256 * row + 16 * (ch ^ (((row & 3) << 2) | ((row >> 2) & 3)))); }
__device__ __forceinline__ bf16x8 rowfrag(LAS unsigned char* img, int lane, int rb, int s) { return *(LAS const bf16x8*)(img + offK(16 * rb + (lane & 15), 4 * s + (lane >> 4))); }
__device__ __forceinline__ bf16x8 trfrag(LAS unsigned char* img, int lane, int c, int ks) {
    const int g = lane >> 4, q = (lane & 15) >> 2, p = lane & 3;
    const unsigned a0 = offB(32 * ks + 8 * g + q, 2 * c + (p >> 1)) + 8 * (p & 1), a1 = offB(32 * ks + 8 * g + 4 + q, 2 * c + (p >> 1)) + 8 * (p & 1);
    const s16x4 lo = __builtin_bit_cast(s16x4, __builtin_amdgcn_ds_read_tr16_b64_v4i16((LAS s16x4*)(img + a0)));
    const s16x4 hi = __builtin_bit_cast(s16x4, __builtin_amdgcn_ds_read_tr16_b64_v4i16((LAS s16x4*)(img + a1)));
    return (bf16x8){lo[0], lo[1], lo[2], lo[3], hi[0], hi[1], hi[2], hi[3]};
}
constexpr int GL_CUM = 67584, GL_CL = 67584 + 64 * 68 * 4, GL_R = 86016, GL_O = 102400;
struct GlaRegs { float lr0, lr1, wg[16], bias; u32x4 q, k, v0, v1, s0, s1, r0, r1; unsigned short k8[8]; };
template <bool PHASE_C>
__device__ __forceinline__ void gla_load(Frame& F, int u, GlaRegs& R) {
    const bf16_t* PROJ = (const bf16_t*)(F.ws + WS_PROJ); const float* LR = (const float*)(F.ws + WS_LR); const bf16_t* SP = (const bf16_t*)(F.ws + WS_SP);
    const int b = u >> 9, h = (u >> 7) & 3, n = u & 127, t0 = b * SEQ + 64 * n, seg = F.tid >> 6, d = F.tid & 63;
    R.lr0 = LR[(size_t)t0 * 16 + F.tid]; R.lr1 = LR[(size_t)t0 * 16 + 512 + F.tid];
#pragma unroll
    for (int i = 0; i < 16; ++i) R.wg[i] = F.in[I_WGK][i * 256 + h * 64 + d];
    R.bias = F.in[I_BGK][h * 64 + d];
    const int row0 = F.tid >> 4, ch0 = F.tid & 15;
    R.v0 = *(const u32x4*)(PROJ + (size_t)(t0 + row0) * PROJ_LD + C_GV + h * 128 + ch0 * 8); R.v1 = *(const u32x4*)(PROJ + (size_t)(t0 + row0 + 32) * PROJ_LD + C_GV + h * 128 + ch0 * 8);
    if (PHASE_C) {
        const int row = F.tid >> 3, ch = F.tid & 7;
        R.q = *(const u32x4*)(PROJ + (size_t)(t0 + row) * PROJ_LD + C_GQ + h * 64 + ch * 8); R.k = *(const u32x4*)(PROJ + (size_t)(t0 + row) * PROJ_LD + C_GK + h * 64 + ch * 8);
        const bf16_t* sp = SP + (size_t)((n * 8 + b * 4 + h) * 64) * 128;
        R.s0 = *(const u32x4*)(sp + (size_t)row0 * 128 + ch0 * 8); R.s1 = *(const u32x4*)(sp + (size_t)(row0 + 32) * 128 + ch0 * 8);
        R.r0 = *(const u32x4*)(PROJ + (size_t)(t0 + row0) * PROJ_LD + C_GR + h * 128 + ch0 * 8); R.r1 = *(const u32x4*)(PROJ + (size_t)(t0 + row0 + 32) * PROJ_LD + C_GR + h * 128 + ch0 * 8);
    } else {
#pragma unroll
        for (int i = 0; i < 8; ++i) R.k8[i] = PROJ[(size_t)(t0 + 8 * seg + i) * PROJ_LD + C_GK + h * 64 + d];
    }
}
__device__ __forceinline__ void gla_prep(Frame& F, const GlaRegs& R, float (&cum)[8], float& cum_last) {
    LAS float* lrs = (LAS float*)(F.lds + GL_LR); LAS float* tot = (LAS float*)(F.lds + GL_TOT); LAS float* CUM = (LAS float*)(F.lds + GL_CUM); LAS float* CL = (LAS float*)(F.lds + GL_CL);
    const int seg = F.tid >> 6, d = F.tid & 63;
    __syncthreads();
    lrs[F.tid] = R.lr0; lrs[512 + F.tid] = R.lr1;
    __syncthreads();
    float run = 0.f;
#pragma unroll
    for (int i = 0; i < 8; ++i) { const int c = 8 * seg + i; float z = R.bias;
#pragma unroll
        for (int k = 0; k < 16; k += 4) { const f32x4 l4 = *(LAS f32x4*)(lrs + c * 16 + k); z += l4.x * R.wg[k] + l4.y * R.wg[k + 1] + l4.z * R.wg[k + 2] + l4.w * R.wg[k + 3]; }
        const float ls = fminf(z, 0.f) - __logf(1.f + __expf(-fabsf(z)));
        run += ls * (1.f / 16.f); cum[i] = run; }
    tot[seg * 64 + d] = run;
    __syncthreads();
    float off = 0.f, all = 0.f;
#pragma unroll
    for (int s = 0; s < 8; ++s) { const float v = tot[s * 64 + d]; all += v; off += s < seg ? v : 0.f; }
#pragma unroll
    for (int i = 0; i < 8; ++i) { cum[i] += off; CUM[(8 * seg + i) * 68 + d] = cum[i]; }
    cum_last = all; if (seg == 0) CL[d] = all;
}
__device__ __forceinline__ void gla_put_b(Frame& F, int goff, const u32x4& a, const u32x4& b) {
    const int row0 = F.tid >> 4, ch0 = F.tid & 15; *(LAS u32x4*)(F.lds + goff + offB(row0, ch0)) = a; *(LAS u32x4*)(F.lds + goff + offB(row0 + 32, ch0)) = b;
}
__device__ __forceinline__ void gla_a_unit(Frame& F, int u, const GlaRegs& R) {
    float* DS = (float*)(F.ws + WS_DS); float* DEC = (float*)(F.ws + WS_DEC);
    const int b = u >> 9, h = (u >> 7) & 3, n = u & 127, seg = F.tid >> 6, d = F.tid & 63, lane = F.lane, w = F.wave;
    float cum[8], cl; gla_prep(F, R, cum, cl);
    { float ke[8];
#pragma unroll
      for (int i = 0; i < 8; ++i) ke[i] = bf2f(R.k8[i]) * __expf(cl - cum[i]);
      u32x4 pk; pk.x = cvtpk(ke[0], ke[1]); pk.y = cvtpk(ke[2], ke[3]); pk.z = cvtpk(ke[4], ke[5]); pk.w = cvtpk(ke[6], ke[7]);
      *(LAS u32x4*)(F.lds + GL_QD + offK(d, seg)) = pk; }
    gla_put_b(F, GL_V, R.v0, R.v1);
    if (seg == 0) DEC[(size_t)((n * 8 + b * 4 + h) * 64) + d] = __expf(cl);
    __syncthreads();
    f32x4 acc[4];
#pragma unroll
    for (int mt = 0; mt < 4; ++mt) acc[mt] = (f32x4){0.f, 0.f, 0.f, 0.f};
#pragma unroll
    for (int ks = 0; ks < 2; ++ks) { const bf16x8 bfr = trfrag(F.lds + GL_V, lane, w, ks);
#pragma unroll
        for (int mt = 0; mt < 4; ++mt) acc[mt] = __builtin_amdgcn_mfma_f32_16x16x32_bf16(rowfrag(F.lds + GL_QD, lane, mt, ks), bfr, acc[mt], 0, 0, 0); }
    float* ds = DS + (size_t)((n * 8 + b * 4 + h) * 64) * 128 + 16 * w + (lane & 15);
#pragma unroll
    for (int mt = 0; mt < 4; ++mt)
#pragma unroll
        for (int e = 0; e < 4; ++e) ds[(16 * mt + 4 * (lane >> 4) + e) * 128] = acc[mt][e];
}
__device__ __forceinline__ void ph_gla_scan(Frame& F) {
    const float* DS = (const float*)(F.ws + WS_DS); const float* DEC = (const float*)(F.ws + WS_DEC); bf16_t* SP = (bf16_t*)(F.ws + WS_SP);
    if (F.tid < 256)
        for (int e = F.bid * 256 + F.tid; e < 65536; e += F.G * 256) {
            float S = 0.f; const int bhdk = e >> 7;
#pragma unroll 8
            for (int n = 0; n < 128; ++n) { const float dsv = DS[(size_t)n * 65536 + e], dc = DEC[n * 512 + bhdk]; SP[(size_t)n * 65536 + e] = (bf16_t)f2bf(S); S = S * dc + dsv; }
        }
}
__device__ __forceinline__ void gla_c_unit(Frame& F, int u, const GlaRegs& R) {
    bf16_t* MIX = (bf16_t*)(F.ws + WS_MIX);
    const int b = u >> 9, h = (u >> 7) & 3, n = u & 127, t0 = b * SEQ + 64 * n, lane = F.lane, w = F.wave, g4 = lane >> 4, l15 = lane & 15;
    float cum[8], cl; gla_prep(F, R, cum, cl);
    gla_put_b(F, GL_V, R.v0, R.v1); gla_put_b(F, GL_SP, R.s0, R.s1);
    { const int row0 = F.tid >> 4, ch0 = F.tid & 15; *(LAS u32x4*)(F.lds + GL_R + row0 * 256 + ch0 * 16) = R.r0; *(LAS u32x4*)(F.lds + GL_R + (row0 + 32) * 256 + ch0 * 16) = R.r1; }
    __syncthreads();
    {
        const int row = F.tid >> 3, ch = F.tid & 7; LAS const float* cp = (LAS const float*)(F.lds + GL_CUM) + row * 68 + 8 * ch;
        const f32x4 c0 = *(LAS const f32x4*)cp, c1 = *(LAS const f32x4*)(cp + 4);
        const float cu[8] = {c0.x, c0.y, c0.z, c0.w, c1.x, c1.y, c1.z, c1.w};
        const unsigned qw[4] = {R.q.x, R.q.y, R.q.z, R.q.w}, kw[4] = {R.k.x, R.k.y, R.k.z, R.k.w}; u32x4 qo, ko; unsigned qq[4], kk[4];
#pragma unroll
        for (int p = 0; p < 4; ++p) { const float e0 = __expf(cu[2 * p]), e1 = __expf(cu[2 * p + 1]);
            qq[p] = cvtpk(bf2f(qw[p] & 0xffffu) * e0, bf2f(qw[p] >> 16) * e1); kk[p] = cvtpk(bf2f(kw[p] & 0xffffu) * __builtin_amdgcn_rcpf(e0), bf2f(kw[p] >> 16) * __builtin_amdgcn_rcpf(e1)); }
        qo.x = qq[0]; qo.y = qq[1]; qo.z = qq[2]; qo.w = qq[3]; ko.x = kk[0]; ko.y = kk[1]; ko.z = kk[2]; ko.w = kk[3];
        *(LAS u32x4*)(F.lds + GL_QD + offK(row, ch)) = qo; *(LAS u32x4*)(F.lds + GL_KI + offK(row, ch)) = ko;
    }
    __syncthreads();
    {
        const int it = w & 3;
#pragma unroll
        for (int jj = 0; jj < 2; ++jj) { const int jt = 2 * (w >> 2) + jj; u32x2 pk; pk.x = 0u; pk.y = 0u;
            if (jt <= it) { f32x4 a = {0.f, 0.f, 0.f, 0.f};
#pragma unroll
                for (int ks = 0; ks < 2; ++ks) a = __builtin_amdgcn_mfma_f32_16x16x32_bf16(rowfrag(F.lds + GL_KI, lane, jt, ks), rowfrag(F.lds + GL_QD, lane, it, ks), a, 0, 0, 0);
                const int i = 16 * it + l15, j0 = 16 * jt + 4 * g4;
                pk.x = cvtpk(j0 <= i ? a[0] : 0.f, j0 + 1 <= i ? a[1] : 0.f); pk.y = cvtpk(j0 + 2 <= i ? a[2] : 0.f, j0 + 3 <= i ? a[3] : 0.f); }
            *(LAS u32x2*)(F.lds + GL_AM + offK(16 * it + l15, 2 * jt + (g4 >> 1)) + (g4 & 1) * 8) = pk; }
    }
    __syncthreads();
    f32x4 acc[4];
    {
        const bf16x8 bv0 = trfrag(F.lds + GL_V, lane, w, 0), bv1 = trfrag(F.lds + GL_V, lane, w, 1), bs0 = trfrag(F.lds + GL_SP, lane, w, 0), bs1 = trfrag(F.lds + GL_SP, lane, w, 1);
#pragma unroll
        for (int mt = 0; mt < 4; ++mt) { f32x4 a = {0.f, 0.f, 0.f, 0.f};
            a = __builtin_amdgcn_mfma_f32_16x16x32_bf16(rowfrag(F.lds + GL_AM, lane, mt, 0), bv0, a, 0, 0, 0);
            a = __builtin_amdgcn_mfma_f32_16x16x32_bf16(rowfrag(F.lds + GL_AM, lane, mt, 1), bv1, a, 0, 0, 0);
            a = __builtin_amdgcn_mfma_f32_16x16x32_bf16(rowfrag(F.lds + GL_QD, lane, mt, 0), bs0, a, 0, 0, 0);
            a = __builtin_amdgcn_mfma_f32_16x16x32_bf16(rowfrag(F.lds + GL_QD, lane, mt, 1), bs1, a, 0, 0, 0);
            acc[mt] = a; }
    }
    LAS float* ssq = (LAS float*)(F.lds + GL_SSQ);
#pragma unroll
    for (int mt = 0; mt < 4; ++mt)
#pragma unroll
        for (int e = 0; e < 4; ++e) { float ss = acc[mt][e] * acc[mt][e]; ss += __shfl_xor(ss, 1); ss += __shfl_xor(ss, 2); ss += __shfl_xor(ss, 4); ss += __shfl_xor(ss, 8);
            if (l15 == 0) ssq[w * 64 + 16 * mt + 4 * g4 + e] = ss; }
    __syncthreads();
    const int v = 16 * w + l15; const float gain = F.in[I_GLA_OG][v];
#pragma unroll
    for (int mt = 0; mt < 4; ++mt)
#pragma unroll
        for (int e = 0; e < 4; ++e) { const int row = 16 * mt + 4 * g4 + e; float tot = 0.f;
#pragma unroll
            for (int ww = 0; ww < 8; ++ww) tot += ssq[ww * 64 + row];
            const float rstd = rsqrtf(tot * (1.f / 128.f) + EPS), r = bf2f(*(LAS const bf16_t*)(F.lds + GL_R + row * 256 + v * 2));
            *(LAS bf16_t*)(F.lds + GL_O + row * 256 + v * 2) = (bf16_t)f2bf(acc[mt][e] * rstd * gain * r * __builtin_amdgcn_rcpf(1.f + __expf(-r))); }
    __syncthreads();
    { const int row0 = F.tid >> 4, ch0 = F.tid & 15;
      *(u32x4*)(MIX + (size_t)(t0 + row0) * DM + h * 128 + ch0 * 8) = *(LAS const u32x4*)(F.lds + GL_O + row0 * 256 + ch0 * 16);
      *(u32x4*)(MIX + (size_t)(t0 + row0 + 32) * DM + h * 128 + ch0 * 8) = *(LAS const u32x4*)(F.lds + GL_O + (row0 + 32) * 256 + ch0 * 16); }
}
__device__ __forceinline__ void ph_gla_a(Frame& F) {
    if (F.bid >= 1024) return; GlaRegs R, Rn; gla_load<false>(F, F.bid, R);
    for (int u = F.bid; u < 1024; u += F.G) { const bool more = u + F.G < 1024; if (more) gla_load<false>(F, u + F.G, Rn); gla_a_unit(F, u, R); if (more) R = Rn; }
}
__device__ __forceinline__ void ph_gla_c(Frame& F) {
    if (F.bid >= 1024) return; GlaRegs R, Rn; gla_load<true>(F, F.bid, R);
    for (int u = F.bid; u < 1024; u += F.G) { const bool more = u + F.G < 1024; if (more) gla_load<true>(F, u + F.G, Rn); gla_c_unit(F, u, R); if (more) R = Rn; }
}

__device__ __forceinline__ void ph_router(Frame& F, bool commit) {
    const bf16_t* X1B = (const bf16_t*)(F.ws + WS_X1B); unsigned* ETOK = (unsigned*)(F.ws + WS_ETOK); float* EGATE = (float*)(F.ws + WS_EGATE); float* ERSTD = (float*)(F.ws + WS_ERSTD); unsigned* TLOC = (unsigned*)(F.ws + WS_TLOC);
    unsigned* ECNT = F.ctl + CW_ECNT;
    const int gw = F.bid * 8 + F.wave, NGW = F.G * 8;
    for (int t = gw; t < T_TOK; t += NGW) {
        f32x4 v[4]; float ss = 0.f;
#pragma unroll
        for (int j = 0; j < 4; ++j) { const u32x2 w = ((const u32x2*)(X1B + (size_t)t * DM))[F.lane + 64 * j]; v[j] = (f32x4){bf2f(w.x & 0xffffu), bf2f(w.x >> 16), bf2f(w.y & 0xffffu), bf2f(w.y >> 16)};
            ss += v[j].x * v[j].x + v[j].y * v[j].y + v[j].z * v[j].z + v[j].w * v[j].w; }
        const float rstd = rsqrtf(wave_sum(ss) * (1.f / DM) + EPS);
        float lg[4] = {0.f, 0.f, 0.f, 0.f};
#pragma unroll
        for (int j = 0; j < 4; ++j) { const f32x4 gg = ((const f32x4*)F.in[I_FFN_G])[F.lane + 64 * j]; v[j] = v[j] * rstd * gg;
#pragma unroll
            for (int e = 0; e < 4; ++e) { const f32x4 w = ((const f32x4*)F.in[I_WRG])[4 * (F.lane + 64 * j) + e];
                lg[0] += v[j][e] * w.x; lg[1] += v[j][e] * w.y; lg[2] += v[j][e] * w.z; lg[3] += v[j][e] * w.w; } }
#pragma unroll
        for (int i = 0; i < 4; ++i) lg[i] = wave_sum(lg[i]) + F.in[I_BRG][i];
        int gs = 0; float gm = lg[0];
#pragma unroll
        for (int i = 1; i < 4; ++i) if (lg[i] > gm) { gm = lg[i]; gs = i; }
        float den = 0.f;
#pragma unroll
        for (int i = 0; i < 4; ++i) den += __expf(lg[i] - gm);
        const float pg = 1.f / den;
        float le[8];
#pragma unroll
        for (int i = 0; i < 8; ++i) le[i] = 0.f;
        const float* wre = F.in[I_WRE] + (size_t)gs * DM * 8;
#pragma unroll
        for (int j = 0; j < 4; ++j)
#pragma unroll
            for (int e = 0; e < 4; ++e) { const int d = 4 * (F.lane + 64 * j) + e; const f32x4 w0 = ((const f32x4*)wre)[2 * d], w1 = ((const f32x4*)wre)[2 * d + 1];
                le[0] += v[j][e] * w0.x; le[1] += v[j][e] * w0.y; le[2] += v[j][e] * w0.z; le[3] += v[j][e] * w0.w; le[4] += v[j][e] * w1.x; le[5] += v[j][e] * w1.y; le[6] += v[j][e] * w1.z; le[7] += v[j][e] * w1.w; }
#pragma unroll
        for (int i = 0; i < 8; ++i) le[i] = wave_sum(le[i]) + F.in[I_BRE][gs * 8 + i];
        int i0 = 0; float m0 = le[0];
#pragma unroll
        for (int i = 1; i < 8; ++i) if (le[i] > m0) { m0 = le[i]; i0 = i; }
        int i1 = i0 == 0 ? 1 : 0; float m1 = -INFINITY;
#pragma unroll
        for (int i = 0; i < 8; ++i) if (i != i0 && le[i] > m1) { m1 = le[i]; i1 = i; }
        const float w0 = 1.f / (1.f + __expf(m1 - m0)), w1 = 1.f - w0;
        if (F.lane == 0 && commit) {
            const int e0 = gs * 8 + i0, e1 = gs * 8 + i1;
            const unsigned p0 = atomicAdd(&ECNT[e0], 1u), p1 = atomicAdd(&ECNT[e1], 1u);
            ETOK[e0 * T_TOK + p0] = (unsigned)t; EGATE[e0 * T_TOK + p0] = pg * w0; ERSTD[e0 * T_TOK + p0] = rstd; ETOK[e1 * T_TOK + p1] = (unsigned)t; EGATE[e1 * T_TOK + p1] = pg * w1; ERSTD[e1 * T_TOK + p1] = rstd;
            TLOC[t * 2] = ((unsigned)e0 << 16) | p0; TLOC[t * 2 + 1] = ((unsigned)e1 << 16) | p1;
        }
    }
}


struct EpiOut {
    static constexpr bool PERM = true, AFTER_DRAIN = false;
    const float* x; bf16_t* x1b;
    __device__ __forceinline__ void operator()(const pg8::f32x4 (&acc)[2][2][4][2], const pg8::Unit& u, int wr, int wc, int fr, int fq) const {
#pragma unroll
        for (int ai = 0; ai < 2; ++ai)
#pragma unroll
            for (int m = 0; m < 4; ++m) { const size_t off = (size_t)(u.pm * 256 + 128 * ai + 64 * wr + 16 * m + fr) * DM + u.pn * 256 + 64 * wc + 8 * fq;
#pragma unroll
                for (int bj = 0; bj < 2; ++bj) { const f32x4 a = __builtin_nontemporal_load((const f32x4*)(x + off + 32 * bj)) + acc[ai][bj][m][0], b = __builtin_nontemporal_load((const f32x4*)(x + off + 32 * bj + 4)) + acc[ai][bj][m][1];
                    u32x4 w; w.x = pg8::cvt_pk_bf16(a[0], a[1]); w.y = pg8::cvt_pk_bf16(a[2], a[3]); w.z = pg8::cvt_pk_bf16(b[0], b[1]); w.w = pg8::cvt_pk_bf16(b[2], b[3]);
                    *(u32x4*)(x1b + off + 32 * bj) = w; } }
    }
};
__device__ __forceinline__ void ph_outproj_gemm(Frame& F) {
    pg8::Gemm g{(const bf16_t*)(F.ws + WS_MIX), (const bf16_t*)(F.ws + WS_WOUT_T), T_TOK, DM, DM};
    pg8::StaticOrder S; S.init(T_TOK, DM, F.G, F.bid);
    EpiOut E{F.in[I_X], (bf16_t*)(F.ws + WS_X1B)};
    pg8::gemm_phase<EpiOut, pg8::StaticOrder, true, true>(F.lds, g, S, E);
}

constexpr int ML_PTILE = LDSCTL_OFF + 256, ML_CNT = LDSCTL_OFF + 512, ML_UT = LDSCTL_OFF + 768, ML_TOK = LDSCTL_OFF + 1024;
struct MoeOrder {
    LAS const int* ut; LAS const unsigned* tokl;
    __device__ __forceinline__ bool next(int i, pg8::Unit& u) const { if (i >= 4 || ut[4 * i + 2] == 0) return false; u.pm = ut[4 * i]; u.pn = ut[4 * i + 1]; u.aux = i; return true; }
    __device__ __forceinline__ unsigned arow(const pg8::Unit& u, int r) const { return tokl[u.aux * 256 + r]; }
    __device__ __forceinline__ void a_ready(const pg8::Unit&) const {}
    __device__ __forceinline__ void done(const pg8::Unit&) const {}
};
__device__ __forceinline__ void moe_setup(Frame& F, bool want_tok) {
    LAS int* ptile = (LAS int*)(F.lds + ML_PTILE); LAS int* cnt = (LAS int*)(F.lds + ML_CNT); LAS int* ut = (LAS int*)(F.lds + ML_UT); LAS unsigned* tokl = (LAS unsigned*)(F.lds + ML_TOK);
    const unsigned* ETOK = (const unsigned*)(F.ws + WS_ETOK);
    __syncthreads();
    if (F.tid < 32) cnt[F.tid] = (int)xb_ld(F.ctl + CW_ECNT + F.tid);
    __syncthreads();
    if (F.tid == 0) {
        int a = 0; for (int e = 0; e < 32; ++e) { ptile[e] = a; a += (cnt[e] + 255) >> 8; } ptile[32] = a;
        const int nx = (F.G & 7) == 0 ? 8 : 1, x = nx == 8 ? (F.bid & 7) : 0, kx = nx == 8 ? (F.bid >> 3) : F.bid, per = F.G / nx;
        const int lo = (x * a) / nx, hi = ((x + 1) * a) / nx;
        for (int i = 0; i < 4; ++i) { const int L = i * per + kx;
            if (L < 4 * (hi - lo)) { const int tl = lo + (L >> 2); int e = 0; while (ptile[e + 1] <= tl) ++e; ut[4 * i] = tl; ut[4 * i + 1] = e * 4 + (L & 3); ut[4 * i + 2] = 1; ut[4 * i + 3] = tl - ptile[e]; }
            else { ut[4 * i] = 0; ut[4 * i + 1] = 0; ut[4 * i + 2] = 0; ut[4 * i + 3] = 0; } }
    }
    __syncthreads();
    if (want_tok)
        for (int idx = F.tid; idx < 1024; idx += 512) { const int i = idx >> 8, r = idx & 255;
            if (ut[4 * i + 2]) { const int e = ut[4 * i + 1] >> 2; int p = 256 * ut[4 * i + 3] + r; if (p >= cnt[e]) p = 0; tokl[idx] = ETOK[e * T_TOK + p]; } else tokl[idx] = 0u; }
    __syncthreads();
}
struct EpiSwiGLU {
    static constexpr bool PERM = true, AFTER_DRAIN = false;
    bf16_t* HID; const float* ERSTD; LAS const int* ptile; LAS const int* cnt;
    __device__ __forceinline__ void operator()(const pg8::f32x4 (&acc)[2][2][4][2], const pg8::Unit& u, int wr, int wc, int fr, int fq) const {
        const int e = u.pn >> 2, p0 = 256 * (u.pm - ptile[e]) + 64 * wr + fr, ne = cnt[e];
        float rs[2][4];
#pragma unroll
        for (int ai = 0; ai < 2; ++ai)
#pragma unroll
            for (int m = 0; m < 4; ++m) { const int p = p0 + 128 * ai + 16 * m; rs[ai][m] = ERSTD[e * T_TOK + (p < ne ? p : 0)]; }
        bf16_t* base = HID + (size_t)(u.pm * 256 + 64 * wr + fr) * 512 + (u.pn & 3) * 128 + 32 * wc + 8 * fq;
#pragma unroll
        for (int ai = 0; ai < 2; ++ai)
#pragma unroll
            for (int m = 0; m < 4; ++m) { float o[8];
#pragma unroll
                for (int j = 0; j < 8; ++j) { const float gt = acc[ai][0][m][j >> 2][j & 3] * rs[ai][m], up = acc[ai][1][m][j >> 2][j & 3] * rs[ai][m]; o[j] = gt * __builtin_amdgcn_rcpf(1.f + __expf(-gt)) * up; }
                u32x4 w; w.x = pg8::cvt_pk_bf16(o[0], o[1]); w.y = pg8::cvt_pk_bf16(o[2], o[3]); w.z = pg8::cvt_pk_bf16(o[4], o[5]); w.w = pg8::cvt_pk_bf16(o[6], o[7]);
                *(u32x4*)(base + (size_t)(128 * ai + 16 * m) * 512) = w; }
    }
};
__device__ __forceinline__ void ph_moe_gateup(Frame& F) {
    moe_setup(F, true);
    pg8::Gemm g{(const bf16_t*)(F.ws + WS_X1B), (const bf16_t*)(F.ws + WS_WGU_T), T_TOK, 32 * 1024, DM};
    MoeOrder S{(LAS const int*)(F.lds + ML_UT), (LAS const unsigned*)(F.lds + ML_TOK)};
    EpiSwiGLU E{(bf16_t*)(F.ws + WS_HID), (const float*)(F.ws + WS_ERSTD), (LAS const int*)(F.lds + ML_PTILE), (LAS const int*)(F.lds + ML_CNT)};
    pg8::gemm_phase_gather<EpiSwiGLU, MoeOrder, true, true>(F.lds, g, S, E);
}
struct EpiDown {
    static constexpr bool PERM = true, AFTER_DRAIN = false;
    bf16_t* Y; const float* EGATE; LAS const int* ptile; LAS const int* cnt;
    __device__ __forceinline__ void operator()(const pg8::f32x4 (&acc)[2][2][4][2], const pg8::Unit& u, int wr, int wc, int fr, int fq) const {
        const int e = u.pn >> 2, p0 = 256 * (u.pm - ptile[e]) + 64 * wr + fr, ne = cnt[e];
        float gw[2][4];
#pragma unroll
        for (int ai = 0; ai < 2; ++ai)
#pragma unroll
            for (int m = 0; m < 4; ++m) { const int p = p0 + 128 * ai + 16 * m; gw[ai][m] = p < ne ? EGATE[e * T_TOK + p] : 0.f; }
        bf16_t* base = Y + (size_t)(u.pm * 256 + 64 * wr + fr) * DM + (u.pn & 3) * 256 + 64 * wc + 8 * fq;
#pragma unroll
        for (int ai = 0; ai < 2; ++ai)
#pragma unroll
            for (int m = 0; m < 4; ++m)
#pragma unroll
                for (int bj = 0; bj < 2; ++bj) { const pg8::f32x4 a = acc[ai][bj][m][0] * gw[ai][m], b = acc[ai][bj][m][1] * gw[ai][m];
                    u32x4 w; w.x = pg8::cvt_pk_bf16(a[0], a[1]); w.y = pg8::cvt_pk_bf16(a[2], a[3]); w.z = pg8::cvt_pk_bf16(b[0], b[1]); w.w = pg8::cvt_pk_bf16(b[2], b[3]);
                    *(u32x4*)(base + (size_t)(128 * ai + 16 * m) * DM + 32 * bj) = w; }
    }
};
__device__ __forceinline__ void ph_moe_down(Frame& F) {
    moe_setup(F, false);
    pg8::Gemm g{(const bf16_t*)(F.ws + WS_HID), (const bf16_t*)(F.ws + WS_WD_T), 40960, 32 * 1024, 512};
    MoeOrder S{(LAS const int*)(F.lds + ML_UT), (LAS const unsigned*)(F.lds + ML_TOK)};
    EpiDown E{(bf16_t*)(F.ws + WS_YBUF), (const float*)(F.ws + WS_EGATE), (LAS const int*)(F.lds + ML_PTILE), (LAS const int*)(F.lds + ML_CNT)};
    pg8::gemm_phase<EpiDown, MoeOrder, true, true>(F.lds, g, S, E);
}
__device__ __forceinline__ void ph_combine(Frame& F, float* dst) {
    LAS int* ptile = (LAS int*)(F.lds + ML_PTILE);
    const unsigned* TLOC = (const unsigned*)(F.ws + WS_TLOC); const bf16_t* Y = (const bf16_t*)(F.ws + WS_YBUF); const bf16_t* X1B = (const bf16_t*)(F.ws + WS_X1B);
    const int gw = F.bid * 8 + F.wave, NGW = F.G * 8;
    for (int t = gw; t < T_TOK; t += NGW) {
        const unsigned l0 = TLOC[t * 2], l1 = TLOC[t * 2 + 1];
        const size_t r0 = (size_t)(256 * ptile[l0 >> 16] + (int)(l0 & 0xffffu)), r1 = (size_t)(256 * ptile[l1 >> 16] + (int)(l1 & 0xffffu));
#pragma unroll
        for (int j = 0; j < 4; ++j) { const int c4 = F.lane + 64 * j; const u32x2 xw = ((const u32x2*)(X1B + (size_t)t * DM))[c4]; f32x4 v = {bf2f(xw.x & 0xffffu), bf2f(xw.x >> 16), bf2f(xw.y & 0xffffu), bf2f(xw.y >> 16)};
            const u32x2 a = ((const u32x2*)(Y + r0 * DM))[c4], b = ((const u32x2*)(Y + r1 * DM))[c4];
            v.x += bf2f(a.x & 0xffffu); v.y += bf2f(a.x >> 16); v.z += bf2f(a.y & 0xffffu); v.w += bf2f(a.y >> 16);
            v.x += bf2f(b.x & 0xffffu); v.y += bf2f(b.x >> 16); v.z += bf2f(b.y & 0xffffu); v.w += bf2f(b.y >> 16);
            __builtin_nontemporal_store(v, ((f32x4*)(dst + (size_t)t * DM)) + c4); }
    }
}

__global__ void __launch_bounds__(512, 2) fwd(Args args) {
    extern __shared__ __attribute__((aligned(16))) unsigned char lds_raw[];
    Frame F;
    F.lds = (LAS unsigned char*)lds_raw; F.tid = threadIdx.x; F.lane = F.tid & 63; F.wave = __builtin_amdgcn_readfirstlane(F.tid >> 6);
    F.G = gridDim.x; F.bid = blockIdx.x; F.in = args.in; F.out = args.out; F.ws = args.ws; F.ctl = (unsigned*)(args.ws + WS_CTL);
    for (int u = F.tid; u < (LDS_BYTES - LDSCTL_OFF) / 4; u += 512) ((LAS unsigned*)(F.lds + LDSCTL_OFF))[u] = 0u;
    __syncthreads();
    XcdBarrier bar = xcd_barrier_post(F.ctl + CW_BAR, (volatile LAS unsigned*)(F.lds + LDSCTL_OFF + 32));
    const int lo = args.ph_lo, hi = args.ph_hi;
#define IN(k) (lo <= (k) && (k) < hi)
#define SEAM(k) do { if (IN(k) && IN((k) + 1)) xcd_barrier(bar); } while (0)
#ifndef PROBE_REP
#define PROBE_REP -1
#endif
#define REPB(k, body) do { if (IN(k)) { body; if (PROBE_REP == (k)) { xcd_barrier(bar); body; } } } while (0)
    REPB(0, { ph_norm_in(F); ph_prep_weights(F); });
    SEAM(0);
    if (IN(1)) { ph_proj_gemm(F, true); if (PROBE_REP == 1) { xcd_barrier(bar); ph_proj_gemm(F, false); } }
    SEAM(1);
    if (IN(2)) { ph_moba_route(F, F.ctl + CW_MCNT, (unsigned*)(F.ws + WS_MLIST)); ph_gla_a(F); if (PROBE_REP == 2) { xcd_barrier(bar); ph_gla_a(F); }
        if (PROBE_REP == 12) { xcd_barrier(bar); ph_moba_route(F, F.ctl + 32768, (unsigned*)(F.ws + WS_PO)); } }
    SEAM(2);
    if (IN(3)) { ph_gla_scan(F); ph_moba_gather(F, F.bid, F.G); if (PROBE_REP == 3) { xcd_barrier(bar); ph_gla_scan(F); ph_moba_gather(F, F.bid, F.G); } if (PROBE_REP == 13) { xcd_barrier(bar); ph_gla_scan(F); } }
    SEAM(3);
    if (IN(4)) { ph_moba_own(F, F.bid, F.G); ph_mem_attn(F, F.bid, F.G); ph_gla_c(F);
        if (PROBE_REP == 4) { xcd_barrier(bar); ph_moba_own(F, F.bid, F.G); ph_mem_attn(F, F.bid, F.G); ph_gla_c(F); }
        if (PROBE_REP == 14) { xcd_barrier(bar); ph_gla_c(F); } }
    SEAM(4);
    REPB(5, ph_outproj_gemm(F));
    SEAM(5);
    if (IN(6)) { ph_router(F, true); if (PROBE_REP == 6) { xcd_barrier(bar); ph_router(F, false); } }
    SEAM(6);
    REPB(7, ph_moe_gateup(F));
    SEAM(7);
    REPB(8, ph_moe_down(F));
    SEAM(8);
    if (IN(9)) { moe_setup(F, false); if (PROBE_REP == 9) { ph_combine(F, (float*)(F.ws + WS_PROJ)); xcd_barrier(bar); } if (PROBE_REP == 20) { xcd_barrier(bar); xcd_barrier(bar); xcd_barrier(bar); xcd_barrier(bar); } ph_combine(F, F.out); }
#undef IN
#undef SEAM
}

extern "C" void kernel_launch(void* const* d_in, const int* in_sizes, int n_in, void* d_out, int out_size, void* d_ws, size_t ws_size, hipStream_t stream) {
    static int grid = 0;
    if (grid == 0) {
        if (n_in != 22 || out_size != T_TOK * DM || ws_size < WS_END) { fprintf(stderr, "kernel_launch: unexpected shapes (n_in %d, out %d, ws %zu)\n", n_in, out_size, ws_size); grid = -1; return; }
        int dev = 0, cus = 0;
        if (hipGetDevice(&dev) != hipSuccess || hipDeviceGetAttribute(&cus, hipDeviceAttributeMultiprocessorCount, dev) != hipSuccess) { grid = -1; return; }
        if (hipFuncSetAttribute((const void*)fwd, hipFuncAttributeMaxDynamicSharedMemorySize, LDS_BYTES) != hipSuccess) { grid = -1; return; }
        int per_cu = 0;
        (void)hipOccupancyMaxActiveBlocksPerMultiprocessor(&per_cu, (const void*)fwd, 512, LDS_BYTES);
        (void)hipGetLastError();
        grid = cus;
    }
    if (grid < 0) return;
    (void)hipMemsetAsync((char*)d_ws + WS_CTL, 0, CTL_ZERO_BYTES, stream);
    Args a{};
    for (int i = 0; i < 22; ++i) a.in[i] = (const float*)d_in[i];
    a.out = (float*)d_out; a.ws = (unsigned char*)d_ws; a.ph_lo = 0; a.ph_hi = 10;
    hipLaunchKernelGGL(fwd, dim3(grid), dim3(512), LDS_BYTES, stream, a);
}
```
